# Optimizing an MI355X kernel written in HIP

```python
import jax, jax.numpy as jnp
from jax import lax
import numpy as np

D_MODEL = 1024
BATCH = 8
SEQ = 4096
DEPTH = 1

CONV_CH = D_MODEL
CONV_WIDTH = 31
HEAD_DIM = 128
HEADS_PER_GROUP = 4
ATTN_GROUPS = ((128, 1), (512, 4), (2048, 16))
N_GROUPS = len(ATTN_GROUPS)
N_ATTN_HEADS = HEADS_PER_GROUP * N_GROUPS
ATTN_WIDTH = N_ATTN_HEADS * HEAD_DIM
ATTN_OUT_WIDTH = HEADS_PER_GROUP * HEAD_DIM
BLOCK = 128
D_FF = 2816
EPS = 1e-6
IN_WIDTH = 2 * CONV_CH + 3 * ATTN_WIDTH + 2 * D_MODEL

kernel_name = "hybrid_conformer_dilated_attn_block"


def _alibi_slopes():
    h = np.arange(1, N_ATTN_HEADS + 1, dtype=np.float32)
    return np.power(np.float32(2.0), -8.0 * h / np.float32(N_ATTN_HEADS)).astype(np.float32)


def rmsnorm(x, g):
    xf = x.astype(jnp.float32)
    y = xf * lax.rsqrt(jnp.mean(xf * xf, axis=-1, keepdims=True) + EPS)
    return (y * g.astype(jnp.float32)).astype(x.dtype)


def swiglu_ffn(h, w_gate, w_up, w_down):
    return (jax.nn.silu(h @ w_gate) * (h @ w_up)) @ w_down


def conformer_conv(u, dw_kernel, dw_bias, ln_gain, ln_bias, w_out):
    a, b = jnp.split(u, 2, axis=-1)
    z = a * jax.nn.sigmoid(b)
    z = lax.conv_general_dilated(
        z, dw_kernel[:, None, :], window_strides=(1,),
        padding=[(CONV_WIDTH - 1, 0)],
        dimension_numbers=('NWC', 'WIO', 'NWC'),
        feature_group_count=CONV_CH) + dw_bias
    zf = z.astype(jnp.float32)
    mu = jnp.mean(zf, axis=-1, keepdims=True)
    var = jnp.mean(jnp.square(zf - mu), axis=-1, keepdims=True)
    zf = (zf - mu) * lax.rsqrt(var + EPS) * ln_gain.astype(jnp.float32) + ln_bias.astype(jnp.float32)
    z = jax.nn.silu(zf).astype(u.dtype)
    return z @ w_out


def dilated_group_attention(q, k, v, slopes, window, dilation):
    B, S, H, E = q.shape
    span = window // dilation
    chunk = dilation * BLOCK
    s_pad = -(-S // chunk) * chunk
    L = s_pad // dilation
    nb = L // BLOCK

    def to_blocks(t):
        t = jnp.pad(t, ((0, 0), (0, s_pad - S), (0, 0), (0, 0)))
        t = t.reshape(B, L, dilation, H, E)
        t = t.transpose(0, 3, 2, 1, 4)
        return t.reshape(B, H, dilation, nb, BLOCK, E)

    def with_prev(t):
        prev = jnp.pad(t[:, :, :, :-1], ((0, 0), (0, 0), (0, 0), (1, 0), (0, 0), (0, 0)))
        return jnp.concatenate([prev, t], axis=4)

    qb = to_blocks(q)
    kc = with_prev(to_blocks(k))
    vc = with_prev(to_blocks(v))

    scores = jnp.einsum('bhrnqe,bhrnke->bhrnqk', qb, kc).astype(jnp.float32) * (E ** -0.5)
    qi = jnp.arange(BLOCK)[:, None]
    ki = jnp.arange(2 * BLOCK)[None, :]
    steps = BLOCK + qi - ki
    in_band = (steps >= 0) & (steps <= span)
    first_block = (jnp.arange(nb) == 0)[:, None, None]
    valid = in_band[None] & ~(first_block & (ki < BLOCK)[None])
    bias = -slopes[:, None, None] * (dilation * steps).astype(jnp.float32)
    scores = scores + bias[None, :, None, None]
    scores = jnp.where(valid[None, None, None], scores, -jnp.inf)
    m = jnp.max(scores, axis=-1, keepdims=True)
    p = jnp.exp(scores - m)
    denom = jnp.sum(p, axis=-1, keepdims=True)
    out = jnp.einsum('bhrnqk,bhrnke->bhrnqe', p.astype(vc.dtype), vc).astype(jnp.float32) / denom
    lse = (m + jnp.log(denom))[..., 0]

    out = out.astype(q.dtype).reshape(B, H, dilation, L, E).transpose(0, 3, 2, 1, 4)
    out = out.reshape(B, s_pad, H, E)[:, :S]
    lse = lse.reshape(B, H, dilation, L).transpose(0, 3, 2, 1).reshape(B, s_pad, H)[:, :S]
    return out, lse


def setup_inputs(seed: int = 0) -> dict:
    key = jax.random.key(seed)
    ks = jax.random.split(key, 24)

    def w(k, shape, fan_in):
        return jax.random.normal(k, shape, jnp.float32) * (fan_in ** -0.5)

    def gain(k, shape):
        return 1.0 + 0.02 * jax.random.normal(k, shape, jnp.float32)

    def small(k, shape):
        return 0.02 * jax.random.normal(k, shape, jnp.float32)

    Lr = DEPTH
    return {
        "x": jax.random.normal(ks[0], (BATCH, SEQ, D_MODEL), jnp.float32),
        "ffn1_norm": gain(ks[1], (Lr, D_MODEL)),
        "ffn1_w_gate": w(ks[2], (Lr, D_MODEL, D_FF), D_MODEL),
        "ffn1_w_up": w(ks[3], (Lr, D_MODEL, D_FF), D_MODEL),
        "ffn1_w_down": w(ks[4], (Lr, D_FF, D_MODEL), D_FF),
        "mix_norm": gain(ks[5], (Lr, D_MODEL)),
        "w_in": w(ks[6], (Lr, D_MODEL, IN_WIDTH), D_MODEL),
        "conv_dw_kernel": w(ks[7], (Lr, CONV_WIDTH, CONV_CH), CONV_WIDTH),
        "conv_dw_bias": small(ks[8], (Lr, CONV_CH)),
        "conv_ln_gain": gain(ks[9], (Lr, CONV_CH)),
        "conv_ln_bias": small(ks[10], (Lr, CONV_CH)),
        "conv_w_out": w(ks[11], (Lr, CONV_CH, D_MODEL), CONV_CH),
        "attn_w_out": w(ks[12], (Lr, ATTN_OUT_WIDTH, D_MODEL), ATTN_OUT_WIDTH),
        "w_o": w(ks[13], (Lr, D_MODEL, D_MODEL), D_MODEL),
        "ffn2_norm": gain(ks[14], (Lr, D_MODEL)),
        "ffn2_w_gate": w(ks[15], (Lr, D_MODEL, D_FF), D_MODEL),
        "ffn2_w_up": w(ks[16], (Lr, D_MODEL, D_FF), D_MODEL),
        "ffn2_w_down": w(ks[17], (Lr, D_FF, D_MODEL), D_FF),
        "final_norm": gain(ks[18], (D_MODEL,)),
    }


def reference(x, ffn1_norm, ffn1_w_gate, ffn1_w_up, ffn1_w_down, mix_norm, w_in,
              conv_dw_kernel, conv_dw_bias, conv_ln_gain, conv_ln_bias, conv_w_out,
              attn_w_out, w_o, ffn2_norm, ffn2_w_gate, ffn2_w_up, ffn2_w_down, final_norm):
    B, S, _ = x.shape
    slopes = jnp.asarray(_alibi_slopes())
    split_at = [2 * CONV_CH,
                2 * CONV_CH + ATTN_WIDTH,
                2 * CONV_CH + 2 * ATTN_WIDTH,
                2 * CONV_CH + 3 * ATTN_WIDTH,
                2 * CONV_CH + 3 * ATTN_WIDTH + D_MODEL]
    for l in range(DEPTH):
        x = x + 0.5 * swiglu_ffn(rmsnorm(x, ffn1_norm[l]), ffn1_w_gate[l], ffn1_w_up[l], ffn1_w_down[l])

        h = rmsnorm(x, mix_norm[l])
        proj = h @ w_in[l]
        u_conv, q, k, v, g_conv, g_attn = jnp.split(proj, split_at, axis=-1)

        y_conv = conformer_conv(u_conv, conv_dw_kernel[l], conv_dw_bias[l],
                                conv_ln_gain[l], conv_ln_bias[l], conv_w_out[l])

        q = q.reshape(B, S, N_GROUPS, HEADS_PER_GROUP, HEAD_DIM)
        k = k.reshape(B, S, N_GROUPS, HEADS_PER_GROUP, HEAD_DIM)
        v = v.reshape(B, S, N_GROUPS, HEADS_PER_GROUP, HEAD_DIM)
        outs, lses = [], []
        for gi, (window, dilation) in enumerate(ATTN_GROUPS):
            o_g, lse_g = dilated_group_attention(
                q[:, :, gi], k[:, :, gi], v[:, :, gi],
                slopes[gi * HEADS_PER_GROUP:(gi + 1) * HEADS_PER_GROUP], window, dilation)
            outs.append(o_g)
            lses.append(lse_g)
        outs = jnp.stack(outs, axis=0)
        lam = jax.nn.softmax(jnp.stack(lses, axis=0), axis=0)
        attn = jnp.sum(lam[..., None].astype(outs.dtype) * outs, axis=0)
        y_attn = attn.reshape(B, S, ATTN_OUT_WIDTH) @ attn_w_out[l]

        mixed = jax.nn.sigmoid(g_conv) * y_conv + jax.nn.sigmoid(g_attn) * y_attn
        x = x + mixed @ w_o[l]

        x = x + 0.5 * swiglu_ffn(rmsnorm(x, ffn2_norm[l]), ffn2_w_gate[l], ffn2_w_up[l], ffn2_w_down[l])
    return rmsnorm(x, final_norm)
```

```cpp
#include <hip/hip_runtime.h>
#include <cstdio>
#include <cstdint>
namespace pg8 {
#define PG8_LAS __attribute__((address_space(3)))
typedef unsigned short bf16_t;
typedef short bf16x8 __attribute__((ext_vector_type(8)));
typedef float f32x4 __attribute__((ext_vector_type(4)));
typedef unsigned u32x4 __attribute__((ext_vector_type(4)));
constexpr int BM = 256, BK = 64, HALF = 128, HTB = HALF * BK * 2  , STAGE_BYTES = 8 * HTB, NXCD = 8, WGM = 8;

__host__ __device__ __forceinline__ int lds_byte(int r, int c) { const int st = (r >> 4) * 2 + (c >> 5), rr = r & 15, cc = c & 31, ob = rr * 64 + cc * 2; return st * 1024 + (ob ^ (((ob >> 9) & 1) << 5)); }
__host__ __device__ __forceinline__ void stage_rc(int b, int& R, int& C) { const int st = b / 1024, sb = b % 1024, swz = sb ^ (((sb >> 9) & 1) << 5); R = (st >> 1) * 16 + swz / 64; C = (st & 1) * 32 + (swz % 64) / 2; }
__host__ __device__ __forceinline__ int perm32(int rho) { const int n = rho >> 4, i = rho & 15; return 8 * (i >> 2) + 4 * n + (i & 3); }

struct Unit { int pm, pn; };
struct Gemm { const bf16_t* A; const bf16_t* Bt; int M, N, K; };

struct StaticOrder {
    int nM, nN, nwg, G, c;
    __host__ __device__ void init(int M, int N, int G_, int c_) { nM = M / BM; nN = N / BM; nwg = nM * nN; G = G_; c = c_; }
    __host__ __device__ bool next(int i, Unit& u) const {
        const long L = (long)i * G + c; if (L >= nwg) return false;
        int wgid = (int)L; { const int q = nwg / NXCD, r = nwg % NXCD, xcd = wgid % NXCD, off = wgid / NXCD; wgid = (xcd < r ? xcd * (q + 1) : r * (q + 1) + (xcd - r) * q) + off; }
        const int nig = WGM * nN, gid = wgid / nig, fm = gid * WGM, gsz = (nM - fm) < WGM ? (nM - fm) : WGM;
        u.pm = fm + ((wgid % nig) % gsz); u.pn = (wgid % nig) / gsz; return true;
    }
    __device__ __forceinline__ void a_ready(const Unit&) const {}
    __device__ __forceinline__ void done(const Unit&) const {}
};

typedef float f32x2_t __attribute__((ext_vector_type(2))); typedef __bf16 bf16x2_t __attribute__((ext_vector_type(2)));
__device__ __forceinline__ unsigned cvt_pk_bf16(float lo, float hi) { const f32x2_t v = {lo, hi}; const bf16x2_t b = __builtin_convertvector(v, bf16x2_t); return __builtin_bit_cast(unsigned, b); }
typedef float f32x2 __attribute__((ext_vector_type(2)));
__device__ __forceinline__ float sigmoid_f(float x) { return __builtin_amdgcn_rcpf(1.0f + __builtin_amdgcn_exp2f(-1.4426950408889634f * x)); }
__device__ __forceinline__ float bf_lo(unsigned u) { return __uint_as_float(u << 16); }
__device__ __forceinline__ float bf_hi(unsigned u) { return __uint_as_float(u & 0xffff0000u); }

template <int ACT> struct EpiPair {
    static constexpr bool PERM = true, AFTER_DRAIN = false;
    bf16_t* O; int ldo;
    __device__ __forceinline__ void operator()(const f32x4 (&acc)[2][2][4][2], const Unit& u, int wr, int wc, int fr, int fq) const {
        const int row0 = u.pm * BM + wr * 64 + fr, col0 = u.pn * HALF + wc * 32 + 8 * fq;
#pragma unroll
        for (int ai = 0; ai < 2; ++ai)
#pragma unroll
            for (int m = 0; m < 4; ++m) {
                float v[8];
#pragma unroll
                for (int n = 0; n < 2; ++n)
#pragma unroll
                    for (int i = 0; i < 4; ++i) { const float a = acc[ai][0][m][n][i], b = acc[ai][1][m][n][i];
                        v[n * 4 + i] = (ACT == 0) ? a * sigmoid_f(a) * b : a * sigmoid_f(b); }
                u32x4 w; w.x = cvt_pk_bf16(v[0], v[1]); w.y = cvt_pk_bf16(v[2], v[3]); w.z = cvt_pk_bf16(v[4], v[5]); w.w = cvt_pk_bf16(v[6], v[7]);
                *(u32x4*)(O + (size_t)(row0 + ai * HALF + m * 16) * ldo + col0) = w; }
    }
};
struct EpiResid {
    static constexpr bool PERM = true, AFTER_DRAIN = false;
    const float* base; float* out; int ldo; float alpha;
    __device__ __forceinline__ void operator()(const f32x4 (&acc)[2][2][4][2], const Unit& u, int wr, int wc, int fr, int fq) const {
        const int row0 = u.pm * BM + wr * 64 + fr, col0 = u.pn * BM + wc * 32 + 8 * fq;
#pragma unroll
        for (int ai = 0; ai < 2; ++ai)
#pragma unroll
            for (int m = 0; m < 4; ++m) { const size_t off = (size_t)(row0 + ai * HALF + m * 16) * ldo + col0;
#pragma unroll
                for (int bj = 0; bj < 2; ++bj)
#pragma unroll
                    for (int n = 0; n < 2; ++n) { const f32x4 bs = *(const f32x4*)(base + off + bj * HALF + 4 * n);
                        *(f32x4*)(out + off + bj * HALF + 4 * n) = bs + acc[ai][bj][m][n] * alpha; } }
    }
};
struct EpiQKV {
    static constexpr bool PERM = true, AFTER_DRAIN = false;
    bf16_t* O; size_t tstride; float qscale;
    __device__ __forceinline__ void operator()(const f32x4 (&acc)[2][2][4][2], const Unit& u, int wr, int wc, int fr, int fq) const {
        const int row0 = u.pm * BM + wr * 64 + fr; const int t = u.pn / 6, ct = u.pn - 6 * t, dsh = 2 * (ct >> 1);
        bf16_t* base = O + (size_t)t * tstride + wc * 32 + 8 * fq; const float sc = (t == 0) ? qscale : 1.0f;
#pragma unroll
        for (int ai = 0; ai < 2; ++ai)
#pragma unroll
            for (int m = 0; m < 4; ++m) { const int row = row0 + ai * HALF + m * 16, b = row >> 12, s = row & 4095;
                const int pos = ((s & ((1 << dsh) - 1)) << (12 - dsh)) + (s >> dsh);
#pragma unroll
                for (int bj = 0; bj < 2; ++bj) { const f32x4 v0 = acc[ai][bj][m][0] * sc, v1 = acc[ai][bj][m][1] * sc;
                    u32x4 w; w.x = cvt_pk_bf16(v0[0], v0[1]); w.y = cvt_pk_bf16(v0[2], v0[3]); w.z = cvt_pk_bf16(v1[0], v1[1]); w.w = cvt_pk_bf16(v1[2], v1[3]);
                    *(u32x4*)(base + ((size_t)((b * 12 + 2 * ct + bj) * 4096 + pos)) * 128) = w; } }
    }
};
struct EpiSig {
    static constexpr bool PERM = true, AFTER_DRAIN = false;
    bf16_t* O; int ldo;
    __device__ __forceinline__ void operator()(const f32x4 (&acc)[2][2][4][2], const Unit& u, int wr, int wc, int fr, int fq) const {
        const int row0 = u.pm * BM + wr * 64 + fr, col0 = u.pn * BM + wc * 32 + 8 * fq;
#pragma unroll
        for (int ai = 0; ai < 2; ++ai)
#pragma unroll
            for (int m = 0; m < 4; ++m) { bf16_t* rowp = O + (size_t)(row0 + ai * HALF + m * 16) * ldo + col0;
#pragma unroll
                for (int bj = 0; bj < 2; ++bj) { float v[8];
#pragma unroll
                    for (int n = 0; n < 2; ++n)
#pragma unroll
                        for (int i = 0; i < 4; ++i) v[n * 4 + i] = sigmoid_f(acc[ai][bj][m][n][i]);
                    u32x4 w; w.x = cvt_pk_bf16(v[0], v[1]); w.y = cvt_pk_bf16(v[2], v[3]); w.z = cvt_pk_bf16(v[4], v[5]); w.w = cvt_pk_bf16(v[6], v[7]);
                    *(u32x4*)(rowp + bj * HALF) = w; } }
    }
};
template <bool HAS_BASE> struct EpiGate {
    static constexpr bool PERM = true, AFTER_DRAIN = false;
    const bf16_t* base; const bf16_t* gate; int ldg; bf16_t* O;
    __device__ __forceinline__ void operator()(const f32x4 (&acc)[2][2][4][2], const Unit& u, int wr, int wc, int fr, int fq) const {
        const int row0 = u.pm * BM + wr * 64 + fr, col0 = u.pn * BM + wc * 32 + 8 * fq;
#pragma unroll
        for (int ai = 0; ai < 2; ++ai)
#pragma unroll
            for (int m = 0; m < 4; ++m) { const size_t r = (size_t)(row0 + ai * HALF + m * 16);
#pragma unroll
                for (int bj = 0; bj < 2; ++bj) {
                    const u32x4 gv = *(const u32x4*)(gate + r * ldg + col0 + bj * HALF);
                    u32x4 bv = (u32x4){0u, 0u, 0u, 0u}; if (HAS_BASE) bv = *(const u32x4*)(base + r * 1024 + col0 + bj * HALF);
                    const f32x4 a0 = acc[ai][bj][m][0], a1 = acc[ai][bj][m][1];
                    float v[8];
                    v[0] = bf_lo(bv.x) + bf_lo(gv.x) * a0[0]; v[1] = bf_hi(bv.x) + bf_hi(gv.x) * a0[1];
                    v[2] = bf_lo(bv.y) + bf_lo(gv.y) * a0[2]; v[3] = bf_hi(bv.y) + bf_hi(gv.y) * a0[3];
                    v[4] = bf_lo(bv.z) + bf_lo(gv.z) * a1[0]; v[5] = bf_hi(bv.z) + bf_hi(gv.z) * a1[1];
                    v[6] = bf_lo(bv.w) + bf_lo(gv.w) * a1[2]; v[7] = bf_hi(bv.w) + bf_hi(gv.w) * a1[3];
                    u32x4 w; w.x = cvt_pk_bf16(v[0], v[1]); w.y = cvt_pk_bf16(v[2], v[3]); w.z = cvt_pk_bf16(v[4], v[5]); w.w = cvt_pk_bf16(v[6], v[7]);
                    *(u32x4*)(O + r * 1024 + col0 + bj * HALF) = w; } }
    }
};

template <class Epi, class Sched, bool ALIGN_EPI = false, bool SP2 = false>
__device__ __forceinline__ void gemm_phase(PG8_LAS unsigned char* lds, const Gemm g, const Sched& S, const Epi& E) {
    const int tid = threadIdx.x, wid = __builtin_amdgcn_readfirstlane(tid >> 6), lane = tid & 63, wr = wid >> 2, wc = wid & 3, fr = lane & 15, fq = lane >> 4;
    const int K = g.K, nt = K / BK;
    unsigned voffA[2], voffB[2];
#pragma unroll
    for (int i = 0; i < 2; ++i) { int R, C; stage_rc(tid * 16 + i * 8192, R, C); const int Rb = Epi::PERM ? ((R & ~31) + perm32(R & 31)) : R;
        voffA[i] = (unsigned)(R * K + C) * 2u; voffB[i] = (unsigned)(Rb * K + C) * 2u; }
    const size_t kstep = (size_t)(BK * 2);
    const size_t hstep = (size_t)HALF * K * 2;
    const size_t tstep = 2 * hstep;
    const unsigned ldsw = (unsigned)wid * 1024u;
    const int aoff = lds_byte(wr * 64 + fr, fq * 8), boff = lds_byte(wc * 32 + fr, fq * 8);
#define PG8_SA(b, h) (((b) * 2 + (h)) * HTB)
#define PG8_SB(b, h) ((4 + (b) * 2 + (h)) * HTB)
#define PG8_STAGE(bufoff, gbase, voff) do { _Pragma("unroll") for (int _i = 0; _i < 2; ++_i) \
        __builtin_amdgcn_global_load_lds((const unsigned*)((const char*)(gbase) + (voff)[_i]), (PG8_LAS unsigned*)(lds + (bufoff) + ldsw + _i * 8192), 16, 0, 0); } while (0)
#define PG8_LDA(dst, b, h) do { _Pragma("unroll") for (int m = 0; m < 4; ++m) _Pragma("unroll") for (int k = 0; k < 2; ++k) dst[m][k] = *(const PG8_LAS bf16x8*)(lds + PG8_SA(b, h) + aoff + m * 2048 + k * 1024); } while (0)
#define PG8_LDB(dst, b, h) do { _Pragma("unroll") for (int n = 0; n < 2; ++n) _Pragma("unroll") for (int k = 0; k < 2; ++k) dst[n][k] = *(const PG8_LAS bf16x8*)(lds + PG8_SB(b, h) + boff + n * 2048 + k * 1024); } while (0)
#define PG8_MMA(ai, bj, At, Bt) do { __builtin_amdgcn_s_setprio(1); _Pragma("unroll") for (int m = 0; m < 4; ++m) _Pragma("unroll") for (int n = 0; n < 2; ++n) _Pragma("unroll") for (int k = 0; k < 2; ++k) \
        acc[ai][bj][m][n] = __builtin_amdgcn_mfma_f32_16x16x32_bf16(Bt[n][k], At[m][k], acc[ai][bj][m][n], 0, 0, 0); __builtin_amdgcn_s_setprio(0); } while (0)
#define PG8_WAIT_V(n) asm volatile("s_waitcnt vmcnt(" #n ")" ::: "memory")
#define PG8_WAIT_L(n) asm volatile("s_waitcnt lgkmcnt(" #n ")" ::: "memory")
#define PG8_BAR __builtin_amdgcn_s_barrier()
#define PG8_SCHED __builtin_amdgcn_sched_barrier(0)
    Unit cur, nxt; int ui = 0;
    if (!S.next(0, cur)) return;
    f32x4 acc[2][2][4][2];
#pragma unroll
    for (int a = 0; a < 2; ++a)
#pragma unroll
        for (int b = 0; b < 2; ++b)
#pragma unroll
            for (int m = 0; m < 4; ++m)
#pragma unroll
                for (int n = 0; n < 2; ++n) acc[a][b][m][n] = (f32x4){0.f, 0.f, 0.f, 0.f};
    bf16x8 At[4][2], B0[2][2], B1[2][2];
    const char* cA = (const char*)g.A + (size_t)cur.pm * tstep; const char* cB = (const char*)g.Bt + (size_t)cur.pn * tstep;
    S.a_ready(cur);
    if constexpr (SP2) {
        PG8_STAGE(PG8_SB(0, 0), cB, voffB); PG8_STAGE(PG8_SB(0, 1), cB + hstep, voffB); PG8_STAGE(PG8_SA(0, 0), cA, voffA); PG8_STAGE(PG8_SA(0, 1), cA + hstep, voffA);
        if (wr == 1) PG8_BAR;
        PG8_WAIT_V(2); PG8_BAR;
        PG8_STAGE(PG8_SB(1, 0), cB + kstep, voffB); PG8_STAGE(PG8_SA(1, 0), cA + kstep, voffA); PG8_STAGE(PG8_SB(1, 1), cB + hstep + kstep, voffB);
        PG8_WAIT_V(6); PG8_BAR;
    } else {
        PG8_STAGE(PG8_SB(0, 0), cB, voffB); PG8_STAGE(PG8_SA(0, 0), cA, voffA); PG8_STAGE(PG8_SB(0, 1), cB + hstep, voffB); PG8_STAGE(PG8_SA(0, 1), cA + hstep, voffA);
        if (wr == 1) PG8_BAR;
        PG8_WAIT_V(4); PG8_BAR;
        PG8_STAGE(PG8_SB(1, 0), cB + kstep, voffB); PG8_STAGE(PG8_SA(1, 0), cA + kstep, voffA); PG8_STAGE(PG8_SB(1, 1), cB + hstep + kstep, voffB);
        PG8_WAIT_V(6); PG8_BAR;
    }
    for (;;) {
        const bool has_next = S.next(ui + 1, nxt);
        const char* nA = has_next ? (const char*)g.A + (size_t)nxt.pm * tstep : cA; const char* nB = has_next ? (const char*)g.Bt + (size_t)nxt.pn * tstep : cB;
        for (int t = 0; t < nt; t += 2) {
            const bool last = (t == nt - 2);
            const char* a1 = cA + (size_t)(t + 1) * kstep;
            const char* a2 = last ? nA : cA + (size_t)(t + 2) * kstep; const char* b2 = last ? nB : cB + (size_t)(t + 2) * kstep;
            const char* a3 = a2 + kstep; const char* b3 = b2 + kstep;
            if (last && has_next) S.a_ready(nxt);
            if constexpr (SP2) {
            PG8_LDB(B0, 0, 0); PG8_LDB(B1, 0, 1); PG8_SCHED; PG8_LDA(At, 0, 0); PG8_STAGE(PG8_SA(1, 1), a1 + hstep, voffA);
            PG8_WAIT_V(8); PG8_WAIT_L(0); PG8_BAR; PG8_MMA(0, 0, At, B0); PG8_MMA(0, 1, At, B1); PG8_BAR; PG8_SCHED;
            PG8_LDA(At, 0, 1); PG8_STAGE(PG8_SB(0, 0), b2, voffB); PG8_STAGE(PG8_SB(0, 1), b2 + hstep, voffB); PG8_STAGE(PG8_SA(0, 0), a2, voffA);
            PG8_WAIT_V(8); PG8_WAIT_L(0); PG8_BAR; PG8_MMA(1, 0, At, B0); PG8_MMA(1, 1, At, B1); PG8_BAR; PG8_SCHED;
            PG8_LDB(B0, 1, 0); PG8_LDB(B1, 1, 1); PG8_SCHED; PG8_LDA(At, 1, 0); PG8_STAGE(PG8_SA(0, 1), a2 + hstep, voffA);
            PG8_WAIT_V(8); PG8_WAIT_L(0); PG8_BAR; PG8_MMA(0, 0, At, B0); PG8_MMA(0, 1, At, B1); PG8_BAR; PG8_SCHED;
            PG8_LDA(At, 1, 1); PG8_STAGE(PG8_SB(1, 0), b3, voffB); PG8_STAGE(PG8_SB(1, 1), b3 + hstep, voffB); PG8_STAGE(PG8_SA(1, 0), a3, voffA);
            PG8_WAIT_V(8); PG8_WAIT_L(0); PG8_BAR; PG8_MMA(1, 0, At, B0); PG8_MMA(1, 1, At, B1); PG8_BAR; PG8_SCHED;
            } else {
            PG8_LDB(B0, 0, 0); PG8_SCHED; PG8_LDA(At, 0, 0); PG8_STAGE(PG8_SA(1, 1), a1 + hstep, voffA);
            PG8_WAIT_L(8); PG8_BAR; PG8_WAIT_L(0); PG8_MMA(0, 0, At, B0); PG8_BAR; PG8_SCHED;
            PG8_LDB(B1, 0, 1); PG8_STAGE(PG8_SB(0, 0), b2, voffB);
            PG8_BAR; PG8_WAIT_L(0); PG8_MMA(0, 1, At, B1); PG8_BAR;
            PG8_LDA(At, 0, 1); PG8_STAGE(PG8_SA(0, 0), a2, voffA);
            PG8_BAR; PG8_WAIT_L(0); PG8_MMA(1, 0, At, B0); PG8_BAR; PG8_SCHED;
            PG8_STAGE(PG8_SB(0, 1), b2 + hstep, voffB);
            PG8_WAIT_V(6); PG8_BAR; PG8_MMA(1, 1, At, B1); PG8_BAR;
            PG8_LDB(B0, 1, 0); PG8_SCHED; PG8_LDA(At, 1, 0); PG8_STAGE(PG8_SA(0, 1), a2 + hstep, voffA);
            PG8_WAIT_L(8); PG8_BAR; PG8_WAIT_L(0); PG8_MMA(0, 0, At, B0); PG8_BAR; PG8_SCHED;
            PG8_LDB(B1, 1, 1); PG8_STAGE(PG8_SB(1, 0), b3, voffB);
            PG8_BAR; PG8_WAIT_L(0); PG8_MMA(0, 1, At, B1); PG8_BAR;
            PG8_LDA(At, 1, 1); PG8_STAGE(PG8_SA(1, 0), a3, voffA);
            PG8_BAR; PG8_WAIT_L(0); PG8_MMA(1, 0, At, B0); PG8_BAR; PG8_SCHED;
            PG8_STAGE(PG8_SB(1, 1), b3 + hstep, voffB);
            PG8_WAIT_V(6); PG8_BAR; PG8_MMA(1, 1, At, B1); PG8_BAR;
            }
        }
        if constexpr (ALIGN_EPI) { if (wr == 0) PG8_BAR; }
        if constexpr (!Epi::AFTER_DRAIN) { E(acc, cur, wr, wc, fr, fq); S.done(cur); }
        if (!has_next) break;
#pragma unroll
        for (int a = 0; a < 2; ++a)
#pragma unroll
            for (int b = 0; b < 2; ++b)
#pragma unroll
                for (int m = 0; m < 4; ++m)
#pragma unroll
                    for (int n = 0; n < 2; ++n) acc[a][b][m][n] = (f32x4){0.f, 0.f, 0.f, 0.f};
        cur = nxt; cA = nA; cB = nB; ++ui;
        if constexpr (ALIGN_EPI) { if (wr == 1) PG8_BAR; }
    }
    PG8_WAIT_V(0);
    if constexpr (!ALIGN_EPI) { if (wr == 0) PG8_BAR; }
    PG8_BAR;
    if constexpr (Epi::AFTER_DRAIN) { E.fused(acc, cur, wr, wc, fr, fq, lds, wid, lane); S.done(cur); }
#undef PG8_SA
#undef PG8_SB
#undef PG8_STAGE
#undef PG8_LDA
#undef PG8_LDB
#undef PG8_MMA
#undef PG8_WAIT_V
#undef PG8_WAIT_L
#undef PG8_BAR
#undef PG8_SCHED
}
}

#include <hip/hip_cooperative_groups.h>
namespace cg = cooperative_groups;
using pg8::sigmoid_f; using pg8::bf_lo; using pg8::bf_hi;
#define LAS __attribute__((address_space(3)))
typedef unsigned short bf16;
typedef unsigned v4u __attribute__((ext_vector_type(4)));
typedef unsigned v2u __attribute__((ext_vector_type(2)));
typedef float f32x4 __attribute__((ext_vector_type(4)));
typedef float f32x2 __attribute__((ext_vector_type(2)));
typedef short bf16x8 __attribute__((ext_vector_type(8)));
typedef short v4i16_t __attribute__((ext_vector_type(4)));

constexpr int NWAVES = 8, NTHREADS = 512;
constexpr int SEQ = 4096, BATCH = 8, M = BATCH * SEQ, D = 1024, FF = 2816, NIN = 8704, AW = 1536, CW = 31;
constexpr float EPS = 1e-6f;
constexpr size_t MiB = 1u << 20;
constexpr size_t WS_CTL = 0;
constexpr size_t WS_WGU1 = 1 * MiB, WS_WD1 = 12 * MiB, WS_WGU2 = 18 * MiB, WS_WD2 = 29 * MiB, WS_WIN = 35 * MiB, WS_WC = 52 * MiB, WS_WA = 54 * MiB, WS_WO = 55 * MiB;
constexpr size_t WS_H = 58 * MiB;
constexpr size_t WS_ZC = 122 * MiB;
constexpr size_t WS_Q = 186 * MiB;
constexpr size_t WS_K = 282 * MiB;
constexpr size_t WS_V = 378 * MiB;
constexpr size_t WS_LSE = 474 * MiB;
constexpr size_t WS_ATT = 476 * MiB;
constexpr size_t WS_ZG = WS_K;
constexpr size_t WS_G = WS_K;
constexpr size_t WS_T1 = WS_K + 128 * MiB;
constexpr size_t WS_MIX = WS_H;
constexpr size_t WS_A1 = WS_Q;
constexpr size_t WS_END = 508 * MiB;
static_assert(WS_T1 + 64 * MiB <= WS_LSE && WS_A1 + (size_t)M * FF * 2 <= WS_LSE, "ws map");

constexpr int LDS_BYTES = 147456;

__device__ __forceinline__ float wave_sum(float v) {
#pragma unroll
    for (int o = 1; o < 64; o <<= 1) v += __shfl_xor(v, o);
    return v;
}
__device__ __forceinline__ unsigned pk2(float lo, float hi) { return pg8::cvt_pk_bf16(lo, hi); }

__device__ __forceinline__ int dst_row(int map, int n) {
    if (map == 3) { if (n < 1024) map = 1; else if (n < 2048) { map = 2; n -= 1024; } else map = 0; }
    if (map == 0) return n;
    return 256 * (n >> 7) + (n & 127) + (map == 2 ? 128 : 0);
}
__device__ __forceinline__ void transpose_item(const float* W, int K, int N, bf16* WT, int map, LAS float* scr, int item, int lane) {
    const int nblk = N / 32, kb = item / nblk, nb = item % nblk, k0 = 64 * kb, n0 = 32 * nb;
    float wv[32];
#pragma unroll
    for (int i = 0; i < 32; ++i) wv[i] = W[(size_t)(k0 + 2 * i + (lane >> 5)) * N + n0 + (lane & 31)];
#pragma unroll
    for (int i = 0; i < 32; ++i) scr[(2 * i + (lane >> 5)) * 33 + (lane & 31)] = wv[i];
    asm volatile("s_waitcnt lgkmcnt(0)" ::: "memory");
    const int c = lane & 7; const int r0 = dst_row(map, n0);
#pragma unroll
    for (int j = 0; j < 4; ++j) { const int n = (lane >> 3) + 8 * j; const LAS float* s = scr + (8 * c) * 33 + n;
        v4u o; o.x = pk2(s[0 * 33], s[1 * 33]); o.y = pk2(s[2 * 33], s[3 * 33]); o.z = pk2(s[4 * 33], s[5 * 33]); o.w = pk2(s[6 * 33], s[7 * 33]);
        *(v4u*)(WT + (size_t)(r0 + n) * K + k0 + 8 * c) = o; }
    asm volatile("s_waitcnt lgkmcnt(0)" ::: "memory");
}

template <bool OUT_BF16> __device__ __forceinline__ void rms_rows(const float* X, const float* gain, void* out, int gw, int NGW, int lane) {
    f32x4 gv[4];
#pragma unroll
    for (int j = 0; j < 4; ++j) gv[j] = ((const f32x4*)gain)[lane + 64 * j];
    for (int m0 = gw * 4; m0 < M; m0 += NGW * 4) {
        f32x4 v[4][4]; float s[4];
#pragma unroll
        for (int r = 0; r < 4; ++r) { const f32x4* xr = (const f32x4*)(X + (size_t)(m0 + r) * D) + lane;
#pragma unroll
            for (int j = 0; j < 4; ++j) v[r][j] = xr[64 * j]; }
#pragma unroll
        for (int r = 0; r < 4; ++r) { float a = 0.f;
#pragma unroll
            for (int j = 0; j < 4; ++j) a += (v[r][j].x * v[r][j].x + v[r][j].y * v[r][j].y) + (v[r][j].z * v[r][j].z + v[r][j].w * v[r][j].w);
            s[r] = a; }
#pragma unroll
        for (int o = 1; o < 64; o <<= 1) {
#pragma unroll
            for (int r = 0; r < 4; ++r) s[r] += __shfl_xor(s[r], o); }
#pragma unroll
        for (int r = 0; r < 4; ++r) { const float rstd = 1.0f / sqrtf(s[r] * (1.0f / D) + EPS);
            if (OUT_BF16) { v2u* o8 = (v2u*)((bf16*)out + (size_t)(m0 + r) * D) + lane;
#pragma unroll
                for (int j = 0; j < 4; ++j) { v2u w; w.x = pk2(v[r][j].x * rstd * gv[j].x, v[r][j].y * rstd * gv[j].y); w.y = pk2(v[r][j].z * rstd * gv[j].z, v[r][j].w * rstd * gv[j].w); o8[64 * j] = w; }
            } else { f32x4* o = (f32x4*)((float*)out + (size_t)(m0 + r) * D) + lane;
#pragma unroll
                for (int j = 0; j < 4; ++j) o[64 * j] = v[r][j] * rstd * gv[j]; } }
    }
}

constexpr int CT = 16;
__device__ __forceinline__ void conv_phase(const bf16* Zg, const float* dwk, const float* dwb, const float* lng, const float* lnb, bf16* ZC, LAS float* red, int blk, int G) {
    const int tid = threadIdx.x, lane = tid & 63, wave = tid >> 6, c = 2 * tid;
    float w0[CW], w1[CW];
#pragma unroll
    for (int j = 0; j < CW; ++j) { const f32x2 t = *(const f32x2*)(dwk + j * D + c); w0[j] = t.x; w1[j] = t.y; }
    const f32x2 bb = *(const f32x2*)(dwb + c), gg = *(const f32x2*)(lng + c), lb = *(const f32x2*)(lnb + c);
    for (int tile = blk; tile < M / CT; tile += G) {
        const int t0 = tile * CT, s0 = t0 & (SEQ - 1);
        float z0[CT + CW - 1], z1[CT + CW - 1];
#pragma unroll
        for (int i = 0; i < CT + CW - 1; ++i) { const bool valid = (s0 + i - (CW - 1)) >= 0; unsigned pk = 0u;
            if (valid) pk = *(const unsigned*)(Zg + (size_t)(t0 + i - (CW - 1)) * D + c);
            z0[i] = bf_lo(pk); z1[i] = bf_hi(pk); }
        float o0[CT], o1[CT];
#pragma unroll
        for (int t = 0; t < CT; ++t) { float a0 = bb.x, a1 = bb.y;
#pragma unroll
            for (int j = 0; j < CW; ++j) { a0 += w0[j] * z0[t + j]; a1 += w1[j] * z1[t + j]; }
            o0[t] = a0; o1[t] = a1; }
#pragma unroll
        for (int t = 0; t < CT; ++t) { const float s1 = wave_sum(o0[t] + o1[t]), s2 = wave_sum(o0[t] * o0[t] + o1[t] * o1[t]);
            if (lane == 0) { red[(2 * t) * 8 + wave] = s1; red[(2 * t + 1) * 8 + wave] = s2; } }
        __syncthreads();
        unsigned* outp = (unsigned*)(ZC + (size_t)t0 * D + c);
#pragma unroll
        for (int t = 0; t < CT; ++t) {
            const f32x4 a = *(const LAS f32x4*)(red + (2 * t) * 8), b = *(const LAS f32x4*)(red + (2 * t) * 8 + 4);
            const f32x4 p = *(const LAS f32x4*)(red + (2 * t + 1) * 8), q = *(const LAS f32x4*)(red + (2 * t + 1) * 8 + 4);
            const float s1 = ((a.x + a.y) + (a.z + a.w)) + ((b.x + b.y) + (b.z + b.w)), s2 = ((p.x + p.y) + (p.z + p.w)) + ((q.x + q.y) + (q.z + q.w));
            const float mu = s1 * (1.0f / D); const float var = fmaxf(s2 * (1.0f / D) - mu * mu, 0.f); const float rstd = 1.0f / sqrtf(var + EPS);
            float y0 = (o0[t] - mu) * rstd * gg.x + lb.x, y1 = (o1[t] - mu) * rstd * gg.y + lb.y;
            y0 = y0 * sigmoid_f(y0); y1 = y1 * sigmoid_f(y1);
            outp[(size_t)t * (D / 2)] = pk2(y0, y1); }
        __syncthreads();
    }
}

constexpr int VROW = 272;
constexpr int ATT_UNITS = BATCH * 12 * 32;
__device__ __forceinline__ v4i16_t tr16(const LAS unsigned char* p) { return __builtin_amdgcn_ds_read_tr16_b64_v4i16((LAS v4i16_t*)p); }
struct AttnPre { v4u k[4], v[4]; bf16x8 q[4]; };
struct AttnIdx { size_t row0; int hg, dsh, n; };
__device__ __forceinline__ AttnIdx attn_decode(int unit) {
    AttnIdx x; const int bh = unit >> 5, j = unit & 31; x.hg = bh % 12; const int gi = x.hg >> 2;
    x.dsh = 2 * gi; const int nbsh = 5 - x.dsh;
    x.n = j & ((1 << nbsh) - 1);
    x.row0 = (size_t)bh * SEQ + (size_t)j * 128; return x;
}
constexpr int ATT_HB = 128 * VROW;
constexpr int ATT_KOFF = 0, ATT_VOFF = 2 * ATT_HB;
__device__ __forceinline__ void attn_load_kv(AttnPre& p, const bf16* K, const bf16* V, size_t r0, int tid) {
#pragma unroll
    for (int i = 0; i < 4; ++i) { const size_t off = r0 * 128 + (size_t)(tid + 512 * i) * 8; p.k[i] = *(const v4u*)(K + off); p.v[i] = *(const v4u*)(V + off); }
}
__device__ __forceinline__ void attn_load(AttnPre& p, const bf16* Q, const bf16* K, const bf16* V, int unit, int tid, int w, int lq, int g) {
    const AttnIdx x = attn_decode(unit);
    attn_load_kv(p, K, V, x.row0, tid);
#pragma unroll
    for (int s = 0; s < 4; ++s) p.q[s] = *(const bf16x8*)(Q + (x.row0 + 16 * w + lq) * 128 + 32 * s + 8 * g);
}
__device__ __forceinline__ void attn_stage(LAS unsigned char* lds, const AttnPre& p, int half, int tid) {
#pragma unroll
    for (int i = 0; i < 4; ++i) { const int cidx = tid + 512 * i, row = cidx >> 4, ch = cidx & 15;
        *(LAS v4u*)(lds + ATT_KOFF + half * ATT_HB + row * VROW + ch * 16) = p.k[i]; *(LAS v4u*)(lds + ATT_VOFF + half * ATT_HB + row * VROW + ch * 16) = p.v[i]; }
}
__device__ __forceinline__ void attn_compute(LAS unsigned char* lds, const bf16x8 (&qf)[4], bf16* O, float* LSE, int unit, int f, int lane, int w, int lq, int g) {
    const AttnIdx x = attn_decode(unit); const int hg = x.hg, n = x.n;
    int rowT[9];
#pragma unroll
    for (int T = 0; T < 9; ++T) { const int kk0 = 16 * w + 16 * T; rowT[T] = ((((kk0 >> 7) ^ f) & 1) << 7) + (kk0 & 127); }
    f32x4 st[9];
    const LAS unsigned char* kb = lds + ATT_KOFF + lq * VROW + 16 * g;
#pragma unroll
    for (int T = 0; T < 9; ++T) { f32x4 a = (f32x4){0.f, 0.f, 0.f, 0.f}; const LAS unsigned char* kp = kb + rowT[T] * VROW;
#pragma unroll
        for (int s = 0; s < 4; ++s) { const bf16x8 kf = *(const LAS bf16x8*)(kp + 64 * s); a = __builtin_amdgcn_mfma_f32_16x16x32_bf16(kf, qf[s], a, 0, 0, 0); }
        st[T] = a; }
    const float slope2 = __builtin_amdgcn_exp2f(-(float)(8 * (hg + 1)) * (1.0f / 12.0f)) * (float)(1 << x.dsh) * 1.4426950408889634f;
    float mx = -__builtin_inff();
#pragma unroll
    for (int T = 0; T < 9; ++T)
#pragma unroll
        for (int reg = 0; reg < 4; ++reg) { const int steps = 128 + lq - 16 * T - 4 * g - reg, ki = 16 * w + 16 * T + 4 * g + reg;
            const bool valid = (steps >= 0) && (steps <= 128) && (n > 0 || ki >= 128);
            const float v = valid ? st[T][reg] - slope2 * (float)steps : -__builtin_inff(); st[T][reg] = v; mx = fmaxf(mx, v); }
    mx = fmaxf(mx, __shfl_xor(mx, 16)); mx = fmaxf(mx, __shfl_xor(mx, 32));
    float sum = 0.f;
#pragma unroll
    for (int T = 0; T < 9; ++T)
#pragma unroll
        for (int reg = 0; reg < 4; ++reg) { const float p = __builtin_amdgcn_exp2f(st[T][reg] - mx); st[T][reg] = p; sum += p; }
    sum += __shfl_xor(sum, 16); sum += __shfl_xor(sum, 32);
    bf16x8 pf[5];
#pragma unroll
    for (int u = 0; u < 5; ++u) { v4u t; t.x = pk2(st[2 * u][0], st[2 * u][1]); t.y = pk2(st[2 * u][2], st[2 * u][3]);
        if (u < 4) { t.z = pk2(st[2 * u + 1][0], st[2 * u + 1][1]); t.w = pk2(st[2 * u + 1][2], st[2 * u + 1][3]); } else { t.z = 0u; t.w = 0u; }
        pf[u] = __builtin_bit_cast(bf16x8, t); }
    const LAS unsigned char* vb = lds + ATT_VOFF + (4 * g + ((lane & 15) >> 2)) * VROW + (lane & 3) * 16;
    f32x4 o[4][2];
#pragma unroll
    for (int cp = 0; cp < 4; ++cp) { o[cp][0] = (f32x4){0.f, 0.f, 0.f, 0.f}; o[cp][1] = (f32x4){0.f, 0.f, 0.f, 0.f}; }
#pragma unroll
    for (int u = 0; u < 5; ++u) { const LAS unsigned char* vlo = vb + rowT[2 * u] * VROW; const LAS unsigned char* vhi = vb + rowT[u < 4 ? 2 * u + 1 : 8] * VROW;
#pragma unroll
        for (int cp = 0; cp < 4; ++cp)
#pragma unroll
            for (int h2 = 0; h2 < 2; ++h2) {
                const v4i16_t lo = tr16(vlo + cp * 64 + h2 * 8), hi = tr16(vhi + cp * 64 + h2 * 8);
                const bf16x8 vf = (bf16x8){lo[0], lo[1], lo[2], lo[3], hi[0], hi[1], hi[2], hi[3]};
                o[cp][h2] = __builtin_amdgcn_mfma_f32_16x16x32_bf16(vf, pf[u], o[cp][h2], 0, 0, 0); } }
    const float inv = 1.0f / sum;
    const size_t rq = x.row0 + 16 * w + lq;
    bf16* op = O + rq * 128 + 8 * g;
#pragma unroll
    for (int cp = 0; cp < 4; ++cp) { const f32x4 a = o[cp][0] * inv, c = o[cp][1] * inv;
        v4u t; t.x = pk2(a[0], a[1]); t.y = pk2(a[2], a[3]); t.z = pk2(c[0], c[1]); t.w = pk2(c[2], c[3]);
        *(v4u*)(op + 32 * cp) = t; }
    if (g == 0) LSE[rq] = mx + __builtin_amdgcn_logf(sum);
}
__device__ __forceinline__ void attn_phase(LAS unsigned char* lds, const bf16* Q, const bf16* K, const bf16* V, bf16* O, float* LSE, int vcu, int G) {
    const int tid = threadIdx.x, lane = tid & 63, w = __builtin_amdgcn_readfirstlane(tid >> 6), lq = lane & 15, g = lane >> 4;
    const int upb = (ATT_UNITS + G - 1) / G; const int u0 = vcu * upb; int u1 = u0 + upb; if (u1 > ATT_UNITS) u1 = ATT_UNITS;
    if (u0 >= u1) return;
    for (int i = tid; i < 4 * ATT_HB / 16; i += NTHREADS) ((LAS v4u*)lds)[i] = (v4u){0u, 0u, 0u, 0u};
    __syncthreads();
    AttnPre pre; int f = 0;
    { const AttnIdx x0 = attn_decode(u0); if (x0.n > 0) { attn_load_kv(pre, K, V, x0.row0 - 128, tid); attn_stage(lds, pre, f, tid); } }
    attn_load(pre, Q, K, V, u0, tid, w, lq, g);
    for (int u = u0; u < u1; ++u) {
        bf16x8 qf[4];
#pragma unroll
        for (int s = 0; s < 4; ++s) qf[s] = pre.q[s];
        attn_stage(lds, pre, f ^ 1, tid);
        __syncthreads();
        if (u + 1 < u1) attn_load(pre, Q, K, V, u + 1, tid, w, lq, g);
        attn_compute(lds, qf, O, LSE, u, f, lane, w, lq, g);
        __syncthreads();
        f ^= 1;
    }
}

__device__ __forceinline__ void merge_rows(const bf16* OG, const float* LSE, bf16* ATT, int gw, int NGW, int lane) {
    const int hh = lane >> 4, c0 = (lane & 15) * 8;
    for (int m0 = gw * 4; m0 < M; m0 += NGW * 4) {
        float l[4][3]; v4u a[4][3];
#pragma unroll
        for (int r = 0; r < 4; ++r) { const int m = m0 + r, b = m >> 12, s = m & 4095;
#pragma unroll
            for (int gi = 0; gi < 3; ++gi) { const int dsh = 2 * gi; const int pos = ((s & ((1 << dsh) - 1)) << (12 - dsh)) + (s >> dsh);
                const size_t row = (size_t)(b * 12 + gi * 4 + hh) * 4096 + pos; l[r][gi] = LSE[row]; a[r][gi] = *(const v4u*)(OG + row * 128 + c0); } }
#pragma unroll
        for (int r = 0; r < 4; ++r) {
            const float mx = fmaxf(l[r][0], fmaxf(l[r][1], l[r][2]));
            float e0 = __builtin_amdgcn_exp2f(l[r][0] - mx), e1 = __builtin_amdgcn_exp2f(l[r][1] - mx), e2 = __builtin_amdgcn_exp2f(l[r][2] - mx);
            const float inv = 1.0f / (e0 + e1 + e2); e0 *= inv; e1 *= inv; e2 *= inv;
            const v4u A = a[r][0], B = a[r][1], C = a[r][2]; v4u o;
            o.x = pk2(e0 * bf_lo(A.x) + e1 * bf_lo(B.x) + e2 * bf_lo(C.x), e0 * bf_hi(A.x) + e1 * bf_hi(B.x) + e2 * bf_hi(C.x));
            o.y = pk2(e0 * bf_lo(A.y) + e1 * bf_lo(B.y) + e2 * bf_lo(C.y), e0 * bf_hi(A.y) + e1 * bf_hi(B.y) + e2 * bf_hi(C.y));
            o.z = pk2(e0 * bf_lo(A.z) + e1 * bf_lo(B.z) + e2 * bf_lo(C.z), e0 * bf_hi(A.z) + e1 * bf_hi(B.z) + e2 * bf_hi(C.z));
            o.w = pk2(e0 * bf_lo(A.w) + e1 * bf_lo(B.w) + e2 * bf_lo(C.w), e0 * bf_hi(A.w) + e1 * bf_hi(B.w) + e2 * bf_hi(C.w));
            *(v4u*)(ATT + (size_t)(m0 + r) * 512 + hh * 128 + c0) = o; }
    }
}

#define XB_TMO      128
#define XB_XCNT(j)  (256  + 64 * (j))
#define XB_XSUB(j)  (1280 + 64 * (j))
#define XB_XGEN(j)  (2304 + 64 * (j))
#define XB_TOP      3328
#define XB_TOPGEN   3392
#define XCD_BAR_WORDS 3456
#define XB_SPIN_CAP (1u << 18)

__device__ __forceinline__ unsigned xb_ld(unsigned* p)              { return __hip_atomic_load(p, __ATOMIC_RELAXED, __HIP_MEMORY_SCOPE_AGENT); }
__device__ __forceinline__ unsigned xb_add(unsigned* p, unsigned v) { return __hip_atomic_fetch_add(p, v, __ATOMIC_RELAXED, __HIP_MEMORY_SCOPE_AGENT); }
__device__ __forceinline__ unsigned xb_xcc_id() { return (unsigned)__builtin_amdgcn_s_getreg((3 << 11) | 20) & 0xFu; }
#define XB_SPIN(cond, bar) do { unsigned _sp = 0; while (cond) { __builtin_amdgcn_s_sleep(1); \
    if ((++_sp & 255u) == 0u) { if (xb_ld(&(bar)[XB_TMO])) break; if (_sp > XB_SPIN_CAP) { atomicAdd(&(bar)[XB_TMO], 1u); break; } } } } while (0)

struct XcdBarrier {
    unsigned* bar; unsigned x;
    volatile LAS unsigned* st;
};

__device__ __forceinline__ XcdBarrier xcd_barrier_post(unsigned* bar, volatile LAS unsigned* st) {
    XcdBarrier b; b.bar = bar; b.x = xb_xcc_id(); b.st = st;
    if (threadIdx.x == 0) (void)xb_add(&bar[XB_XCNT(b.x)], 1u);
    return b;
}
__device__ __forceinline__ void xcd_barrier_complete(unsigned* bar, unsigned x, unsigned& nloc, unsigned& nx) {
    const unsigned G = gridDim.x * gridDim.y * gridDim.z;
    unsigned sum, cnt, mine, sp = 0u;
    for (;;) {
        sum = 0u; cnt = 0u; mine = 0u;
#pragma unroll
        for (unsigned j = 0; j < 16; ++j) { const unsigned c = xb_ld(&bar[XB_XCNT(j)]); sum += c; cnt += (c > 0u) ? 1u : 0u; mine = (j == x) ? c : mine; }
        if (sum == G) break;
        __builtin_amdgcn_s_sleep(1);
        if ((++sp & 255u) == 0u) { if (xb_ld(&bar[XB_TMO])) break; if (sp > XB_SPIN_CAP) { atomicAdd(&bar[XB_TMO], 1u); break; } }
    }
    nloc = mine > 0u ? mine : 1u; nx = cnt > 0u ? cnt : 1u;
}

__device__ __forceinline__ void xcd_barrier(const XcdBarrier& b) {
    asm volatile("s_waitcnt vmcnt(0)" ::: "memory");
    __syncthreads();
    if (threadIdx.x == 0) {
        unsigned* bar = b.bar;
        __builtin_amdgcn_s_waitcnt(0);
        unsigned nloc = b.st[0], nx = b.st[1];
        if (nloc == 0u) { xcd_barrier_complete(bar, b.x, nloc, nx); b.st[0] = nloc; b.st[1] = nx; }
        const unsigned old = xb_add(&bar[XB_XSUB(b.x)], 1u);
        const unsigned gen = old / nloc;
        if (old + 1u == (gen + 1u) * nloc) {
            __builtin_amdgcn_fence(__ATOMIC_RELEASE, "agent");
            asm volatile("s_waitcnt vmcnt(0)" ::: "memory");
            const unsigned og = xb_add(&bar[XB_TOP], 1u);
            const unsigned tg = og / nx;
            if (og + 1u == (tg + 1u) * nx) xb_add(&bar[XB_TOPGEN], 1u);
            else XB_SPIN(xb_ld(&bar[XB_TOPGEN]) == tg, bar);
            __builtin_amdgcn_fence(__ATOMIC_ACQUIRE, "agent");
            xb_add(&bar[XB_XGEN(b.x)], 1u);
            asm volatile("s_waitcnt vmcnt(0)" ::: "memory");
        } else {
            XB_SPIN(xb_ld(&bar[XB_XGEN(b.x)]) == gen, bar);
            __builtin_amdgcn_fence(__ATOMIC_ACQUIRE, "agent");
            asm volatile("s_waitcnt vmcnt(0)" ::: "memory");
        }
    }
    __syncthreads();
}

struct Args { const float* in[19]; float* out; unsigned char* ws; int ph_lo, ph_hi; };
#ifndef MK_MULTI
#define MK_MULTI 0
#endif
#if MK_MULTI
#define GRID_SYNC() do { } while (0)
#else
#ifndef MK_CG
#define MK_CG 0
#endif
#if MK_CG
#define GRID_SYNC() do { __threadfence(); cg::this_grid().sync(); } while (0)
#else
#define GRID_SYNC() xcd_barrier(xbar)
#endif
#endif

__global__ void __launch_bounds__(NTHREADS, 2) fwd_kernel(Args args) {
    extern __shared__ __attribute__((aligned(16))) unsigned char lds_raw[];
    LAS unsigned char* lds = (LAS unsigned char*)lds_raw;
    const int tid = threadIdx.x, lane = tid & 63, wave = __builtin_amdgcn_readfirstlane(tid >> 6);
    const int G = gridDim.x, bx = blockIdx.x; const int vcu = (G % 8 == 0) ? (bx % 8) * (G / 8) + bx / 8 : bx;
    const int gw = vcu * NWAVES + wave, NGW = G * NWAVES;
    unsigned char* ws = args.ws;
#if !MK_MULTI && !MK_CG
    volatile LAS unsigned* xst = (volatile LAS unsigned*)(lds + LDS_BYTES - 128);
    if (tid < 2) xst[tid] = 0u;
    __syncthreads();
    XcdBarrier xbar = xcd_barrier_post((unsigned*)(ws + WS_CTL), xst);
#endif
    const float* x = args.in[0];
    float* X = args.out;
    bf16* Wgu1 = (bf16*)(ws + WS_WGU1); bf16* Wd1 = (bf16*)(ws + WS_WD1); bf16* Wgu2 = (bf16*)(ws + WS_WGU2); bf16* Wd2 = (bf16*)(ws + WS_WD2);
    bf16* Win = (bf16*)(ws + WS_WIN); bf16* Wc = (bf16*)(ws + WS_WC); bf16* Wa = (bf16*)(ws + WS_WA); bf16* Wo = (bf16*)(ws + WS_WO);
    bf16* H = (bf16*)(ws + WS_H); bf16* ZC = (bf16*)(ws + WS_ZC); bf16* Qb = (bf16*)(ws + WS_Q); bf16* Kb = (bf16*)(ws + WS_K); bf16* Vb = (bf16*)(ws + WS_V);
    float* LSE = (float*)(ws + WS_LSE); bf16* ATT = (bf16*)(ws + WS_ATT); bf16* ZG = (bf16*)(ws + WS_ZG); bf16* GT = (bf16*)(ws + WS_G);
    bf16* T1 = (bf16*)(ws + WS_T1); bf16* MIX = (bf16*)(ws + WS_MIX); bf16* A1 = (bf16*)(ws + WS_A1);
    const int lo = args.ph_lo, hi = args.ph_hi;
#define IN(k) (lo <= (k) && (k) < hi)
#define SEAM(k) do { if (IN(k) && IN((k) + 1)) GRID_SYNC(); } while (0)
#define GEMM_PHASE(EPI, Aptr, Bptr, Nn, Kk, ...) do { pg8::Gemm g_{Aptr, Bptr, M, Nn, Kk}; pg8::StaticOrder S_; S_.init(M, Nn, G, bx); EPI E_{__VA_ARGS__}; \
        pg8::gemm_phase<EPI, pg8::StaticOrder, true, true>(lds, g_, S_, E_); } while (0)

    if (IN(0)) {
        LAS float* scr = (LAS float*)(lds + wave * 16384);
        constexpr int I_GU = 16 * 88, I_DN = 44 * 32, I_IN = 16 * 272, I_C = 16 * 32, I_A = 8 * 32;
        constexpr int NITEMS = 6 * I_GU + I_IN + 2 * I_C + I_A;
        static_assert(I_DN == I_GU, "items");
        for (int it = gw; it < NITEMS; it += NGW) {
            int r = it;
            if (r < I_GU) { transpose_item(args.in[2], D, FF, Wgu1, 1, scr, r, lane); continue; } r -= I_GU;
            if (r < I_GU) { transpose_item(args.in[3], D, FF, Wgu1, 2, scr, r, lane); continue; } r -= I_GU;
            if (r < I_GU) { transpose_item(args.in[4], FF, D, Wd1, 0, scr, r, lane); continue; } r -= I_GU;
            if (r < I_GU) { transpose_item(args.in[15], D, FF, Wgu2, 1, scr, r, lane); continue; } r -= I_GU;
            if (r < I_GU) { transpose_item(args.in[16], D, FF, Wgu2, 2, scr, r, lane); continue; } r -= I_GU;
            if (r < I_GU) { transpose_item(args.in[17], FF, D, Wd2, 0, scr, r, lane); continue; } r -= I_GU;
            if (r < I_IN) { transpose_item(args.in[6], D, NIN, Win, 3, scr, r, lane); continue; } r -= I_IN;
            if (r < I_C) { transpose_item(args.in[11], D, D, Wc, 0, scr, r, lane); continue; } r -= I_C;
            if (r < I_A) { transpose_item(args.in[12], 512, D, Wa, 0, scr, r, lane); continue; } r -= I_A;
            transpose_item(args.in[13], D, D, Wo, 0, scr, r, lane);
        }
        rms_rows<true>(x, args.in[1], H, gw, NGW, lane);
        __syncthreads();
    }
    SEAM(0);
    if (IN(1)) GEMM_PHASE(pg8::EpiPair<0>, H, Wgu1, 2 * FF, D, A1, FF);
    SEAM(1);
    if (IN(2)) GEMM_PHASE(pg8::EpiResid, A1, Wd1, D, FF, x, X, D, 0.5f);
    SEAM(2);
    if (IN(3)) rms_rows<true>(X, args.in[5], H, gw, NGW, lane);
    SEAM(3);
    if (IN(4)) GEMM_PHASE(pg8::EpiPair<1>, H, Win, 2048, D, ZG, D);
    SEAM(4);
    if (IN(5)) conv_phase(ZG, args.in[7], args.in[8], args.in[9], args.in[10], ZC, (LAS float*)lds, bx, G);
    SEAM(5);
    if (IN(6)) GEMM_PHASE(pg8::EpiQKV, H, Win + (size_t)2048 * D, 3 * AW, D, Qb, (size_t)(WS_K - WS_Q) / 2, 0.08838834764831845f * 1.4426950408889634f);
    SEAM(6);
    if (IN(7)) attn_phase(lds, Qb, Kb, Vb, Qb, LSE, vcu, G);
    SEAM(7);
    if (IN(8)) { merge_rows(Qb, LSE, ATT, gw, NGW, lane); __syncthreads(); }
    if (IN(8)) GEMM_PHASE(pg8::EpiSig, H, Win + (size_t)6656 * D, 2048, D, GT, 2048);
    SEAM(8);
    if (IN(9)) GEMM_PHASE(pg8::EpiGate<false>, ZC, Wc, D, D, nullptr, GT, 2048, T1);
    SEAM(9);
    if (IN(10)) GEMM_PHASE(pg8::EpiGate<true>, ATT, Wa, D, 512, T1, GT + 1024, 2048, MIX);
    SEAM(10);
    if (IN(11)) GEMM_PHASE(pg8::EpiResid, MIX, Wo, D, D, X, X, D, 1.0f);
    SEAM(11);
    if (IN(12)) rms_rows<true>(X, args.in[14], H, gw, NGW, lane);
    SEAM(12);
    if (IN(13)) GEMM_PHASE(pg8::EpiPair<0>, H, Wgu2, 2 * FF, D, A1, FF);
    SEAM(13);
    if (IN(14)) GEMM_PHASE(pg8::EpiResid, A1, Wd2, D, FF, X, X, D, 0.5f);
    SEAM(14);
    if (IN(15)) rms_rows<false>(X, args.in[18], X, gw, NGW, lane);
#undef IN
#undef SEAM
}
constexpr int NPHASES = 16;

extern "C" void kernel_launch(void* const* d_in, const int* in_sizes, int n_in, void* d_out, int out_size, void* d_ws, size_t ws_size, hipStream_t stream) {
    static int grid = 0;
    if (grid == 0) {
        if (n_in != 19 || out_size != M * D || ws_size < WS_END) { fprintf(stderr, "kernel_launch: unexpected shapes (n_in %d out %d ws %zu)\n", n_in, out_size, ws_size); grid = -1; return; }
        int dev = 0, cus = 0, per_cu = 0;
        hipGetDevice(&dev); hipDeviceGetAttribute(&cus, hipDeviceAttributeMultiprocessorCount, dev);
        if (hipFuncSetAttribute((const void*)fwd_kernel, hipFuncAttributeMaxDynamicSharedMemorySize, LDS_BYTES) != hipSuccess) { fprintf(stderr, "kernel_launch: hipFuncSetAttribute failed\n"); grid = -1; return; }
        if (hipOccupancyMaxActiveBlocksPerMultiprocessor(&per_cu, (const void*)fwd_kernel, NTHREADS, LDS_BYTES) != hipSuccess || per_cu < 1) { fprintf(stderr, "kernel_launch: occupancy query says %d\n", per_cu); per_cu = 1; }
        (void)hipGetLastError();
        if (per_cu > 1) per_cu = 1;
        grid = cus * per_cu;
    }
    if (grid < 0) return;
    Args a{};
    for (int i = 0; i < 19; ++i) a.in[i] = (const float*)d_in[i];
    a.out = (float*)d_out; a.ws = (unsigned char*)d_ws;
#if MK_MULTI
    for (int p = 0; p < NPHASES; ++p) { a.ph_lo = p; a.ph_hi = p + 1; hipLaunchKernelGGL(fwd_kernel, dim3(grid), dim3(NTHREADS), LDS_BYTES, stream, a); }
#else
    a.ph_lo = 0; a.ph_hi = NPHASES;
#if MK_CG
    void* kargs[] = {&a};
    hipError_t e = hipLaunchCooperativeKernel((const void*)fwd_kernel, dim3(grid), dim3(NTHREADS), kargs, LDS_BYTES, stream);
    if (e != hipSuccess) fprintf(stderr, "cooperative launch failed: %s (grid %d)\n", hipGetErrorString(e), grid);
#else
    if (hipMemsetAsync((char*)d_ws + WS_CTL, 0, 65536, stream) != hipSuccess) { fprintf(stderr, "kernel_launch: memset failed\n"); return; }
    hipLaunchKernelGGL(fwd_kernel, dim3(grid), dim3(NTHREADS), LDS_BYTES, stream, a);
#endif
#endif
}
```

```cpp
#include <hip/hip_runtime.h>
#include <cstdio>
#include <cstdint>
namespace pg8 {
#define PG8_LAS __attribute__((address_space(3)))
typedef unsigned short bf16_t;
typedef short bf16x8 __attribute__((ext_vector_type(8)));
typedef float f32x4 __attribute__((ext_vector_type(4)));
typedef unsigned u32x4 __attribute__((ext_vector_type(4)));
constexpr int BM = 256, BK = 64, HALF = 128, HTB = HALF * BK * 2  , STAGE_BYTES = 8 * HTB, NXCD = 8, WGM = 8;

__host__ __device__ __forceinline__ int lds_byte(int r, int c) { const int st = (r >> 4) * 2 + (c >> 5), rr = r & 15, cc = c & 31, ob = rr * 64 + cc * 2; return st * 1024 + (ob ^ (((ob >> 9) & 1) << 5)); }
__host__ __device__ __forceinline__ void stage_rc(int b, int& R, int& C) { const int st = b / 1024, sb = b % 1024, swz = sb ^ (((sb >> 9) & 1) << 5); R = (st >> 1) * 16 + swz / 64; C = (st & 1) * 32 + (swz % 64) / 2; }
__host__ __device__ __forceinline__ int perm32(int rho) { const int n = rho >> 4, i = rho & 15; return 8 * (i >> 2) + 4 * n + (i & 3); }

struct Unit { int pm, pn; };
struct Gemm { const bf16_t* A; const bf16_t* Bt; int M, N, K; };

struct StaticOrder {
    int nM, nN, nwg, G, c;
    __host__ __device__ void init(int M, int N, int G_, int c_) { nM = M / BM; nN = N / BM; nwg = nM * nN; G = G_; c = c_; }
    __host__ __device__ bool next(int i, Unit& u) const {
        const long L = (long)i * G + c; if (L >= nwg) return false;
        int wgid = (int)L; { const int q = nwg / NXCD, r = nwg % NXCD, xcd = wgid % NXCD, off = wgid / NXCD; wgid = (xcd < r ? xcd * (q + 1) : r * (q + 1) + (xcd - r) * q) + off; }
        const int nig = WGM * nN, gid = wgid / nig, fm = gid * WGM, gsz = (nM - fm) < WGM ? (nM - fm) : WGM;
        u.pm = fm + ((wgid % nig) % gsz); u.pn = (wgid % nig) / gsz; return true;
    }
    __device__ __forceinline__ void a_ready(const Unit&) const {}
    __device__ __forceinline__ void done(const Unit&) const {}
};

typedef float f32x2_t __attribute__((ext_vector_type(2))); typedef __bf16 bf16x2_t __attribute__((ext_vector_type(2)));
__device__ __forceinline__ unsigned cvt_pk_bf16(float lo, float hi) { const f32x2_t v = {lo, hi}; const bf16x2_t b = __builtin_convertvector(v, bf16x2_t); return __builtin_bit_cast(unsigned, b); }
typedef float f32x2 __attribute__((ext_vector_type(2)));
__device__ __forceinline__ float sigmoid_f(float x) { return __builtin_amdgcn_rcpf(1.0f + __builtin_amdgcn_exp2f(-1.4426950408889634f * x)); }
__device__ __forceinline__ float bf_lo(unsigned u) { return __uint_as_float(u << 16); }
__device__ __forceinline__ float bf_hi(unsigned u) { return __uint_as_float(u & 0xffff0000u); }

template <int ACT> struct EpiPair {
    static constexpr bool PERM = true, AFTER_DRAIN = false;
    bf16_t* O; int ldo;
    __device__ __forceinline__ void operator()(const f32x4 (&acc)[2][2][4][2], const Unit& u, int wr, int wc, int fr, int fq) const {
        const int row0 = u.pm * BM + wr * 64 + fr, col0 = u.pn * HALF + wc * 32 + 8 * fq;
#pragma unroll
        for (int ai = 0; ai < 2; ++ai)
#pragma unroll
            for (int m = 0; m < 4; ++m) {
                float v[8];
#pragma unroll
                for (int n = 0; n < 2; ++n)
#pragma unroll
                    for (int i = 0; i < 4; ++i) { const float a = acc[ai][0][m][n][i], b = acc[ai][1][m][n][i];
                        v[n * 4 + i] = (ACT == 0) ? a * sigmoid_f(a) * b : a * sigmoid_f(b); }
                u32x4 w; w.x = cvt_pk_bf16(v[0], v[1]); w.y = cvt_pk_bf16(v[2], v[3]); w.z = cvt_pk_bf16(v[4], v[5]); w.w = cvt_pk_bf16(v[6], v[7]);
                *(u32x4*)(O + (size_t)(row0 + ai * HALF + m * 16) * ldo + col0) = w; }
    }
};
struct EpiResid {
    static constexpr bool PERM = true, AFTER_DRAIN = false;
    const float* base; float* out; int ldo; float alpha;
    __device__ __forceinline__ void operator()(const f32x4 (&acc)[2][2][4][2], const Unit& u, int wr, int wc, int fr, int fq) const {
        const int row0 = u.pm * BM + wr * 64 + fr, col0 = u.pn * BM + wc * 32 + 8 * fq;
#pragma unroll
        for (int ai = 0; ai < 2; ++ai)
#pragma unroll
            for (int m = 0; m < 4; ++m) { const size_t off = (size_t)(row0 + ai * HALF + m * 16) * ldo + col0;
#pragma unroll
                for (int bj = 0; bj < 2; ++bj)
#pragma unroll
                    for (int n = 0; n < 2; ++n) { const f32x4 bs = *(const f32x4*)(base + off + bj * HALF + 4 * n);
                        *(f32x4*)(out + off + bj * HALF + 4 * n) = bs + acc[ai][bj][m][n] * alpha; } }
    }
};
struct EpiQKV {
    static constexpr bool PERM = true, AFTER_DRAIN = false;
    bf16_t* O; size_t tstride; float qscale;
    __device__ __forceinline__ void operator()(const f32x4 (&acc)[2][2][4][2], const Unit& u, int wr, int wc, int fr, int fq) const {
        const int row0 = u.pm * BM + wr * 64 + fr; const int t = u.pn / 6, ct = u.pn - 6 * t, dsh = 2 * (ct >> 1);
        bf16_t* base = O + (size_t)t * tstride + wc * 32 + 8 * fq; const float sc = (t == 0) ? qscale : 1.0f;
#pragma unroll
        for (int ai = 0; ai < 2; ++ai)
#pragma unroll
            for (int m = 0; m < 4; ++m) { const int row = row0 + ai * HALF + m * 16, b = row >> 12, s = row & 4095;
                const int pos = ((s & ((1 << dsh) - 1)) << (12 - dsh)) + (s >> dsh);
#pragma unroll
                for (int bj = 0; bj < 2; ++bj) { const f32x4 v0 = acc[ai][bj][m][0] * sc, v1 = acc[ai][bj][m][1] * sc;
                    u32x4 w; w.x = cvt_pk_bf16(v0[0], v0[1]); w.y = cvt_pk_bf16(v0[2], v0[3]); w.z = cvt_pk_bf16(v1[0], v1[1]); w.w = cvt_pk_bf16(v1[2], v1[3]);
                    *(u32x4*)(base + ((size_t)((b * 12 + 2 * ct + bj) * 4096 + pos)) * 128) = w; } }
    }
};
struct EpiSig {
    static constexpr bool PERM = true, AFTER_DRAIN = false;
    bf16_t* O; int ldo;
    __device__ __forceinline__ void operator()(const f32x4 (&acc)[2][2][4][2], const Unit& u, int wr, int wc, int fr, int fq) const {
        const int row0 = u.pm * BM + wr * 64 + fr, col0 = u.pn * BM + wc * 32 + 8 * fq;
#pragma unroll
        for (int ai = 0; ai < 2; ++ai)
#pragma unroll
            for (int m = 0; m < 4; ++m) { bf16_t* rowp = O + (size_t)(row0 + ai * HALF + m * 16) * ldo + col0;
#pragma unroll
                for (int bj = 0; bj < 2; ++bj) { float v[8];
#pragma unroll
                    for (int n = 0; n < 2; ++n)
#pragma unroll
                        for (int i = 0; i < 4; ++i) v[n * 4 + i] = sigmoid_f(acc[ai][bj][m][n][i]);
                    u32x4 w; w.x = cvt_pk_bf16(v[0], v[1]); w.y = cvt_pk_bf16(v[2], v[3]); w.z = cvt_pk_bf16(v[4], v[5]); w.w = cvt_pk_bf16(v[6], v[7]);
                    *(u32x4*)(rowp + bj * HALF) = w; } }
    }
};
template <bool HAS_BASE> struct EpiGate {
    static constexpr bool PERM = true, AFTER_DRAIN = false;
    const bf16_t* base; const bf16_t* gate; int ldg; bf16_t* O;
    __device__ __forceinline__ void operator()(const f32x4 (&acc)[2][2][4][2], const Unit& u, int wr, int wc, int fr, int fq) const {
        const int row0 = u.pm * BM + wr * 64 + fr, col0 = u.pn * BM + wc * 32 + 8 * fq;
#pragma unroll
        for (int ai = 0; ai < 2; ++ai)
#pragma unroll
            for (int m = 0; m < 4; ++m) { const size_t r = (size_t)(row0 + ai * HALF + m * 16);
#pragma unroll
                for (int bj = 0; bj < 2; ++bj) {
                    const u32x4 gv = *(const u32x4*)(gate + r * ldg + col0 + bj * HALF);
                    u32x4 bv = (u32x4){0u, 0u, 0u, 0u}; if (HAS_BASE) bv = *(const u32x4*)(base + r * 1024 + col0 + bj * HALF);
                    const f32x4 a0 = acc[ai][bj][m][0], a1 = acc[ai][bj][m][1];
                    float v[8];
                    v[0] = bf_lo(bv.x) + bf_lo(gv.x) * a0[0]; v[1] = bf_hi(bv.x) + bf_hi(gv.x) * a0[1];
                    v[2] = bf_lo(bv.y) + bf_lo(gv.y) * a0[2]; v[3] = bf_hi(bv.y) + bf_hi(gv.y) * a0[3];
                    v[4] = bf_lo(bv.z) + bf_lo(gv.z) * a1[0]; v[5] = bf_hi(bv.z) + bf_hi(gv.z) * a1[1];
                    v[6] = bf_lo(bv.w) + bf_lo(gv.w) * a1[2]; v[7] = bf_hi(bv.w) + bf_hi(gv.w) * a1[3];
                    u32x4 w; w.x = cvt_pk_bf16(v[0], v[1]); w.y = cvt_pk_bf16(v[2], v[3]); w.z = cvt_pk_bf16(v[4], v[5]); w.w = cvt_pk_bf16(v[6], v[7]);
                    *(u32x4*)(O + r * 1024 + col0 + bj * HALF) = w; } }
    }
};

template <class Epi, class Sched, bool ALIGN_EPI = false, bool SP2 = false>
__device__ __forceinline__ void gemm_phase(PG8_LAS unsigned char* lds, const Gemm g, const Sched& S, const Epi& E) {
    const int tid = threadIdx.x, wid = __builtin_amdgcn_readfirstlane(tid >> 6), lane = tid & 63, wr = wid >> 2, wc = wid & 3, fr = lane & 15, fq = lane >> 4;
    const int K = g.K, nt = K / BK;
    unsigned voffA[2], voffB[2];
#pragma unroll
    for (int i = 0; i < 2; ++i) { int R, C; stage_rc(tid * 16 + i * 8192, R, C); const int Rb = Epi::PERM ? ((R & ~31) + perm32(R & 31)) : R;
        voffA[i] = (unsigned)(R * K + C) * 2u; voffB[i] = (unsigned)(Rb * K + C) * 2u; }
    const size_t kstep = (size_t)(BK * 2);
    const size_t hstep = (size_t)HALF * K * 2;
    const size_t tstep = 2 * hstep;
    const unsigned ldsw = (unsigned)wid * 1024u;
    const int aoff = lds_byte(wr * 64 + fr, fq * 8), boff = lds_byte(wc * 32 + fr, fq * 8);
#define PG8_SA(b, h) (((b) * 2 + (h)) * HTB)
#define PG8_SB(b, h) ((4 + (b) * 2 + (h)) * HTB)
#define PG8_STAGE(bufoff, gbase, voff) do { _Pragma("unroll") for (int _i = 0; _i < 2; ++_i) \
        __builtin_amdgcn_global_load_lds((const unsigned*)((const char*)(gbase) + (voff)[_i]), (PG8_LAS unsigned*)(lds + (bufoff) + ldsw + _i * 8192), 16, 0, 0); } while (0)
#define PG8_LDA(dst, b, h) do { _Pragma("unroll") for (int m = 0; m < 4; ++m) _Pragma("unroll") for (int k = 0; k < 2; ++k) dst[m][k] = *(const PG8_LAS bf16x8*)(lds + PG8_SA(b, h) + aoff + m * 2048 + k * 1024); } while (0)
#define PG8_LDB(dst, b, h) do { _Pragma("unroll") for (int n = 0; n < 2; ++n) _Pragma("unroll") for (int k = 0; k < 2; ++k) dst[n][k] = *(const PG8_LAS bf16x8*)(lds + PG8_SB(b, h) + boff + n * 2048 + k * 1024); } while (0)
#define PG8_MMA(ai, bj, At, Bt) do { __builtin_amdgcn_s_setprio(1); _Pragma("unroll") for (int m = 0; m < 4; ++m) _Pragma("unroll") for (int n = 0; n < 2; ++n) _Pragma("unroll") for (int k = 0; k < 2; ++k) \
        acc[ai][bj][m][n] = __builtin_amdgcn_mfma_f32_16x16x32_bf16(Bt[n][k], At[m][k], acc[ai][bj][m][n], 0, 0, 0); __builtin_amdgcn_s_setprio(0); } while (0)
#define PG8_WAIT_V(n) asm volatile("s_waitcnt vmcnt(" #n ")" ::: "memory")
#define PG8_WAIT_L(n) asm volatile("s_waitcnt lgkmcnt(" #n ")" ::: "memory")
#define PG8_BAR __builtin_amdgcn_s_barrier()
#define PG8_SCHED __builtin_amdgcn_sched_barrier(0)
    Unit cur, nxt; int ui = 0;
    if (!S.next(0, cur)) return;
    f32x4 acc[2][2][4][2];
#pragma unroll
    for (int a = 0; a < 2; ++a)
#pragma unroll
        for (int b = 0; b < 2; ++b)
#pragma unroll
            for (int m = 0; m < 4; ++m)
#pragma unroll
                for (int n = 0; n < 2; ++n) acc[a][b][m][n] = (f32x4){0.f, 0.f, 0.f, 0.f};
    bf16x8 At[4][2], B0[2][2], B1[2][2];
    const char* cA = (const char*)g.A + (size_t)cur.pm * tstep; const char* cB = (const char*)g.Bt + (size_t)cur.pn * tstep;
    S.a_ready(cur);
    if constexpr (SP2) {
        PG8_STAGE(PG8_SB(0, 0), cB, voffB); PG8_STAGE(PG8_SB(0, 1), cB + hstep, voffB); PG8_STAGE(PG8_SA(0, 0), cA, voffA); PG8_STAGE(PG8_SA(0, 1), cA + hstep, voffA);
        if (wr == 1) PG8_BAR;
        PG8_WAIT_V(2); PG8_BAR;
        PG8_STAGE(PG8_SB(1, 0), cB + kstep, voffB); PG8_STAGE(PG8_SA(1, 0), cA + kstep, voffA); PG8_STAGE(PG8_SB(1, 1), cB + hstep + kstep, voffB);
        PG8_WAIT_V(6); PG8_BAR;
    } else {
        PG8_STAGE(PG8_SB(0, 0), cB, voffB); PG8_STAGE(PG8_SA(0, 0), cA, voffA); PG8_STAGE(PG8_SB(0, 1), cB + hstep, voffB); PG8_STAGE(PG8_SA(0, 1), cA + hstep, voffA);
        if (wr == 1) PG8_BAR;
        PG8_WAIT_V(4); PG8_BAR;
        PG8_STAGE(PG8_SB(1, 0), cB + kstep, voffB); PG8_STAGE(PG8_SA(1, 0), cA + kstep, voffA); PG8_STAGE(PG8_SB(1, 1), cB + hstep + kstep, voffB);
        PG8_WAIT_V(6); PG8_BAR;
    }
    for (;;) {
        const bool has_next = S.next(ui + 1, nxt);
        const char* nA = has_next ? (const char*)g.A + (size_t)nxt.pm * tstep : cA; const char* nB = has_next ? (const char*)g.Bt + (size_t)nxt.pn * tstep : cB;
        for (int t = 0; t < nt; t += 2) {
            const bool last = (t == nt - 2);
            const char* a1 = cA + (size_t)(t + 1) * kstep;
            const char* a2 = last ? nA : cA + (size_t)(t + 2) * kstep; const char* b2 = last ? nB : cB + (size_t)(t + 2) * kstep;
            const char* a3 = a2 + kstep; const char* b3 = b2 + kstep;
            if (last && has_next) S.a_ready(nxt);
            if constexpr (SP2) {
            PG8_LDB(B0, 0, 0); PG8_LDB(B1, 0, 1); PG8_SCHED; PG8_LDA(At, 0, 0); PG8_STAGE(PG8_SA(1, 1), a1 + hstep, voffA);
            PG8_WAIT_V(8); PG8_WAIT_L(0); PG8_BAR; PG8_MMA(0, 0, At, B0); PG8_MMA(0, 1, At, B1); PG8_BAR; PG8_SCHED;
            PG8_LDA(At, 0, 1); PG8_STAGE(PG8_SB(0, 0), b2, voffB); PG8_STAGE(PG8_SB(0, 1), b2 + hstep, voffB); PG8_STAGE(PG8_SA(0, 0), a2, voffA);
            PG8_WAIT_V(8); PG8_WAIT_L(0); PG8_BAR; PG8_MMA(1, 0, At, B0); PG8_MMA(1, 1, At, B1); PG8_BAR; PG8_SCHED;
            PG8_LDB(B0, 1, 0); PG8_LDB(B1, 1, 1); PG8_SCHED; PG8_LDA(At, 1, 0); PG8_STAGE(PG8_SA(0, 1), a2 + hstep, voffA);
            PG8_WAIT_V(8); PG8_WAIT_L(0); PG8_BAR; PG8_MMA(0, 0, At, B0); PG8_MMA(0, 1, At, B1); PG8_BAR; PG8_SCHED;
            PG8_LDA(At, 1, 1); PG8_STAGE(PG8_SB(1, 0), b3, voffB); PG8_STAGE(PG8_SB(1, 1), b3 + hstep, voffB); PG8_STAGE(PG8_SA(1, 0), a3, voffA);
            PG8_WAIT_V(8); PG8_WAIT_L(0); PG8_BAR; PG8_MMA(1, 0, At, B0); PG8_MMA(1, 1, At, B1); PG8_BAR; PG8_SCHED;
            } else {
            PG8_LDB(B0, 0, 0); PG8_SCHED; PG8_LDA(At, 0, 0); PG8_STAGE(PG8_SA(1, 1), a1 + hstep, voffA);
            PG8_WAIT_L(8); PG8_BAR; PG8_WAIT_L(0); PG8_MMA(0, 0, At, B0); PG8_BAR; PG8_SCHED;
            PG8_LDB(B1, 0, 1); PG8_STAGE(PG8_SB(0, 0), b2, voffB);
            PG8_BAR; PG8_WAIT_L(0); PG8_MMA(0, 1, At, B1); PG8_BAR;
            PG8_LDA(At, 0, 1); PG8_STAGE(PG8_SA(0, 0), a2, voffA);
            PG8_BAR; PG8_WAIT_L(0); PG8_MMA(1, 0, At, B0); PG8_BAR; PG8_SCHED;
            PG8_STAGE(PG8_SB(0, 1), b2 + hstep, voffB);
            PG8_WAIT_V(6); PG8_BAR; PG8_MMA(1, 1, At, B1); PG8_BAR;
            PG8_LDB(B0, 1, 0); PG8_SCHED; PG8_LDA(At, 1, 0); PG8_STAGE(PG8_SA(0, 1), a2 + hstep, voffA);
            PG8_WAIT_L(8); PG8_BAR; PG8_WAIT_L(0); PG8_MMA(0, 0, At, B0); PG8_BAR; PG8_SCHED;
            PG8_LDB(B1, 1, 1); PG8_STAGE(PG8_SB(1, 0), b3, voffB);
            PG8_BAR; PG8_WAIT_L(0); PG8_MMA(0, 1, At, B1); PG8_BAR;
            PG8_LDA(At, 1, 1); PG8_STAGE(PG8_SA(1, 0), a3, voffA);
            PG8_BAR; PG8_WAIT_L(0); PG8_MMA(1, 0, At, B0); PG8_BAR; PG8_SCHED;
            PG8_STAGE(PG8_SB(1, 1), b3 + hstep, voffB);
            PG8_WAIT_V(6); PG8_BAR; PG8_MMA(1, 1, At, B1); PG8_BAR;
            }
        }
        if constexpr (ALIGN_EPI) { if (wr == 0) PG8_BAR; }
        if constexpr (!Epi::AFTER_DRAIN) { E(acc, cur, wr, wc, fr, fq); S.done(cur); }
        if (!has_next) break;
#pragma unroll
        for (int a = 0; a < 2; ++a)
#pragma unroll
            for (int b = 0; b < 2; ++b)
#pragma unroll
                for (int m = 0; m < 4; ++m)
#pragma unroll
                    for (int n = 0; n < 2; ++n) acc[a][b][m][n] = (f32x4){0.f, 0.f, 0.f, 0.f};
        cur = nxt; cA = nA; cB = nB; ++ui;
        if constexpr (ALIGN_EPI) { if (wr == 1) PG8_BAR; }
    }
    PG8_WAIT_V(0);
    if constexpr (!ALIGN_EPI) { if (wr == 0) PG8_BAR; }
    PG8_BAR;
    if constexpr (Epi::AFTER_DRAIN) { E.fused(acc, cur, wr, wc, fr, fq, lds, wid, lane); S.done(cur); }
#undef PG8_SA
#undef PG8_SB
#undef PG8_STAGE
#undef PG8_LDA
#undef PG8_LDB
#undef PG8_MMA
#undef PG8_WAIT_V
#undef PG8_WAIT_L
#undef PG8_BAR
#undef PG8_SCHED
}
}

#include <hip/hip_cooperative_groups.h>
namespace cg = cooperative_groups;
using pg8::sigmoid_f; using pg8::bf_lo; using pg8::bf_hi;
#define LAS __attribute__((address_space(3)))
typedef unsigned short bf16;
typedef unsigned v4u __attribute__((ext_vector_type(4)));
typedef unsigned v2u __attribute__((ext_vector_type(2)));
typedef float f32x4 __attribute__((ext_vector_type(4)));
typedef float f32x2 __attribute__((ext_vector_type(2)));
typedef short bf16x8 __attribute__((ext_vector_type(8)));
typedef short v4i16_t __attribute__((ext_vector_type(4)));

constexpr int NWAVES = 8, NTHREADS = 512;
constexpr int SEQ = 4096, BATCH = 8, M = BATCH * SEQ, D = 1024, FF = 2816, NIN = 8704, AW = 1536, CW = 31;
constexpr float EPS = 1e-6f;
constexpr size_t MiB = 1u << 20;
constexpr size_t WS_CTL = 0;
constexpr size_t WS_WGU1 = 1 * MiB, WS_WD1 = 12 * MiB, WS_WGU2 = 18 * MiB, WS_WD2 = 29 * MiB, WS_WIN = 35 * MiB, WS_WC = 52 * MiB, WS_WA = 54 * MiB, WS_WO = 55 * MiB;
constexpr size_t WS_H = 58 * MiB;
constexpr size_t WS_ZC = 122 * MiB;
constexpr size_t WS_Q = 186 * MiB;
constexpr size_t WS_K = 282 * MiB;
constexpr size_t WS_V = 378 * MiB;
constexpr size_t WS_LSE = 474 * MiB;
constexpr size_t WS_ATT = 476 * MiB;
constexpr size_t WS_ZG = WS_K;
constexpr size_t WS_G = WS_K;
constexpr size_t WS_T1 = WS_K + 128 * MiB;
constexpr size_t WS_MIX = WS_H;
constexpr size_t WS_A1 = WS_Q;
constexpr size_t WS_END = 508 * MiB;
static_assert(WS_T1 + 64 * MiB <= WS_LSE && WS_A1 + (size_t)M * FF * 2 <= WS_LSE, "ws map");

constexpr int LDS_BYTES = 147456;

__device__ __forceinline__ float wave_sum(float v) {
#pragma unroll
    for (int o = 1; o < 64; o <<= 1) v += __shfl_xor(v, o);
    return v;
}
__device__ __forceinline__ unsigned pk2(float lo, float hi) { return pg8::cvt_pk_bf16(lo, hi); }

__device__ __forceinline__ int dst_row(int map, int n) {
    if (map == 3) { if (n < 1024) map = 1; else if (n < 2048) { map = 2; n -= 1024; } else map = 0; }
    if (map == 0) return n;
    return 256 * (n >> 7) + (n & 127) + (map == 2 ? 128 : 0);
}
__device__ __forceinline__ void transpose_item(const float* W, int K, int N, bf16* WT, int map, LAS float* scr, int item, int lane) {
    const int nblk = N / 32, kb = item / nblk, nb = item % nblk, k0 = 64 * kb, n0 = 32 * nb;
    float wv[32];
#pragma unroll
    for (int i = 0; i < 32; ++i) wv[i] = W[(size_t)(k0 + 2 * i + (lane >> 5)) * N + n0 + (lane & 31)];
#pragma unroll
    for (int i = 0; i < 32; ++i) scr[(2 * i + (lane >> 5)) * 33 + (lane & 31)] = wv[i];
    asm volatile("s_waitcnt lgkmcnt(0)" ::: "memory");
    const int c = lane & 7; const int r0 = dst_row(map, n0);
#pragma unroll
    for (int j = 0; j < 4; ++j) { const int n = (lane >> 3) + 8 * j; const LAS float* s = scr + (8 * c) * 33 + n;
        v4u o; o.x = pk2(s[0 * 33], s[1 * 33]); o.y = pk2(s[2 * 33], s[3 * 33]); o.z = pk2(s[4 * 33], s[5 * 33]); o.w = pk2(s[6 * 33], s[7 * 33]);
        *(v4u*)(WT + (size_t)(r0 + n) * K + k0 + 8 * c) = o; }
    asm volatile("s_waitcnt lgkmcnt(0)" ::: "memory");
}

template <bool OUT_BF16> __device__ __forceinline__ void rms_rows(const float* X, const float* gain, void* out, int gw, int NGW, int lane) {
    f32x4 gv[4];
#pragma unroll
    for (int j = 0; j < 4; ++j) gv[j] = ((const f32x4*)gain)[lane + 64 * j];
    for (int m0 = gw * 4; m0 < M; m0 += NGW * 4) {
        f32x4 v[4][4]; float s[4];
#pragma unroll
        for (int r = 0; r < 4; ++r) { const f32x4* xr = (const f32x4*)(X + (size_t)(m0 + r) * D) + lane;
#pragma unroll
            for (int j = 0; j < 4; ++j) v[r][j] = xr[64 * j]; }
#pragma unroll
        for (int r = 0; r < 4; ++r) { float a = 0.f;
#pragma unroll
            for (int j = 0; j < 4; ++j) a += (v[r][j].x * v[r][j].x + v[r][j].y * v[r][j].y) + (v[r][j].z * v[r][j].z + v[r][j].w * v[r][j].w);
            s[r] = a; }
#pragma unroll
        for (int o = 1; o < 64; o <<= 1) {
#pragma unroll
            for (int r = 0; r < 4; ++r) s[r] += __shfl_xor(s[r], o); }
#pragma unroll
        for (int r = 0; r < 4; ++r) { const float rstd = 1.0f / sqrtf(s[r] * (1.0f / D) + EPS);
            if (OUT_BF16) { v2u* o8 = (v2u*)((bf16*)out + (size_t)(m0 + r) * D) + lane;
#pragma unroll
                for (int j = 0; j < 4; ++j) { v2u w; w.x = pk2(v[r][j].x * rstd * gv[j].x, v[r][j].y * rstd * gv[j].y); w.y = pk2(v[r][j].z * rstd * gv[j].z, v[r][j].w * rstd * gv[j].w); o8[64 * j] = w; }
            } else { f32x4* o = (f32x4*)((float*)out + (size_t)(m0 + r) * D) + lane;
#pragma unroll
                for (int j = 0; j < 4; ++j) o[64 * j] = v[r][j] * rstd * gv[j]; } }
    }
}

constexpr int CT = 16;
__device__ __forceinline__ void conv_phase(const bf16* Zg, const float* dwk, const float* dwb, const float* lng, const float* lnb, bf16* ZC, LAS float* red, int vcu, int G) {
    const int tid = threadIdx.x, lane = tid & 63, wave = tid >> 6, c = 2 * tid;
    float w0[CW], w1[CW];
#pragma unroll
    for (int j = 0; j < CW; ++j) { const f32x2 t = *(const f32x2*)(dwk + j * D + c); w0[j] = t.x; w1[j] = t.y; }
    const f32x2 bb = *(const f32x2*)(dwb + c), gg = *(const f32x2*)(lng + c), lb = *(const f32x2*)(lnb + c);
    constexpr int NT = M / CT; const int tpb = (NT + G - 1) / G; const int tb = vcu * tpb; int te = tb + tpb; if (te > NT) te = NT;
    if (tb >= te) return;
    float z0[CT + CW - 1], z1[CT + CW - 1]; unsigned nx[CT];
    { const int t0 = tb * CT, s0 = t0 & (SEQ - 1);
#pragma unroll
        for (int i = 0; i < CT + CW - 1; ++i) { const bool valid = (s0 + i - (CW - 1)) >= 0; unsigned pk = 0u;
            if (valid) pk = *(const unsigned*)(Zg + (size_t)(t0 + i - (CW - 1)) * D + c);
            z0[i] = bf_lo(pk); z1[i] = bf_hi(pk); } }
    for (int tile = tb; tile < te; ++tile) {
        const int t0 = tile * CT; const bool more = (tile + 1 < te);
        if (more) {
#pragma unroll
            for (int i = 0; i < CT; ++i) nx[i] = *(const unsigned*)(Zg + (size_t)(t0 + CT + i) * D + c); }
        float o0[CT], o1[CT];
#pragma unroll
        for (int t = 0; t < CT; ++t) { o0[t] = bb.x; o1[t] = bb.y; }
#pragma unroll
        for (int j = 0; j < CW; ++j) {
#pragma unroll
            for (int t = 0; t < CT; ++t) { o0[t] += w0[j] * z0[t + j]; o1[t] += w1[j] * z1[t + j]; } }
        { const bool fresh = (((t0 + CT) & (SEQ - 1)) == 0);
#pragma unroll
            for (int i = 0; i < CW - 1; ++i) { z0[i] = fresh ? 0.f : z0[i + CT]; z1[i] = fresh ? 0.f : z1[i + CT]; } }
        { float k32[2 * CT];
#pragma unroll
            for (int t = 0; t < CT; ++t) { k32[2 * t] = o0[t] + o1[t]; k32[2 * t + 1] = o0[t] * o0[t] + o1[t] * o1[t]; }
            float k16[16], k8[8], k4[4], k2[2];
            const bool b5 = (lane & 32) != 0, b4 = (lane & 16) != 0, b3 = (lane & 8) != 0, b2 = (lane & 4) != 0, b1 = (lane & 2) != 0;
#pragma unroll
            for (int k = 0; k < 16; ++k) { const float send = b5 ? k32[k] : k32[16 + k], mine = b5 ? k32[16 + k] : k32[k]; k16[k] = mine + __shfl_xor(send, 32); }
#pragma unroll
            for (int k = 0; k < 8; ++k) { const float send = b4 ? k16[k] : k16[8 + k], mine = b4 ? k16[8 + k] : k16[k]; k8[k] = mine + __shfl_xor(send, 16); }
#pragma unroll
            for (int k = 0; k < 4; ++k) { const float send = b3 ? k8[k] : k8[4 + k], mine = b3 ? k8[4 + k] : k8[k]; k4[k] = mine + __shfl_xor(send, 8); }
#pragma unroll
            for (int k = 0; k < 2; ++k) { const float send = b2 ? k4[k] : k4[2 + k], mine = b2 ? k4[2 + k] : k4[k]; k2[k] = mine + __shfl_xor(send, 4); }
            const float send1 = b1 ? k2[0] : k2[1], mine1 = b1 ? k2[1] : k2[0]; float tot = mine1 + __shfl_xor(send1, 2);
            tot += __shfl_xor(tot, 1);
            if ((lane & 1) == 0) red[(lane >> 1) * 8 + wave] = tot; }
        __syncthreads();
        if (tid < CT) {
            const f32x4 a = *(const LAS f32x4*)(red + (2 * tid) * 8), b = *(const LAS f32x4*)(red + (2 * tid) * 8 + 4);
            const f32x4 p = *(const LAS f32x4*)(red + (2 * tid + 1) * 8), q = *(const LAS f32x4*)(red + (2 * tid + 1) * 8 + 4);
            const float s1 = ((a.x + a.y) + (a.z + a.w)) + ((b.x + b.y) + (b.z + b.w)), s2 = ((p.x + p.y) + (p.z + p.w)) + ((q.x + q.y) + (q.z + q.w));
            const float mu = s1 * (1.0f / D); const float var = fmaxf(s2 * (1.0f / D) - mu * mu, 0.f);
            *(LAS f32x2*)(red + 256 + 2 * tid) = (f32x2){mu, 1.0f / sqrtf(var + EPS)}; }
        __syncthreads();
        unsigned* outp = (unsigned*)(ZC + (size_t)t0 * D + c);
#pragma unroll
        for (int t = 0; t < CT; ++t) { const f32x2 st = *(const LAS f32x2*)(red + 256 + 2 * t);
            float y0 = (o0[t] - st.x) * st.y * gg.x + lb.x, y1 = (o1[t] - st.x) * st.y * gg.y + lb.y;
            y0 = y0 * sigmoid_f(y0); y1 = y1 * sigmoid_f(y1);
            outp[(size_t)t * (D / 2)] = pk2(y0, y1); }
        if (more) {
#pragma unroll
            for (int i = 0; i < CT; ++i) { z0[CW - 1 + i] = bf_lo(nx[i]); z1[CW - 1 + i] = bf_hi(nx[i]); } }
        __syncthreads();
    }
}

constexpr int VROW = 272;
constexpr int ATT_UNITS = BATCH * 12 * 32;
__device__ __forceinline__ v4i16_t tr16(const LAS unsigned char* p) { return __builtin_amdgcn_ds_read_tr16_b64_v4i16((LAS v4i16_t*)p); }
struct AttnPre { v4u k[4], v[4]; bf16x8 q[4]; };
struct AttnIdx { size_t row0; int hg, dsh, n; };
__device__ __forceinline__ AttnIdx attn_decode(int unit) {
    AttnIdx x; const int bh = unit >> 5, j = unit & 31; x.hg = bh % 12; const int gi = x.hg >> 2;
    x.dsh = 2 * gi; const int nbsh = 5 - x.dsh;
    x.n = j & ((1 << nbsh) - 1);
    x.row0 = (size_t)bh * SEQ + (size_t)j * 128; return x;
}
constexpr int ATT_HB = 128 * VROW;
constexpr int ATT_KOFF = 0, ATT_VOFF = 2 * ATT_HB;
__device__ __forceinline__ void attn_load_kv(AttnPre& p, const bf16* K, const bf16* V, size_t r0, int tid) {
#pragma unroll
    for (int i = 0; i < 4; ++i) { const size_t off = r0 * 128 + (size_t)(tid + 512 * i) * 8; p.k[i] = *(const v4u*)(K + off); p.v[i] = *(const v4u*)(V + off); }
}
__device__ __forceinline__ void attn_load(AttnPre& p, const bf16* Q, const bf16* K, const bf16* V, int unit, int tid, int w, int lq, int g) {
    const AttnIdx x = attn_decode(unit);
    attn_load_kv(p, K, V, x.row0, tid);
#pragma unroll
    for (int s = 0; s < 4; ++s) p.q[s] = *(const bf16x8*)(Q + (x.row0 + 16 * w + lq) * 128 + 32 * s + 8 * g);
}
__device__ __forceinline__ void attn_stage(LAS unsigned char* lds, const AttnPre& p, int half, int tid) {
#pragma unroll
    for (int i = 0; i < 4; ++i) { const int cidx = tid + 512 * i, row = cidx >> 4, ch = cidx & 15;
        *(LAS v4u*)(lds + ATT_KOFF + half * ATT_HB + row * VROW + ch * 16) = p.k[i]; *(LAS v4u*)(lds + ATT_VOFF + half * ATT_HB + row * VROW + ch * 16) = p.v[i]; }
}
__device__ __forceinline__ void attn_compute(LAS unsigned char* lds, const bf16x8 (&qf)[4], bf16* O, float* LSE, int unit, int f, int lane, int w, int lq, int g) {
    const AttnIdx x = attn_decode(unit); const int hg = x.hg, n = x.n;
    int rowT[9];
#pragma unroll
    for (int T = 0; T < 9; ++T) { const int kk0 = 16 * w + 16 * T; rowT[T] = ((((kk0 >> 7) ^ f) & 1) << 7) + (kk0 & 127); }
    f32x4 st[9];
    const LAS unsigned char* kb = lds + ATT_KOFF + lq * VROW + 16 * g;
#pragma unroll
    for (int T = 0; T < 9; ++T) { f32x4 a = (f32x4){0.f, 0.f, 0.f, 0.f}; const LAS unsigned char* kp = kb + rowT[T] * VROW;
#pragma unroll
        for (int s = 0; s < 4; ++s) { const bf16x8 kf = *(const LAS bf16x8*)(kp + 64 * s); a = __builtin_amdgcn_mfma_f32_16x16x32_bf16(kf, qf[s], a, 0, 0, 0); }
        st[T] = a; }
    const float slope2 = __builtin_amdgcn_exp2f(-(float)(8 * (hg + 1)) * (1.0f / 12.0f)) * (float)(1 << x.dsh) * 1.4426950408889634f;
    float mx = -__builtin_inff();
#pragma unroll
    for (int T = 0; T < 9; ++T)
#pragma unroll
        for (int reg = 0; reg < 4; ++reg) { const int steps = 128 + lq - 16 * T - 4 * g - reg, ki = 16 * w + 16 * T + 4 * g + reg;
            const bool valid = (steps >= 0) && (steps <= 128) && (n > 0 || ki >= 128);
            const float v = valid ? st[T][reg] - slope2 * (float)steps : -__builtin_inff(); st[T][reg] = v; mx = fmaxf(mx, v); }
    mx = fmaxf(mx, __shfl_xor(mx, 16)); mx = fmaxf(mx, __shfl_xor(mx, 32));
    float sum = 0.f;
#pragma unroll
    for (int T = 0; T < 9; ++T)
#pragma unroll
        for (int reg = 0; reg < 4; ++reg) { const float p = __builtin_amdgcn_exp2f(st[T][reg] - mx); st[T][reg] = p; sum += p; }
    sum += __shfl_xor(sum, 16); sum += __shfl_xor(sum, 32);
    bf16x8 pf[5];
#pragma unroll
    for (int u = 0; u < 5; ++u) { v4u t; t.x = pk2(st[2 * u][0], st[2 * u][1]); t.y = pk2(st[2 * u][2], st[2 * u][3]);
        if (u < 4) { t.z = pk2(st[2 * u + 1][0], st[2 * u + 1][1]); t.w = pk2(st[2 * u + 1][2], st[2 * u + 1][3]); } else { t.z = 0u; t.w = 0u; }
        pf[u] = __builtin_bit_cast(bf16x8, t); }
    const LAS unsigned char* vb = lds + ATT_VOFF + (4 * g + ((lane & 15) >> 2)) * VROW + (lane & 3) * 16;
    f32x4 o[4][2];
#pragma unroll
    for (int cp = 0; cp < 4; ++cp) { o[cp][0] = (f32x4){0.f, 0.f, 0.f, 0.f}; o[cp][1] = (f32x4){0.f, 0.f, 0.f, 0.f}; }
#pragma unroll
    for (int u = 0; u < 5; ++u) { const LAS unsigned char* vlo = vb + rowT[2 * u] * VROW; const LAS unsigned char* vhi = vb + rowT[u < 4 ? 2 * u + 1 : 8] * VROW;
#pragma unroll
        for (int cp = 0; cp < 4; ++cp)
#pragma unroll
            for (int h2 = 0; h2 < 2; ++h2) {
                const v4i16_t lo = tr16(vlo + cp * 64 + h2 * 8), hi = tr16(vhi + cp * 64 + h2 * 8);
                const bf16x8 vf = (bf16x8){lo[0], lo[1], lo[2], lo[3], hi[0], hi[1], hi[2], hi[3]};
                o[cp][h2] = __builtin_amdgcn_mfma_f32_16x16x32_bf16(vf, pf[u], o[cp][h2], 0, 0, 0); } }
    const float inv = 1.0f / sum;
    const size_t rq = x.row0 + 16 * w + lq;
    bf16* op = O + rq * 128 + 8 * g;
#pragma unroll
    for (int cp = 0; cp < 4; ++cp) { const f32x4 a = o[cp][0] * inv, c = o[cp][1] * inv;
        v4u t; t.x = pk2(a[0], a[1]); t.y = pk2(a[2], a[3]); t.z = pk2(c[0], c[1]); t.w = pk2(c[2], c[3]);
        *(v4u*)(op + 32 * cp) = t; }
    if (g == 0) LSE[rq] = mx + __builtin_amdgcn_logf(sum);
}
__device__ __forceinline__ void attn_phase(LAS unsigned char* lds, const bf16* Q, const bf16* K, const bf16* V, bf16* O, float* LSE, int vcu, int G) {
    const int tid = threadIdx.x, lane = tid & 63, w = __builtin_amdgcn_readfirstlane(tid >> 6), lq = lane & 15, g = lane >> 4;
    const int upb = (ATT_UNITS + G - 1) / G; const int u0 = vcu * upb; int u1 = u0 + upb; if (u1 > ATT_UNITS) u1 = ATT_UNITS;
    if (u0 >= u1) return;
    for (int i = tid; i < 4 * ATT_HB / 16; i += NTHREADS) ((LAS v4u*)lds)[i] = (v4u){0u, 0u, 0u, 0u};
    __syncthreads();
    AttnPre pre; int f = 0;
    { const AttnIdx x0 = attn_decode(u0); if (x0.n > 0) { attn_load_kv(pre, K, V, x0.row0 - 128, tid); attn_stage(lds, pre, f, tid); } }
    attn_load(pre, Q, K, V, u0, tid, w, lq, g);
    for (int u = u0; u < u1; ++u) {
        bf16x8 qf[4];
#pragma unroll
        for (int s = 0; s < 4; ++s) qf[s] = pre.q[s];
        attn_stage(lds, pre, f ^ 1, tid);
        __syncthreads();
        if (u + 1 < u1) attn_load(pre, Q, K, V, u + 1, tid, w, lq, g);
        attn_compute(lds, qf, O, LSE, u, f, lane, w, lq, g);
        __syncthreads();
        f ^= 1;
    }
}

__device__ __forceinline__ void merge_rows(const bf16* OG, const float* LSE, bf16* ATT, int gw, int NGW, int lane) {
    const int hh = lane >> 4, c0 = (lane & 15) * 8;
    for (int m0 = gw * 4; m0 < M; m0 += NGW * 4) {
        float l[4][3]; v4u a[4][3];
#pragma unroll
        for (int r = 0; r < 4; ++r) { const int m = m0 + r, b = m >> 12, s = m & 4095;
#pragma unroll
            for (int gi = 0; gi < 3; ++gi) { const int dsh = 2 * gi; const int pos = ((s & ((1 << dsh) - 1)) << (12 - dsh)) + (s >> dsh);
                const size_t row = (size_t)(b * 12 + gi * 4 + hh) * 4096 + pos; l[r][gi] = LSE[row]; a[r][gi] = *(const v4u*)(OG + row * 128 + c0); } }
#pragma unroll
        for (int r = 0; r < 4; ++r) {
            const float mx = fmaxf(l[r][0], fmaxf(l[r][1], l[r][2]));
            float e0 = __builtin_amdgcn_exp2f(l[r][0] - mx), e1 = __builtin_amdgcn_exp2f(l[r][1] - mx), e2 = __builtin_amdgcn_exp2f(l[r][2] - mx);
            const float inv = 1.0f / (e0 + e1 + e2); e0 *= inv; e1 *= inv; e2 *= inv;
            const v4u A = a[r][0], B = a[r][1], C = a[r][2]; v4u o;
            o.x = pk2(e0 * bf_lo(A.x) + e1 * bf_lo(B.x) + e2 * bf_lo(C.x), e0 * bf_hi(A.x) + e1 * bf_hi(B.x) + e2 * bf_hi(C.x));
            o.y = pk2(e0 * bf_lo(A.y) + e1 * bf_lo(B.y) + e2 * bf_lo(C.y), e0 * bf_hi(A.y) + e1 * bf_hi(B.y) + e2 * bf_hi(C.y));
            o.z = pk2(e0 * bf_lo(A.z) + e1 * bf_lo(B.z) + e2 * bf_lo(C.z), e0 * bf_hi(A.z) + e1 * bf_hi(B.z) + e2 * bf_hi(C.z));
            o.w = pk2(e0 * bf_lo(A.w) + e1 * bf_lo(B.w) + e2 * bf_lo(C.w), e0 * bf_hi(A.w) + e1 * bf_hi(B.w) + e2 * bf_hi(C.w));
            *(v4u*)(ATT + (size_t)(m0 + r) * 512 + hh * 128 + c0) = o; }
    }
}

#define XB_TMO      128
#define XB_XCNT(j)  (256  + 64 * (j))
#define XB_XSUB(j)  (1280 + 64 * (j))
#define XB_XGEN(j)  (2304 + 64 * (j))
#define XB_TOP      3328
#define XB_TOPGEN   3392
#define XCD_BAR_WORDS 3456
#define XB_SPIN_CAP (1u << 18)

__device__ __forceinline__ unsigned xb_ld(unsigned* p)              { return __hip_atomic_load(p, __ATOMIC_RELAXED, __HIP_MEMORY_SCOPE_AGENT); }
__device__ __forceinline__ unsigned xb_add(unsigned* p, unsigned v) { return __hip_atomic_fetch_add(p, v, __ATOMIC_RELAXED, __HIP_MEMORY_SCOPE_AGENT); }
__device__ __forceinline__ unsigned xb_xcc_id() { return (unsigned)__builtin_amdgcn_s_getreg((3 << 11) | 20) & 0xFu; }
#define XB_SPIN(cond, bar) do { unsigned _sp = 0; while (cond) { __builtin_amdgcn_s_sleep(1); \
    if ((++_sp & 255u) == 0u) { if (xb_ld(&(bar)[XB_TMO])) break; if (_sp > XB_SPIN_CAP) { atomicAdd(&(bar)[XB_TMO], 1u); break; } } } } while (0)

struct XcdBarrier {
    unsigned* bar; unsigned x;
    volatile LAS unsigned* st;
};

__device__ __forceinline__ XcdBarrier xcd_barrier_post(unsigned* bar, volatile LAS unsigned* st) {
    XcdBarrier b; b.bar = bar; b.x = xb_xcc_id(); b.st = st;
    if (threadIdx.x == 0) (void)xb_add(&bar[XB_XCNT(b.x)], 1u);
    return b;
}
__device__ __forceinline__ void xcd_barrier_complete(unsigned* bar, unsigned x, unsigned& nloc, unsigned& nx) {
    const unsigned G = gridDim.x * gridDim.y * gridDim.z;
    unsigned sum, cnt, mine, sp = 0u;
    for (;;) {
        sum = 0u; cnt = 0u; mine = 0u;
#pragma unroll
        for (unsigned j = 0; j < 16; ++j) { const unsigned c = xb_ld(&bar[XB_XCNT(j)]); sum += c; cnt += (c > 0u) ? 1u : 0u; mine = (j == x) ? c : mine; }
        if (sum == G) break;
        __builtin_amdgcn_s_sleep(1);
        if ((++sp & 255u) == 0u) { if (xb_ld(&bar[XB_TMO])) break; if (sp > XB_SPIN_CAP) { atomicAdd(&bar[XB_TMO], 1u); break; } }
    }
    nloc = mine > 0u ? mine : 1u; nx = cnt > 0u ? cnt : 1u;
}

__device__ __forceinline__ void xcd_barrier(const XcdBarrier& b) {
    asm volatile("s_waitcnt vmcnt(0)" ::: "memory");
    __syncthreads();
    if (threadIdx.x == 0) {
        unsigned* bar = b.bar;
        __builtin_amdgcn_s_waitcnt(0);
        unsigned nloc = b.st[0], nx = b.st[1];
        if (nloc == 0u) { xcd_barrier_complete(bar, b.x, nloc, nx); b.st[0] = nloc; b.st[1] = nx; }
        const unsigned old = xb_add(&bar[XB_XSUB(b.x)], 1u);
        const unsigned gen = old / nloc;
        if (old + 1u == (gen + 1u) * nloc) {
            __builtin_amdgcn_fence(__ATOMIC_RELEASE, "agent");
            asm volatile("s_waitcnt vmcnt(0)" ::: "memory");
            const unsigned og = xb_add(&bar[XB_TOP], 1u);
            const unsigned tg = og / nx;
            if (og + 1u == (tg + 1u) * nx) xb_add(&bar[XB_TOPGEN], 1u);
            else XB_SPIN(xb_ld(&bar[XB_TOPGEN]) == tg, bar);
            __builtin_amdgcn_fence(__ATOMIC_ACQUIRE, "agent");
            xb_add(&bar[XB_XGEN(b.x)], 1u);
            asm volatile("s_waitcnt vmcnt(0)" ::: "memory");
        } else {
            XB_SPIN(xb_ld(&bar[XB_XGEN(b.x)]) == gen, bar);
            __builtin_amdgcn_fence(__ATOMIC_ACQUIRE, "agent");
            asm volatile("s_waitcnt vmcnt(0)" ::: "memory");
        }
    }
    __syncthreads();
}

struct Args { const float* in[19]; float* out; unsigned char* ws; int ph_lo, ph_hi; };
#ifndef MK_MULTI
#define MK_MULTI 0
#endif
#if MK_MULTI
#define GRID_SYNC() do { } while (0)
#else
#ifndef MK_CG
#define MK_CG 0
#endif
#if MK_CG
#define GRID_SYNC() do { __threadfence(); cg::this_grid().sync(); } while (0)
#else
#define GRID_SYNC() xcd_barrier(xbar)
#endif
#endif

__global__ void __launch_bounds__(NTHREADS, 2) fwd_kernel(Args args) {
    extern __shared__ __attribute__((aligned(16))) unsigned char lds_raw[];
    LAS unsigned char* lds = (LAS unsigned char*)lds_raw;
    const int tid = threadIdx.x, lane = tid & 63, wave = __builtin_amdgcn_readfirstlane(tid >> 6);
    const int G = gridDim.x, bx = blockIdx.x; const int vcu = (G % 8 == 0) ? (bx % 8) * (G / 8) + bx / 8 : bx;
    const int gw = vcu * NWAVES + wave, NGW = G * NWAVES;
    unsigned char* ws = args.ws;
#if !MK_MULTI && !MK_CG
    volatile LAS unsigned* xst = (volatile LAS unsigned*)(lds + LDS_BYTES - 128);
    if (tid < 2) xst[tid] = 0u;
    __syncthreads();
    XcdBarrier xbar = xcd_barrier_post((unsigned*)(ws + WS_CTL), xst);
#endif
    const float* x = args.in[0];
    float* X = args.out;
    bf16* Wgu1 = (bf16*)(ws + WS_WGU1); bf16* Wd1 = (bf16*)(ws + WS_WD1); bf16* Wgu2 = (bf16*)(ws + WS_WGU2); bf16* Wd2 = (bf16*)(ws + WS_WD2);
    bf16* Win = (bf16*)(ws + WS_WIN); bf16* Wc = (bf16*)(ws + WS_WC); bf16* Wa = (bf16*)(ws + WS_WA); bf16* Wo = (bf16*)(ws + WS_WO);
    bf16* H = (bf16*)(ws + WS_H); bf16* ZC = (bf16*)(ws + WS_ZC); bf16* Qb = (bf16*)(ws + WS_Q); bf16* Kb = (bf16*)(ws + WS_K); bf16* Vb = (bf16*)(ws + WS_V);
    float* LSE = (float*)(ws + WS_LSE); bf16* ATT = (bf16*)(ws + WS_ATT); bf16* ZG = (bf16*)(ws + WS_ZG); bf16* GT = (bf16*)(ws + WS_G);
    bf16* T1 = (bf16*)(ws + WS_T1); bf16* MIX = (bf16*)(ws + WS_MIX); bf16* A1 = (bf16*)(ws + WS_A1);
    const int lo = args.ph_lo, hi = args.ph_hi;
#define IN(k) (lo <= (k) && (k) < hi)
#define SEAM(k) do { if (IN(k) && IN((k) + 1)) GRID_SYNC(); } while (0)
#define GEMM_PHASE(EPI, Aptr, Bptr, Nn, Kk, ...) do { pg8::Gemm g_{Aptr, Bptr, M, Nn, Kk}; pg8::StaticOrder S_; S_.init(M, Nn, G, bx); EPI E_{__VA_ARGS__}; \
        pg8::gemm_phase<EPI, pg8::StaticOrder, true, true>(lds, g_, S_, E_); } while (0)

    if (IN(0)) {
        LAS float* scr = (LAS float*)(lds + wave * 16384);
        constexpr int I_GU = 16 * 88, I_DN = 44 * 32, I_IN = 16 * 272, I_C = 16 * 32, I_A = 8 * 32;
        constexpr int NITEMS = 6 * I_GU + I_IN + 2 * I_C + I_A;
        static_assert(I_DN == I_GU, "items");
        for (int it = gw; it < NITEMS; it += NGW) {
            int r = it;
            if (r < I_GU) { transpose_item(args.in[2], D, FF, Wgu1, 1, scr, r, lane); continue; } r -= I_GU;
            if (r < I_GU) { transpose_item(args.in[3], D, FF, Wgu1, 2, scr, r, lane); continue; } r -= I_GU;
            if (r < I_GU) { transpose_item(args.in[4], FF, D, Wd1, 0, scr, r, lane); continue; } r -= I_GU;
            if (r < I_GU) { transpose_item(args.in[15], D, FF, Wgu2, 1, scr, r, lane); continue; } r -= I_GU;
            if (r < I_GU) { transpose_item(args.in[16], D, FF, Wgu2, 2, scr, r, lane); continue; } r -= I_GU;
            if (r < I_GU) { transpose_item(args.in[17], FF, D, Wd2, 0, scr, r, lane); continue; } r -= I_GU;
            if (r < I_IN) { transpose_item(args.in[6], D, NIN, Win, 3, scr, r, lane); continue; } r -= I_IN;
            if (r < I_C) { transpose_item(args.in[11], D, D, Wc, 0, scr, r, lane); continue; } r -= I_C;
            if (r < I_A) { transpose_item(args.in[12], 512, D, Wa, 0, scr, r, lane); continue; } r -= I_A;
            transpose_item(args.in[13], D, D, Wo, 0, scr, r, lane);
        }
        rms_rows<true>(x, args.in[1], H, gw, NGW, lane);
        __syncthreads();
    }
    SEAM(0);
    if (IN(1)) GEMM_PHASE(pg8::EpiPair<0>, H, Wgu1, 2 * FF, D, A1, FF);
    SEAM(1);
    if (IN(2)) GEMM_PHASE(pg8::EpiResid, A1, Wd1, D, FF, x, X, D, 0.5f);
    SEAM(2);
    if (IN(3)) rms_rows<true>(X, args.in[5], H, gw, NGW, lane);
    SEAM(3);
    if (IN(4)) GEMM_PHASE(pg8::EpiPair<1>, H, Win, 2048, D, ZG, D);
    SEAM(4);
    if (IN(5)) conv_phase(ZG, args.in[7], args.in[8], args.in[9], args.in[10], ZC, (LAS float*)lds, vcu, G);
    SEAM(5);
    if (IN(6)) GEMM_PHASE(pg8::EpiQKV, H, Win + (size_t)2048 * D, 3 * AW, D, Qb, (size_t)(WS_K - WS_Q) / 2, 0.08838834764831845f * 1.4426950408889634f);
    SEAM(6);
    if (IN(7)) attn_phase(lds, Qb, Kb, Vb, Qb, LSE, vcu, G);
    SEAM(7);
    if (IN(8)) { merge_rows(Qb, LSE, ATT, gw, NGW, lane); __syncthreads(); }
    if (IN(8)) GEMM_PHASE(pg8::EpiSig, H, Win + (size_t)6656 * D, 2048, D, GT, 2048);
    SEAM(8);
    if (IN(9)) GEMM_PHASE(pg8::EpiGate<false>, ZC, Wc, D, D, nullptr, GT, 2048, T1);
    SEAM(9);
    if (IN(10)) GEMM_PHASE(pg8::EpiGate<true>, ATT, Wa, D, 512, T1, GT + 1024, 2048, MIX);
    SEAM(10);
    if (IN(11)) GEMM_PHASE(pg8::EpiResid, MIX, Wo, D, D, X, X, D, 1.0f);
    SEAM(11);
    if (IN(12)) rms_rows<true>(X, args.in[14], H, gw, NGW, lane);
    SEAM(12);
    if (IN(13)) GEMM_PHASE(pg8::EpiPair<0>, H, Wgu2, 2 * FF, D, A1, FF);
    SEAM(13);
    if (IN(14)) GEMM_PHASE(pg8::EpiResid, A1, Wd2, D, FF, X, X, D, 0.5f);
    SEAM(14);
    if (IN(15)) rms_rows<false>(X, args.in[18], X, gw, NGW, lane);
#undef IN
#undef SEAM
}
constexpr int NPHASES = 16;

extern "C" void kernel_launch(void* const* d_in, const int* in_sizes, int n_in, void* d_out, int out_size, void* d_ws, size_t ws_size, hipStream_t stream) {
    static int grid = 0;
    if (grid == 0) {
        if (n_in != 19 || out_size != M * D || ws_size < WS_END) { fprintf(stderr, "kernel_launch: unexpected shapes (n_in %d out %d ws %zu)\n", n_in, out_size, ws_size); grid = -1; return; }
        int dev = 0, cus = 0, per_cu = 0;
        hipGetDevice(&dev); hipDeviceGetAttribute(&cus, hipDeviceAttributeMultiprocessorCount, dev);
        if (hipFuncSetAttribute((const void*)fwd_kernel, hipFuncAttributeMaxDynamicSharedMemorySize, LDS_BYTES) != hipSuccess) { fprintf(stderr, "kernel_launch: hipFuncSetAttribute failed\n"); grid = -1; return; }
        if (hipOccupancyMaxActiveBlocksPerMultiprocessor(&per_cu, (const void*)fwd_kernel, NTHREADS, LDS_BYTES) != hipSuccess || per_cu < 1) { fprintf(stderr, "kernel_launch: occupancy query says %d\n", per_cu); per_cu = 1; }
        (void)hipGetLastError();
        if (per_cu > 1) per_cu = 1;
        grid = cus * per_cu;
    }
    if (grid < 0) return;
    Args a{};
    for (int i = 0; i < 19; ++i) a.in[i] = (const float*)d_in[i];
    a.out = (float*)d_out; a.ws = (unsigned char*)d_ws;
#if MK_MULTI
    for (int p = 0; p < NPHASES; ++p) { a.ph_lo = p; a.ph_hi = p + 1; hipLaunchKernelGGL(fwd_kernel, dim3(grid), dim3(NTHREADS), LDS_BYTES, stream, a); }
#else
    a.ph_lo = 0; a.ph_hi = NPHASES;
#if MK_CG
    void* kargs[] = {&a};
    hipError_t e = hipLaunchCooperativeKernel((const void*)fwd_kernel, dim3(grid), dim3(NTHREADS), kargs, LDS_BYTES, stream);
    if (e != hipSuccess) fprintf(stderr, "cooperative launch failed: %s (grid %d)\n", hipGetErrorString(e), grid);
#else
    if (hipMemsetAsync((char*)d_ws + WS_CTL, 0, 65536, stream) != hipSuccess) { fprintf(stderr, "kernel_launch: memset failed\n"); return; }
    hipLaunchKernelGGL(fwd_kernel, dim3(grid), dim3(NTHREADS), LDS_BYTES, stream, a);
#endif
#endif
}
```

```cpp
#include <hip/hip_runtime.h>
#include <cstdio>
#include <cstdint>
namespace pg8 {
#define PG8_LAS __attribute__((address_space(3)))
typedef unsigned short bf16_t;
typedef short bf16x8 __attribute__((ext_vector_type(8)));
typedef float f32x4 __attribute__((ext_vector_type(4)));
typedef unsigned u32x4 __attribute__((ext_vector_type(4)));
constexpr int BM = 256, BK = 64, HALF = 128, HTB = HALF * BK * 2  , STAGE_BYTES = 8 * HTB, NXCD = 8, WGM = 8;

__host__ __device__ __forceinline__ int lds_byte(int r, int c) { const int st = (r >> 4) * 2 + (c >> 5), rr = r & 15, cc = c & 31, ob = rr * 64 + cc * 2; return st * 1024 + (ob ^ (((ob >> 9) & 1) << 5)); }
__host__ __device__ __forceinline__ void stage_rc(int b, int& R, int& C) { const int st = b / 1024, sb = b % 1024, swz = sb ^ (((sb >> 9) & 1) << 5); R = (st >> 1) * 16 + swz / 64; C = (st & 1) * 32 + (swz % 64) / 2; }
__host__ __device__ __forceinline__ int perm32(int rho) { const int n = rho >> 4, i = rho & 15; return 8 * (i >> 2) + 4 * n + (i & 3); }

struct Unit { int pm, pn; };
struct Gemm { const bf16_t* A; const bf16_t* Bt; int M, N, K; };

struct StaticOrder {
    int nM, nN, nwg, G, c;
    __host__ __device__ void init(int M, int N, int G_, int c_) { nM = M / BM; nN = N / BM; nwg = nM * nN; G = G_; c = c_; }
    __host__ __device__ bool next(int i, Unit& u) const {
        const long L = (long)i * G + c; if (L >= nwg) return false;
        int wgid = (int)L; { const int q = nwg / NXCD, r = nwg % NXCD, xcd = wgid % NXCD, off = wgid / NXCD; wgid = (xcd < r ? xcd * (q + 1) : r * (q + 1) + (xcd - r) * q) + off; }
        const int nig = WGM * nN, gid = wgid / nig, fm = gid * WGM, gsz = (nM - fm) < WGM ? (nM - fm) : WGM;
        u.pm = fm + ((wgid % nig) % gsz); u.pn = (wgid % nig) / gsz; return true;
    }
    __device__ __forceinline__ void a_ready(const Unit&) const {}
    __device__ __forceinline__ void done(const Unit&) const {}
};

typedef float f32x2_t __attribute__((ext_vector_type(2))); typedef __bf16 bf16x2_t __attribute__((ext_vector_type(2)));
__device__ __forceinline__ unsigned cvt_pk_bf16(float lo, float hi) { const f32x2_t v = {lo, hi}; const bf16x2_t b = __builtin_convertvector(v, bf16x2_t); return __builtin_bit_cast(unsigned, b); }
typedef float f32x2 __attribute__((ext_vector_type(2)));
__device__ __forceinline__ float sigmoid_f(float x) { return __builtin_amdgcn_rcpf(1.0f + __builtin_amdgcn_exp2f(-1.4426950408889634f * x)); }
__device__ __forceinline__ float bf_lo(unsigned u) { return __uint_as_float(u << 16); }
__device__ __forceinline__ float bf_hi(unsigned u) { return __uint_as_float(u & 0xffff0000u); }

template <int ACT> struct EpiPair {
    static constexpr bool PERM = true, AFTER_DRAIN = false;
    bf16_t* O; int ldo;
    __device__ __forceinline__ void operator()(const f32x4 (&acc)[2][2][4][2], const Unit& u, int wr, int wc, int fr, int fq) const {
        const int row0 = u.pm * BM + wr * 64 + fr, col0 = u.pn * HALF + wc * 32 + 8 * fq;
#pragma unroll
        for (int ai = 0; ai < 2; ++ai)
#pragma unroll
            for (int m = 0; m < 4; ++m) {
                float v[8];
#pragma unroll
                for (int n = 0; n < 2; ++n)
#pragma unroll
                    for (int i = 0; i < 4; ++i) { const float a = acc[ai][0][m][n][i], b = acc[ai][1][m][n][i];
                        v[n * 4 + i] = (ACT == 0) ? a * sigmoid_f(a) * b : a * sigmoid_f(b); }
                u32x4 w; w.x = cvt_pk_bf16(v[0], v[1]); w.y = cvt_pk_bf16(v[2], v[3]); w.z = cvt_pk_bf16(v[4], v[5]); w.w = cvt_pk_bf16(v[6], v[7]);
                *(u32x4*)(O + (size_t)(row0 + ai * HALF + m * 16) * ldo + col0) = w; }
    }
};
struct EpiResid {
    static constexpr bool PERM = true, AFTER_DRAIN = false;
    const float* base; float* out; int ldo; float alpha;
    __device__ __forceinline__ void operator()(const f32x4 (&acc)[2][2][4][2], const Unit& u, int wr, int wc, int fr, int fq) const {
        const int row0 = u.pm * BM + wr * 64 + fr, col0 = u.pn * BM + wc * 32 + 8 * fq;
#pragma unroll
        for (int ai = 0; ai < 2; ++ai)
#pragma unroll
            for (int m = 0; m < 4; ++m) { const size_t off = (size_t)(row0 + ai * HALF + m * 16) * ldo + col0;
#pragma unroll
                for (int bj = 0; bj < 2; ++bj)
#pragma unroll
                    for (int n = 0; n < 2; ++n) { const f32x4 bs = *(const f32x4*)(base + off + bj * HALF + 4 * n);
                        *(f32x4*)(out + off + bj * HALF + 4 * n) = bs + acc[ai][bj][m][n] * alpha; } }
    }
};
struct EpiQKV {
    static constexpr bool PERM = true, AFTER_DRAIN = false;
    bf16_t* O; size_t tstride; float qscale;
    __device__ __forceinline__ void operator()(const f32x4 (&acc)[2][2][4][2], const Unit& u, int wr, int wc, int fr, int fq) const {
        const int row0 = u.pm * BM + wr * 64 + fr; const int t = u.pn / 6, ct = u.pn - 6 * t, dsh = 2 * (ct >> 1);
        bf16_t* base = O + (size_t)t * tstride + wc * 32 + 8 * fq; const float sc = (t == 0) ? qscale : 1.0f;
#pragma unroll
        for (int ai = 0; ai < 2; ++ai)
#pragma unroll
            for (int m = 0; m < 4; ++m) { const int row = row0 + ai * HALF + m * 16, b = row >> 12, s = row & 4095;
                const int pos = ((s & ((1 << dsh) - 1)) << (12 - dsh)) + (s >> dsh);
#pragma unroll
                for (int bj = 0; bj < 2; ++bj) { const f32x4 v0 = acc[ai][bj][m][0] * sc, v1 = acc[ai][bj][m][1] * sc;
                    u32x4 w; w.x = cvt_pk_bf16(v0[0], v0[1]); w.y = cvt_pk_bf16(v0[2], v0[3]); w.z = cvt_pk_bf16(v1[0], v1[1]); w.w = cvt_pk_bf16(v1[2], v1[3]);
                    *(u32x4*)(base + ((size_t)((b * 12 + 2 * ct + bj) * 4096 + pos)) * 128) = w; } }
    }
};
struct EpiSig {
    static constexpr bool PERM = true, AFTER_DRAIN = false;
    bf16_t* O; int ldo;
    __device__ __forceinline__ void operator()(const f32x4 (&acc)[2][2][4][2], const Unit& u, int wr, int wc, int fr, int fq) const {
        const int row0 = u.pm * BM + wr * 64 + fr, col0 = u.pn * BM + wc * 32 + 8 * fq;
#pragma unroll
        for (int ai = 0; ai < 2; ++ai)
#pragma unroll
            for (int m = 0; m < 4; ++m) { bf16_t* rowp = O + (size_t)(row0 + ai * HALF + m * 16) * ldo + col0;
#pragma unroll
                for (int bj = 0; bj < 2; ++bj) { float v[8];
#pragma unroll
                    for (int n = 0; n < 2; ++n)
#pragma unroll
                        for (int i = 0; i < 4; ++i) v[n * 4 + i] = sigmoid_f(acc[ai][bj][m][n][i]);
                    u32x4 w; w.x = cvt_pk_bf16(v[0], v[1]); w.y = cvt_pk_bf16(v[2], v[3]); w.z = cvt_pk_bf16(v[4], v[5]); w.w = cvt_pk_bf16(v[6], v[7]);
                    *(u32x4*)(rowp + bj * HALF) = w; } }
    }
};
template <bool HAS_BASE> struct EpiGate {
    static constexpr bool PERM = true, AFTER_DRAIN = false;
    const bf16_t* base; const bf16_t* gate; int ldg; bf16_t* O;
    __device__ __forceinline__ void operator()(const f32x4 (&acc)[2][2][4][2], const Unit& u, int wr, int wc, int fr, int fq) const {
        const int row0 = u.pm * BM + wr * 64 + fr, col0 = u.pn * BM + wc * 32 + 8 * fq;
#pragma unroll
        for (int ai = 0; ai < 2; ++ai)
#pragma unroll
            for (int m = 0; m < 4; ++m) { const size_t r = (size_t)(row0 + ai * HALF + m * 16);
#pragma unroll
                for (int bj = 0; bj < 2; ++bj) {
                    const u32x4 gv = *(const u32x4*)(gate + r * ldg + col0 + bj * HALF);
                    u32x4 bv = (u32x4){0u, 0u, 0u, 0u}; if (HAS_BASE) bv = *(const u32x4*)(base + r * 1024 + col0 + bj * HALF);
                    const f32x4 a0 = acc[ai][bj][m][0], a1 = acc[ai][bj][m][1];
                    float v[8];
                    v[0] = bf_lo(bv.x) + bf_lo(gv.x) * a0[0]; v[1] = bf_hi(bv.x) + bf_hi(gv.x) * a0[1];
                    v[2] = bf_lo(bv.y) + bf_lo(gv.y) * a0[2]; v[3] = bf_hi(bv.y) + bf_hi(gv.y) * a0[3];
                    v[4] = bf_lo(bv.z) + bf_lo(gv.z) * a1[0]; v[5] = bf_hi(bv.z) + bf_hi(gv.z) * a1[1];
                    v[6] = bf_lo(bv.w) + bf_lo(gv.w) * a1[2]; v[7] = bf_hi(bv.w) + bf_hi(gv.w) * a1[3];
                    u32x4 w; w.x = cvt_pk_bf16(v[0], v[1]); w.y = cvt_pk_bf16(v[2], v[3]); w.z = cvt_pk_bf16(v[4], v[5]); w.w = cvt_pk_bf16(v[6], v[7]);
                    *(u32x4*)(O + r * 1024 + col0 + bj * HALF) = w; } }
    }
};

template <class Epi, class Sched, bool ALIGN_EPI = false, bool SP2 = false>
__device__ __forceinline__ void gemm_phase(PG8_LAS unsigned char* lds, const Gemm g, const Sched& S, const Epi& E) {
    const int tid = threadIdx.x, wid = __builtin_amdgcn_readfirstlane(tid >> 6), lane = tid & 63, wr = wid >> 2, wc = wid & 3, fr = lane & 15, fq = lane >> 4;
    const int K = g.K, nt = K / BK;
    unsigned voffA[2], voffB[2];
#pragma unroll
    for (int i = 0; i < 2; ++i) { int R, C; stage_rc(tid * 16 + i * 8192, R, C); const int Rb = Epi::PERM ? ((R & ~31) + perm32(R & 31)) : R;
        voffA[i] = (unsigned)(R * K + C) * 2u; voffB[i] = (unsigned)(Rb * K + C) * 2u; }
    const size_t kstep = (size_t)(BK * 2);
    const size_t hstep = (size_t)HALF * K * 2;
    const size_t tstep = 2 * hstep;
    const unsigned ldsw = (unsigned)wid * 1024u;
    const int aoff = lds_byte(wr * 64 + fr, fq * 8), boff = lds_byte(wc * 32 + fr, fq * 8);
#define PG8_SA(b, h) (((b) * 2 + (h)) * HTB)
#define PG8_SB(b, h) ((4 + (b) * 2 + (h)) * HTB)
#define PG8_STAGE(bufoff, gbase, voff) do { _Pragma("unroll") for (int _i = 0; _i < 2; ++_i) \
        __builtin_amdgcn_global_load_lds((const unsigned*)((const char*)(gbase) + (voff)[_i]), (PG8_LAS unsigned*)(lds + (bufoff) + ldsw + _i * 8192), 16, 0, 0); } while (0)
#define PG8_LDA(dst, b, h) do { _Pragma("unroll") for (int m = 0; m < 4; ++m) _Pragma("unroll") for (int k = 0; k < 2; ++k) dst[m][k] = *(const PG8_LAS bf16x8*)(lds + PG8_SA(b, h) + aoff + m * 2048 + k * 1024); } while (0)
#define PG8_LDB(dst, b, h) do { _Pragma("unroll") for (int n = 0; n < 2; ++n) _Pragma("unroll") for (int k = 0; k < 2; ++k) dst[n][k] = *(const PG8_LAS bf16x8*)(lds + PG8_SB(b, h) + boff + n * 2048 + k * 1024); } while (0)
#define PG8_MMA(ai, bj, At, Bt) do { __builtin_amdgcn_s_setprio(1); _Pragma("unroll") for (int m = 0; m < 4; ++m) _Pragma("unroll") for (int n = 0; n < 2; ++n) _Pragma("unroll") for (int k = 0; k < 2; ++k) \
        acc[ai][bj][m][n] = __builtin_amdgcn_mfma_f32_16x16x32_bf16(Bt[n][k], At[m][k], acc[ai][bj][m][n], 0, 0, 0); __builtin_amdgcn_s_setprio(0); } while (0)
#define PG8_WAIT_V(n) asm volatile("s_waitcnt vmcnt(" #n ")" ::: "memory")
#define PG8_WAIT_L(n) asm volatile("s_waitcnt lgkmcnt(" #n ")" ::: "memory")
#define PG8_BAR __builtin_amdgcn_s_barrier()
#define PG8_SCHED __builtin_amdgcn_sched_barrier(0)
    Unit cur, nxt; int ui = 0;
    if (!S.next(0, cur)) return;
    f32x4 acc[2][2][4][2];
#pragma unroll
    for (int a = 0; a < 2; ++a)
#pragma unroll
        for (int b = 0; b < 2; ++b)
#pragma unroll
            for (int m = 0; m < 4; ++m)
#pragma unroll
                for (int n = 0; n < 2; ++n) acc[a][b][m][n] = (f32x4){0.f, 0.f, 0.f, 0.f};
    bf16x8 At[4][2], B0[2][2], B1[2][2];
    const char* cA = (const char*)g.A + (size_t)cur.pm * tstep; const char* cB = (const char*)g.Bt + (size_t)cur.pn * tstep;
    S.a_ready(cur);
    if constexpr (SP2) {
        PG8_STAGE(PG8_SB(0, 0), cB, voffB); PG8_STAGE(PG8_SB(0, 1), cB + hstep, voffB); PG8_STAGE(PG8_SA(0, 0), cA, voffA); PG8_STAGE(PG8_SA(0, 1), cA + hstep, voffA);
        if (wr == 1) PG8_BAR;
        PG8_WAIT_V(2); PG8_BAR;
        PG8_STAGE(PG8_SB(1, 0), cB + kstep, voffB); PG8_STAGE(PG8_SA(1, 0), cA + kstep, voffA); PG8_STAGE(PG8_SB(1, 1), cB + hstep + kstep, voffB);
        PG8_WAIT_V(6); PG8_BAR;
    } else {
        PG8_STAGE(PG8_SB(0, 0), cB, voffB); PG8_STAGE(PG8_SA(0, 0), cA, voffA); PG8_STAGE(PG8_SB(0, 1), cB + hstep, voffB); PG8_STAGE(PG8_SA(0, 1), cA + hstep, voffA);
        if (wr == 1) PG8_BAR;
        PG8_WAIT_V(4); PG8_BAR;
        PG8_STAGE(PG8_SB(1, 0), cB + kstep, voffB); PG8_STAGE(PG8_SA(1, 0), cA + kstep, voffA); PG8_STAGE(PG8_SB(1, 1), cB + hstep + kstep, voffB);
        PG8_WAIT_V(6); PG8_BAR;
    }
    for (;;) {
        const bool has_next = S.next(ui + 1, nxt);
        const char* nA = has_next ? (const char*)g.A + (size_t)nxt.pm * tstep : cA; const char* nB = has_next ? (const char*)g.Bt + (size_t)nxt.pn * tstep : cB;
        for (int t = 0; t < nt; t += 2) {
            const bool last = (t == nt - 2);
            const char* a1 = cA + (size_t)(t + 1) * kstep;
            const char* a2 = last ? nA : cA + (size_t)(t + 2) * kstep; const char* b2 = last ? nB : cB + (size_t)(t + 2) * kstep;
            const char* a3 = a2 + kstep; const char* b3 = b2 + kstep;
            if (last && has_next) S.a_ready(nxt);
            if constexpr (SP2) {
            PG8_LDB(B0, 0, 0); PG8_LDB(B1, 0, 1); PG8_SCHED; PG8_LDA(At, 0, 0); PG8_STAGE(PG8_SA(1, 1), a1 + hstep, voffA);
            PG8_WAIT_V(8); PG8_WAIT_L(0); PG8_BAR; PG8_MMA(0, 0, At, B0); PG8_MMA(0, 1, At, B1); PG8_BAR; PG8_SCHED;
            PG8_LDA(At, 0, 1); PG8_STAGE(PG8_SB(0, 0), b2, voffB); PG8_STAGE(PG8_SB(0, 1), b2 + hstep, voffB); PG8_STAGE(PG8_SA(0, 0), a2, voffA);
            PG8_WAIT_V(8); PG8_WAIT_L(0); PG8_BAR; PG8_MMA(1, 0, At, B0); PG8_MMA(1, 1, At, B1); PG8_BAR; PG8_SCHED;
            PG8_LDB(B0, 1, 0); PG8_LDB(B1, 1, 1); PG8_SCHED; PG8_LDA(At, 1, 0); PG8_STAGE(PG8_SA(0, 1), a2 + hstep, voffA);
            PG8_WAIT_V(8); PG8_WAIT_L(0); PG8_BAR; PG8_MMA(0, 0, At, B0); PG8_MMA(0, 1, At, B1); PG8_BAR; PG8_SCHED;
            PG8_LDA(At, 1, 1); PG8_STAGE(PG8_SB(1, 0), b3, voffB); PG8_STAGE(PG8_SB(1, 1), b3 + hstep, voffB); PG8_STAGE(PG8_SA(1, 0), a3, voffA);
            PG8_WAIT_V(8); PG8_WAIT_L(0); PG8_BAR; PG8_MMA(1, 0, At, B0); PG8_MMA(1, 1, At, B1); PG8_BAR; PG8_SCHED;
            } else {
            PG8_LDB(B0, 0, 0); PG8_SCHED; PG8_LDA(At, 0, 0); PG8_STAGE(PG8_SA(1, 1), a1 + hstep, voffA);
            PG8_WAIT_L(8); PG8_BAR; PG8_WAIT_L(0); PG8_MMA(0, 0, At, B0); PG8_BAR; PG8_SCHED;
            PG8_LDB(B1, 0, 1); PG8_STAGE(PG8_SB(0, 0), b2, voffB);
            PG8_BAR; PG8_WAIT_L(0); PG8_MMA(0, 1, At, B1); PG8_BAR;
            PG8_LDA(At, 0, 1); PG8_STAGE(PG8_SA(0, 0), a2, voffA);
            PG8_BAR; PG8_WAIT_L(0); PG8_MMA(1, 0, At, B0); PG8_BAR; PG8_SCHED;
            PG8_STAGE(PG8_SB(0, 1), b2 + hstep, voffB);
            PG8_WAIT_V(6); PG8_BAR; PG8_MMA(1, 1, At, B1); PG8_BAR;
            PG8_LDB(B0, 1, 0); PG8_SCHED; PG8_LDA(At, 1, 0); PG8_STAGE(PG8_SA(0, 1), a2 + hstep, voffA);
            PG8_WAIT_L(8); PG8_BAR; PG8_WAIT_L(0); PG8_MMA(0, 0, At, B0); PG8_BAR; PG8_SCHED;
            PG8_LDB(B1, 1, 1); PG8_STAGE(PG8_SB(1, 0), b3, voffB);
            PG8_BAR; PG8_WAIT_L(0); PG8_MMA(0, 1, At, B1); PG8_BAR;
            PG8_LDA(At, 1, 1); PG8_STAGE(PG8_SA(1, 0), a3, voffA);
            PG8_BAR; PG8_WAIT_L(0); PG8_MMA(1, 0, At, B0); PG8_BAR; PG8_SCHED;
            PG8_STAGE(PG8_SB(1, 1), b3 + hstep, voffB);
            PG8_WAIT_V(6); PG8_BAR; PG8_MMA(1, 1, At, B1); PG8_BAR;
            }
        }
        if constexpr (ALIGN_EPI) { if (wr == 0) PG8_BAR; }
        if constexpr (!Epi::AFTER_DRAIN) { E(acc, cur, wr, wc, fr, fq); S.done(cur); }
        if (!has_next) break;
#pragma unroll
        for (int a = 0; a < 2; ++a)
#pragma unroll
            for (int b = 0; b < 2; ++b)
#pragma unroll
                for (int m = 0; m < 4; ++m)
#pragma unroll
                    for (int n = 0; n < 2; ++n) acc[a][b][m][n] = (f32x4){0.f, 0.f, 0.f, 0.f};
        cur = nxt; cA = nA; cB = nB; ++ui;
        if constexpr (ALIGN_EPI) { if (wr == 1) PG8_BAR; }
    }
    PG8_WAIT_V(0);
    if constexpr (!ALIGN_EPI) { if (wr == 0) PG8_BAR; }
    PG8_BAR;
    if constexpr (Epi::AFTER_DRAIN) { E.fused(acc, cur, wr, wc, fr, fq, lds, wid, lane); S.done(cur); }
#undef PG8_SA
#undef PG8_SB
#undef PG8_STAGE
#undef PG8_LDA
#undef PG8_LDB
#undef PG8_MMA
#undef PG8_WAIT_V
#undef PG8_WAIT_L
#undef PG8_BAR
#undef PG8_SCHED
}
}

#include <hip/hip_cooperative_groups.h>
namespace cg = cooperative_groups;
using pg8::sigmoid_f; using pg8::bf_lo; using pg8::bf_hi;
#define LAS __attribute__((address_space(3)))
typedef unsigned short bf16;
typedef unsigned v4u __attribute__((ext_vector_type(4)));
typedef unsigned v2u __attribute__((ext_vector_type(2)));
typedef float f32x4 __attribute__((ext_vector_type(4)));
typedef float f32x2 __attribute__((ext_vector_type(2)));
typedef short bf16x8 __attribute__((ext_vector_type(8)));
typedef short v4i16_t __attribute__((ext_vector_type(4)));

constexpr int NWAVES = 8, NTHREADS = 512;
constexpr int SEQ = 4096, BATCH = 8, M = BATCH * SEQ, D = 1024, FF = 2816, NIN = 8704, AW = 1536, CW = 31;
constexpr float EPS = 1e-6f;
constexpr size_t MiB = 1u << 20;
constexpr size_t WS_CTL = 0;
constexpr size_t WS_WGU1 = 1 * MiB, WS_WD1 = 12 * MiB, WS_WGU2 = 18 * MiB, WS_WD2 = 29 * MiB, WS_WIN = 35 * MiB, WS_WC = 52 * MiB, WS_WA = 54 * MiB, WS_WO = 55 * MiB;
constexpr size_t WS_H = 58 * MiB;
constexpr size_t WS_ZC = 122 * MiB;
constexpr size_t WS_Q = 186 * MiB;
constexpr size_t WS_K = 282 * MiB;
constexpr size_t WS_V = 378 * MiB;
constexpr size_t WS_LSE = 474 * MiB;
constexpr size_t WS_ATT = 476 * MiB;
constexpr size_t WS_ZG = WS_K;
constexpr size_t WS_G = WS_K;
constexpr size_t WS_T1 = WS_K + 128 * MiB;
constexpr size_t WS_MIX = WS_H;
constexpr size_t WS_A1 = WS_Q;
constexpr size_t WS_END = 508 * MiB;
static_assert(WS_T1 + 64 * MiB <= WS_LSE && WS_A1 + (size_t)M * FF * 2 <= WS_LSE, "ws map");

constexpr int LDS_BYTES = 147456;

__device__ __forceinline__ float wave_sum(float v) {
#pragma unroll
    for (int o = 1; o < 64; o <<= 1) v += __shfl_xor(v, o);
    return v;
}
__device__ __forceinline__ unsigned pk2(float lo, float hi) { return pg8::cvt_pk_bf16(lo, hi); }

__device__ __forceinline__ int dst_row(int map, int n) {
    if (map == 3) { if (n < 1024) map = 1; else if (n < 2048) { map = 2; n -= 1024; } else map = 0; }
    if (map == 0) return n;
    return 256 * (n >> 7) + (n & 127) + (map == 2 ? 128 : 0);
}
__device__ __forceinline__ void transpose_item(const float* W, int K, int N, bf16* WT, int map, LAS float* scr, int item, int lane) {
    const int nblk = N / 32, kb = item / nblk, nb = item % nblk, k0 = 64 * kb, n0 = 32 * nb;
    float wv[32];
#pragma unroll
    for (int i = 0; i < 32; ++i) wv[i] = W[(size_t)(k0 + 2 * i + (lane >> 5)) * N + n0 + (lane & 31)];
#pragma unroll
    for (int i = 0; i < 32; ++i) scr[(2 * i + (lane >> 5)) * 33 + (lane & 31)] = wv[i];
    asm volatile("s_waitcnt lgkmcnt(0)" ::: "memory");
    const int c = lane & 7; const int r0 = dst_row(map, n0);
#pragma unroll
    for (int j = 0; j < 4; ++j) { const int n = (lane >> 3) + 8 * j; const LAS float* s = scr + (8 * c) * 33 + n;
        v4u o; o.x = pk2(s[0 * 33], s[1 * 33]); o.y = pk2(s[2 * 33], s[3 * 33]); o.z = pk2(s[4 * 33], s[5 * 33]); o.w = pk2(s[6 * 33], s[7 * 33]);
        *(v4u*)(WT + (size_t)(r0 + n) * K + k0 + 8 * c) = o; }
    asm volatile("s_waitcnt lgkmcnt(0)" ::: "memory");
}

template <bool OUT_BF16> __device__ __forceinline__ void rms_rows(const float* X, const float* gain, void* out, int gw, int NGW, int lane) {
    f32x4 gv[4];
#pragma unroll
    for (int j = 0; j < 4; ++j) gv[j] = ((const f32x4*)gain)[lane + 64 * j];
    for (int m0 = gw * 4; m0 < M; m0 += NGW * 4) {
        f32x4 v[4][4]; float s[4];
#pragma unroll
        for (int r = 0; r < 4; ++r) { const f32x4* xr = (const f32x4*)(X + (size_t)(m0 + r) * D) + lane;
#pragma unroll
            for (int j = 0; j < 4; ++j) v[r][j] = xr[64 * j]; }
#pragma unroll
        for (int r = 0; r < 4; ++r) { float a = 0.f;
#pragma unroll
            for (int j = 0; j < 4; ++j) a += (v[r][j].x * v[r][j].x + v[r][j].y * v[r][j].y) + (v[r][j].z * v[r][j].z + v[r][j].w * v[r][j].w);
            s[r] = a; }
#pragma unroll
        for (int o = 1; o < 64; o <<= 1) {
#pragma unroll
            for (int r = 0; r < 4; ++r) s[r] += __shfl_xor(s[r], o); }
#pragma unroll
        for (int r = 0; r < 4; ++r) { const float rstd = 1.0f / sqrtf(s[r] * (1.0f / D) + EPS);
            if (OUT_BF16) { v2u* o8 = (v2u*)((bf16*)out + (size_t)(m0 + r) * D) + lane;
#pragma unroll
                for (int j = 0; j < 4; ++j) { v2u w; w.x = pk2(v[r][j].x * rstd * gv[j].x, v[r][j].y * rstd * gv[j].y); w.y = pk2(v[r][j].z * rstd * gv[j].z, v[r][j].w * rstd * gv[j].w); o8[64 * j] = w; }
            } else { f32x4* o = (f32x4*)((float*)out + (size_t)(m0 + r) * D) + lane;
#pragma unroll
                for (int j = 0; j < 4; ++j) o[64 * j] = v[r][j] * rstd * gv[j]; } }
    }
}

constexpr int CT = 16;
__device__ __forceinline__ void conv_phase(const bf16* Zg, const float* dwk, const float* dwb, const float* lng, const float* lnb, bf16* ZC, LAS float* red, int vcu, int G) {
    const int tid = threadIdx.x, lane = tid & 63, wave = tid >> 6, c = 2 * tid;
    float w0[CW], w1[CW];
#pragma unroll
    for (int j = 0; j < CW; ++j) { const f32x2 t = *(const f32x2*)(dwk + j * D + c); w0[j] = t.x; w1[j] = t.y; }
    const f32x2 bb = *(const f32x2*)(dwb + c), gg = *(const f32x2*)(lng + c), lb = *(const f32x2*)(lnb + c);
    constexpr int NT = M / CT; const int tpb = (NT + G - 1) / G; const int tb = vcu * tpb; int te = tb + tpb; if (te > NT) te = NT;
    if (tb >= te) return;
    float z0[CT + CW - 1], z1[CT + CW - 1]; unsigned nx[CT];
    { const int t0 = tb * CT, s0 = t0 & (SEQ - 1);
#pragma unroll
        for (int i = 0; i < CT + CW - 1; ++i) { const bool valid = (s0 + i - (CW - 1)) >= 0; unsigned pk = 0u;
            if (valid) pk = *(const unsigned*)(Zg + (size_t)(t0 + i - (CW - 1)) * D + c);
            z0[i] = bf_lo(pk); z1[i] = bf_hi(pk); } }
    for (int tile = tb; tile < te; ++tile) {
        const int t0 = tile * CT; const bool more = (tile + 1 < te);
        if (more) {
#pragma unroll
            for (int i = 0; i < CT; ++i) nx[i] = *(const unsigned*)(Zg + (size_t)(t0 + CT + i) * D + c); }
        float o0[CT], o1[CT];
#pragma unroll
        for (int t = 0; t < CT; ++t) { o0[t] = bb.x; o1[t] = bb.y; }
#pragma unroll
        for (int j = 0; j < CW; ++j) {
#pragma unroll
            for (int t = 0; t < CT; ++t) { o0[t] += w0[j] * z0[t + j]; o1[t] += w1[j] * z1[t + j]; } }
        { const bool fresh = (((t0 + CT) & (SEQ - 1)) == 0);
#pragma unroll
            for (int i = 0; i < CW - 1; ++i) { z0[i] = fresh ? 0.f : z0[i + CT]; z1[i] = fresh ? 0.f : z1[i + CT]; } }
        { float k32[2 * CT];
#pragma unroll
            for (int t = 0; t < CT; ++t) { k32[2 * t] = o0[t] + o1[t]; k32[2 * t + 1] = o0[t] * o0[t] + o1[t] * o1[t]; }
            float k16[16], k8[8], k4[4], k2[2];
            const bool b5 = (lane & 32) != 0, b4 = (lane & 16) != 0, b3 = (lane & 8) != 0, b2 = (lane & 4) != 0, b1 = (lane & 2) != 0;
#pragma unroll
            for (int k = 0; k < 16; ++k) { const float send = b5 ? k32[k] : k32[16 + k], mine = b5 ? k32[16 + k] : k32[k]; k16[k] = mine + __shfl_xor(send, 32); }
#pragma unroll
            for (int k = 0; k < 8; ++k) { const float send = b4 ? k16[k] : k16[8 + k], mine = b4 ? k16[8 + k] : k16[k]; k8[k] = mine + __shfl_xor(send, 16); }
#pragma unroll
            for (int k = 0; k < 4; ++k) { const float send = b3 ? k8[k] : k8[4 + k], mine = b3 ? k8[4 + k] : k8[k]; k4[k] = mine + __shfl_xor(send, 8); }
#pragma unroll
            for (int k = 0; k < 2; ++k) { const float send = b2 ? k4[k] : k4[2 + k], mine = b2 ? k4[2 + k] : k4[k]; k2[k] = mine + __shfl_xor(send, 4); }
            const float send1 = b1 ? k2[0] : k2[1], mine1 = b1 ? k2[1] : k2[0]; float tot = mine1 + __shfl_xor(send1, 2);
            tot += __shfl_xor(tot, 1);
            if ((lane & 1) == 0) red[(lane >> 1) * 8 + wave] = tot; }
        __syncthreads();
        if (tid < CT) {
            const f32x4 a = *(const LAS f32x4*)(red + (2 * tid) * 8), b = *(const LAS f32x4*)(red + (2 * tid) * 8 + 4);
            const f32x4 p = *(const LAS f32x4*)(red + (2 * tid + 1) * 8), q = *(const LAS f32x4*)(red + (2 * tid + 1) * 8 + 4);
            const float s1 = ((a.x + a.y) + (a.z + a.w)) + ((b.x + b.y) + (b.z + b.w)), s2 = ((p.x + p.y) + (p.z + p.w)) + ((q.x + q.y) + (q.z + q.w));
            const float mu = s1 * (1.0f / D); const float var = fmaxf(s2 * (1.0f / D) - mu * mu, 0.f);
            *(LAS f32x2*)(red + 256 + 2 * tid) = (f32x2){mu, 1.0f / sqrtf(var + EPS)}; }
        __syncthreads();
        unsigned* outp = (unsigned*)(ZC + (size_t)t0 * D + c);
#pragma unroll
        for (int t = 0; t < CT; ++t) { const f32x2 st = *(const LAS f32x2*)(red + 256 + 2 * t);
            float y0 = (o0[t] - st.x) * st.y * gg.x + lb.x, y1 = (o1[t] - st.x) * st.y * gg.y + lb.y;
            y0 = y0 * sigmoid_f(y0); y1 = y1 * sigmoid_f(y1);
            outp[(size_t)t * (D / 2)] = pk2(y0, y1); }
        if (more) {
#pragma unroll
            for (int i = 0; i < CT; ++i) { z0[CW - 1 + i] = bf_lo(nx[i]); z1[CW - 1 + i] = bf_hi(nx[i]); } }
        __syncthreads();
    }
}

constexpr int VROW = 272;
constexpr int ATT_UNITS = BATCH * 12 * 32;
__device__ __forceinline__ v4i16_t tr16(const LAS unsigned char* p) { return __builtin_amdgcn_ds_read_tr16_b64_v4i16((LAS v4i16_t*)p); }
struct AttnPre { v4u k[4], v[4]; bf16x8 q[4]; };
struct AttnIdx { size_t row0; int hg, dsh, n; };
__device__ __forceinline__ AttnIdx attn_decode(int unit) {
    AttnIdx x; const int bh = unit >> 5, j = unit & 31; x.hg = bh % 12; const int gi = x.hg >> 2;
    x.dsh = 2 * gi; const int nbsh = 5 - x.dsh;
    x.n = j & ((1 << nbsh) - 1);
    x.row0 = (size_t)bh * SEQ + (size_t)j * 128; return x;
}
constexpr int ATT_HB = 128 * VROW;
constexpr int ATT_KOFF = 0, ATT_VOFF = 2 * ATT_HB;
__device__ __forceinline__ void attn_load_kv(AttnPre& p, const bf16* K, const bf16* V, size_t r0, int tid) {
#pragma unroll
    for (int i = 0; i < 4; ++i) { const size_t off = r0 * 128 + (size_t)(tid + 512 * i) * 8; p.k[i] = *(const v4u*)(K + off); p.v[i] = *(const v4u*)(V + off); }
}
__device__ __forceinline__ void attn_load(AttnPre& p, const bf16* Q, const bf16* K, const bf16* V, int unit, int tid, int w, int lq, int g) {
    const AttnIdx x = attn_decode(unit);
    attn_load_kv(p, K, V, x.row0, tid);
#pragma unroll
    for (int s = 0; s < 4; ++s) p.q[s] = *(const bf16x8*)(Q + (x.row0 + 16 * w + lq) * 128 + 32 * s + 8 * g);
}
__device__ __forceinline__ void attn_stage(LAS unsigned char* lds, const AttnPre& p, int half, int tid) {
#pragma unroll
    for (int i = 0; i < 4; ++i) { const int cidx = tid + 512 * i, row = cidx >> 4, ch = cidx & 15;
        *(LAS v4u*)(lds + ATT_KOFF + half * ATT_HB + row * VROW + ch * 16) = p.k[i]; *(LAS v4u*)(lds + ATT_VOFF + half * ATT_HB + row * VROW + ch * 16) = p.v[i]; }
}
__device__ __forceinline__ void attn_compute(LAS unsigned char* lds, const bf16x8 (&qf)[4], bf16* O, float* LSE, int unit, int f, int lane, int w, int lq, int g) {
    const AttnIdx x = attn_decode(unit); const int hg = x.hg, n = x.n;
    int rowT[9];
#pragma unroll
    for (int T = 0; T < 9; ++T) { const int kk0 = 16 * w + 16 * T; rowT[T] = ((((kk0 >> 7) ^ f) & 1) << 7) + (kk0 & 127); }
    f32x4 st[9];
    const LAS unsigned char* kb = lds + ATT_KOFF + lq * VROW + 16 * g;
#pragma unroll
    for (int T = 0; T < 9; ++T) { f32x4 a = (f32x4){0.f, 0.f, 0.f, 0.f}; const LAS unsigned char* kp = kb + rowT[T] * VROW;
#pragma unroll
        for (int s = 0; s < 4; ++s) { const bf16x8 kf = *(const LAS bf16x8*)(kp + 64 * s); a = __builtin_amdgcn_mfma_f32_16x16x32_bf16(kf, qf[s], a, 0, 0, 0); }
        st[T] = a; }
    const float slope2 = __builtin_amdgcn_exp2f(-(float)(8 * (hg + 1)) * (1.0f / 12.0f)) * (float)(1 << x.dsh) * 1.4426950408889634f;
    float mx = -__builtin_inff();
#pragma unroll
    for (int T = 0; T < 9; ++T)
#pragma unroll
        for (int reg = 0; reg < 4; ++reg) { const int steps = 128 + lq - 16 * T - 4 * g - reg, ki = 16 * w + 16 * T + 4 * g + reg;
            const bool valid = (steps >= 0) && (steps <= 128) && (n > 0 || ki >= 128);
            const float v = valid ? st[T][reg] - slope2 * (float)steps : -__builtin_inff(); st[T][reg] = v; mx = fmaxf(mx, v); }
    mx = fmaxf(mx, __shfl_xor(mx, 16)); mx = fmaxf(mx, __shfl_xor(mx, 32));
    float sum = 0.f;
#pragma unroll
    for (int T = 0; T < 9; ++T)
#pragma unroll
        for (int reg = 0; reg < 4; ++reg) { const float p = __builtin_amdgcn_exp2f(st[T][reg] - mx); st[T][reg] = p; sum += p; }
    sum += __shfl_xor(sum, 16); sum += __shfl_xor(sum, 32);
    bf16x8 pf[5];
#pragma unroll
    for (int u = 0; u < 5; ++u) { v4u t; t.x = pk2(st[2 * u][0], st[2 * u][1]); t.y = pk2(st[2 * u][2], st[2 * u][3]);
        if (u < 4) { t.z = pk2(st[2 * u + 1][0], st[2 * u + 1][1]); t.w = pk2(st[2 * u + 1][2], st[2 * u + 1][3]); } else { t.z = 0u; t.w = 0u; }
        pf[u] = __builtin_bit_cast(bf16x8, t); }
    const LAS unsigned char* vb = lds + ATT_VOFF + (4 * g + ((lane & 15) >> 2)) * VROW + (lane & 3) * 16;
    f32x4 o[4][2];
#pragma unroll
    for (int cp = 0; cp < 4; ++cp) { o[cp][0] = (f32x4){0.f, 0.f, 0.f, 0.f}; o[cp][1] = (f32x4){0.f, 0.f, 0.f, 0.f}; }
#pragma unroll
    for (int u = 0; u < 5; ++u) { const LAS unsigned char* vlo = vb + rowT[2 * u] * VROW; const LAS unsigned char* vhi = vb + rowT[u < 4 ? 2 * u + 1 : 8] * VROW;
#pragma unroll
        for (int cp = 0; cp < 4; ++cp)
#pragma unroll
            for (int h2 = 0; h2 < 2; ++h2) {
                const v4i16_t lo = tr16(vlo + cp * 64 + h2 * 8), hi = tr16(vhi + cp * 64 + h2 * 8);
                const bf16x8 vf = (bf16x8){lo[0], lo[1], lo[2], lo[3], hi[0], hi[1], hi[2], hi[3]};
                o[cp][h2] = __builtin_amdgcn_mfma_f32_16x16x32_bf16(vf, pf[u], o[cp][h2], 0, 0, 0); } }
    const float inv = 1.0f / sum;
    const size_t rq = x.row0 + 16 * w + lq;
    bf16* op = O + rq * 128 + 8 * g;
#pragma unroll
    for (int cp = 0; cp < 4; ++cp) { const f32x4 a = o[cp][0] * inv, c = o[cp][1] * inv;
        v4u t; t.x = pk2(a[0], a[1]); t.y = pk2(a[2], a[3]); t.z = pk2(c[0], c[1]); t.w = pk2(c[2], c[3]);
        *(v4u*)(op + 32 * cp) = t; }
    if (g == 0) LSE[rq] = mx + __builtin_amdgcn_logf(sum);
}
__device__ __forceinline__ void attn_phase(LAS unsigned char* lds, const bf16* Q, const bf16* K, const bf16* V, bf16* O, float* LSE, int vcu, int G) {
    const int tid = threadIdx.x, lane = tid & 63, w = __builtin_amdgcn_readfirstlane(tid >> 6), lq = lane & 15, g = lane >> 4;
    const int upb = (ATT_UNITS + G - 1) / G; const int u0 = vcu * upb; int u1 = u0 + upb; if (u1 > ATT_UNITS) u1 = ATT_UNITS;
    if (u0 >= u1) return;
    for (int i = tid; i < 4 * ATT_HB / 16; i += NTHREADS) ((LAS v4u*)lds)[i] = (v4u){0u, 0u, 0u, 0u};
    __syncthreads();
    AttnPre pre; int f = 0;
    { const AttnIdx x0 = attn_decode(u0); if (x0.n > 0) { attn_load_kv(pre, K, V, x0.row0 - 128, tid); attn_stage(lds, pre, f, tid); } }
    attn_load(pre, Q, K, V, u0, tid, w, lq, g);
    for (int u = u0; u < u1; ++u) {
        bf16x8 qf[4];
#pragma unroll
        for (int s = 0; s < 4; ++s) qf[s] = pre.q[s];
        attn_stage(lds, pre, f ^ 1, tid);
        __syncthreads();
        if (u + 1 < u1) attn_load(pre, Q, K, V, u + 1, tid, w, lq, g);
        attn_compute(lds, qf, O, LSE, u, f, lane, w, lq, g);
        __syncthreads();
        f ^= 1;
    }
}

__device__ __forceinline__ void merge_rows(const bf16* OG, const float* LSE, bf16* ATT, int gw, int NGW, int lane) {
    const int hh = lane >> 4, c0 = (lane & 15) * 8;
    for (int m0 = gw * 4; m0 < M; m0 += NGW * 4) {
        float l[4][3]; v4u a[4][3];
#pragma unroll
        for (int r = 0; r < 4; ++r) { const int m = m0 + r, b = m >> 12, s = m & 4095;
#pragma unroll
            for (int gi = 0; gi < 3; ++gi) { const int dsh = 2 * gi; const int pos = ((s & ((1 << dsh) - 1)) << (12 - dsh)) + (s >> dsh);
                const size_t row = (size_t)(b * 12 + gi * 4 + hh) * 4096 + pos; l[r][gi] = LSE[row]; a[r][gi] = *(const v4u*)(OG + row * 128 + c0); } }
#pragma unroll
        for (int r = 0; r < 4; ++r) {
            const float mx = fmaxf(l[r][0], fmaxf(l[r][1], l[r][2]));
            float e0 = __builtin_amdgcn_exp2f(l[r][0] - mx), e1 = __builtin_amdgcn_exp2f(l[r][1] - mx), e2 = __builtin_amdgcn_exp2f(l[r][2] - mx);
            const float inv = 1.0f / (e0 + e1 + e2); e0 *= inv; e1 *= inv; e2 *= inv;
            const v4u A = a[r][0], B = a[r][1], C = a[r][2]; v4u o;
            o.x = pk2(e0 * bf_lo(A.x) + e1 * bf_lo(B.x) + e2 * bf_lo(C.x), e0 * bf_hi(A.x) + e1 * bf_hi(B.x) + e2 * bf_hi(C.x));
            o.y = pk2(e0 * bf_lo(A.y) + e1 * bf_lo(B.y) + e2 * bf_lo(C.y), e0 * bf_hi(A.y) + e1 * bf_hi(B.y) + e2 * bf_hi(C.y));
            o.z = pk2(e0 * bf_lo(A.z) + e1 * bf_lo(B.z) + e2 * bf_lo(C.z), e0 * bf_hi(A.z) + e1 * bf_hi(B.z) + e2 * bf_hi(C.z));
            o.w = pk2(e0 * bf_lo(A.w) + e1 * bf_lo(B.w) + e2 * bf_lo(C.w), e0 * bf_hi(A.w) + e1 * bf_hi(B.w) + e2 * bf_hi(C.w));
            *(v4u*)(ATT + (size_t)(m0 + r) * 512 + hh * 128 + c0) = o; }
    }
}

#define XB_TMO      128
#define XB_XCNT(j)  (256  + 64 * (j))
#define XB_XSUB(j)  (1280 + 64 * (j))
#define XB_XGEN(j)  (2304 + 64 * (j))
#define XB_TOP      3328
#define XB_TOPGEN   3392
#define XCD_BAR_WORDS 3456
#define XB_SPIN_CAP (1u << 18)

__device__ __forceinline__ unsigned xb_ld(unsigned* p)              { return __hip_atomic_load(p, __ATOMIC_RELAXED, __HIP_MEMORY_SCOPE_AGENT); }
__device__ __forceinline__ unsigned xb_add(unsigned* p, unsigned v) { return __hip_atomic_fetch_add(p, v, __ATOMIC_RELAXED, __HIP_MEMORY_SCOPE_AGENT); }
__device__ __forceinline__ unsigned xb_xcc_id() { return (unsigned)__builtin_amdgcn_s_getreg((3 << 11) | 20) & 0xFu; }
#define XB_SPIN(cond, bar) do { unsigned _sp = 0; while (cond) { __builtin_amdgcn_s_sleep(1); \
    if ((++_sp & 255u) == 0u) { if (xb_ld(&(bar)[XB_TMO])) break; if (_sp > XB_SPIN_CAP) { atomicAdd(&(bar)[XB_TMO], 1u); break; } } } } while (0)

struct XcdBarrier {
    unsigned* bar; unsigned x;
    volatile LAS unsigned* st;
};

__device__ __forceinline__ XcdBarrier xcd_barrier_post(unsigned* bar, volatile LAS unsigned* st) {
    XcdBarrier b; b.bar = bar; b.x = xb_xcc_id(); b.st = st;
    if (threadIdx.x == 0) (void)xb_add(&bar[XB_XCNT(b.x)], 1u);
    return b;
}
__device__ __forceinline__ void xcd_barrier_complete(unsigned* bar, unsigned x, unsigned& nloc, unsigned& nx) {
    const unsigned G = gridDim.x * gridDim.y * gridDim.z;
    unsigned sum, cnt, mine, sp = 0u;
    for (;;) {
        sum = 0u; cnt = 0u; mine = 0u;
#pragma unroll
        for (unsigned j = 0; j < 16; ++j) { const unsigned c = xb_ld(&bar[XB_XCNT(j)]); sum += c; cnt += (c > 0u) ? 1u : 0u; mine = (j == x) ? c : mine; }
        if (sum == G) break;
        __builtin_amdgcn_s_sleep(1);
        if ((++sp & 255u) == 0u) { if (xb_ld(&bar[XB_TMO])) break; if (sp > XB_SPIN_CAP) { atomicAdd(&bar[XB_TMO], 1u); break; } }
    }
    nloc = mine > 0u ? mine : 1u; nx = cnt > 0u ? cnt : 1u;
}

__device__ __forceinline__ void xcd_barrier(const XcdBarrier& b) {
    asm volatile("s_waitcnt vmcnt(0)" ::: "memory");
    __syncthreads();
    if (threadIdx.x == 0) {
        unsigned* bar = b.bar;
        __builtin_amdgcn_s_waitcnt(0);
        unsigned nloc = b.st[0], nx = b.st[1];
        if (nloc == 0u) { xcd_barrier_complete(bar, b.x, nloc, nx); b.st[0] = nloc; b.st[1] = nx; }
        const unsigned old = xb_add(&bar[XB_XSUB(b.x)], 1u);
        const unsigned gen = old / nloc;
        if (old + 1u == (gen + 1u) * nloc) {
            __builtin_amdgcn_fence(__ATOMIC_RELEASE, "agent");
            asm volatile("s_waitcnt vmcnt(0)" ::: "memory");
            const unsigned og = xb_add(&bar[XB_TOP], 1u);
            const unsigned tg = og / nx;
            if (og + 1u == (tg + 1u) * nx) xb_add(&bar[XB_TOPGEN], 1u);
            else XB_SPIN(xb_ld(&bar[XB_TOPGEN]) == tg, bar);
            __builtin_amdgcn_fence(__ATOMIC_ACQUIRE, "agent");
            xb_add(&bar[XB_XGEN(b.x)], 1u);
            asm volatile("s_waitcnt vmcnt(0)" ::: "memory");
        } else {
            XB_SPIN(xb_ld(&bar[XB_XGEN(b.x)]) == gen, bar);
            __builtin_amdgcn_fence(__ATOMIC_ACQUIRE, "agent");
            asm volatile("s_waitcnt vmcnt(0)" ::: "memory");
        }
    }
    __syncthreads();
}

struct Args { const float* in[19]; float* out; unsigned char* ws; int ph_lo, ph_hi; };
#ifndef MK_MULTI
#define MK_MULTI 0
#endif
#if MK_MULTI
#define GRID_SYNC() do { } while (0)
#else
#ifndef MK_CG
#define MK_CG 0
#endif
#if MK_CG
#define GRID_SYNC() do { __threadfence(); cg::this_grid().sync(); } while (0)
#else
#define GRID_SYNC() xcd_barrier(xbar)
#endif
#endif

__global__ void __launch_bounds__(NTHREADS, 2) fwd_kernel(Args args) {
    extern __shared__ __attribute__((aligned(16))) unsigned char lds_raw[];
    LAS unsigned char* lds = (LAS unsigned char*)lds_raw;
    const int tid = threadIdx.x, lane = tid & 63, wave = __builtin_amdgcn_readfirstlane(tid >> 6);
    const int G = gridDim.x, bx = blockIdx.x; const int vcu = (G % 8 == 0) ? (bx % 8) * (G / 8) + bx / 8 : bx;
    const int gw = vcu * NWAVES + wave, NGW = G * NWAVES;
    unsigned char* ws = args.ws;
#if !MK_MULTI && !MK_CG
    volatile LAS unsigned* xst = (volatile LAS unsigned*)(lds + LDS_BYTES - 128);
    if (tid < 2) xst[tid] = 0u;
    __syncthreads();
    XcdBarrier xbar = xcd_barrier_post((unsigned*)(ws + WS_CTL), xst);
#endif
    const float* x = args.in[0];
    float* X = args.out;
    bf16* Wgu1 = (bf16*)(ws + WS_WGU1); bf16* Wd1 = (bf16*)(ws + WS_WD1); bf16* Wgu2 = (bf16*)(ws + WS_WGU2); bf16* Wd2 = (bf16*)(ws + WS_WD2);
    bf16* Win = (bf16*)(ws + WS_WIN); bf16* Wc = (bf16*)(ws + WS_WC); bf16* Wa = (bf16*)(ws + WS_WA); bf16* Wo = (bf16*)(ws + WS_WO);
    bf16* H = (bf16*)(ws + WS_H); bf16* ZC = (bf16*)(ws + WS_ZC); bf16* Qb = (bf16*)(ws + WS_Q); bf16* Kb = (bf16*)(ws + WS_K); bf16* Vb = (bf16*)(ws + WS_V);
    float* LSE = (float*)(ws + WS_LSE); bf16* ATT = (bf16*)(ws + WS_ATT); bf16* ZG = (bf16*)(ws + WS_ZG); bf16* GT = (bf16*)(ws + WS_G);
    bf16* T1 = (bf16*)(ws + WS_T1); bf16* MIX = (bf16*)(ws + WS_MIX); bf16* A1 = (bf16*)(ws + WS_A1);
    const int lo = args.ph_lo, hi = args.ph_hi;
#define IN(k) (lo <= (k) && (k) < hi)
#define SEAM(k) do { if (IN(k) && IN((k) + 1)) GRID_SYNC(); } while (0)
#define GEMM_PHASE(EPI, Aptr, Bptr, Nn, Kk, ...) do { pg8::Gemm g_{Aptr, Bptr, M, Nn, Kk}; pg8::StaticOrder S_; S_.init(M, Nn, G, bx); EPI E_{__VA_ARGS__}; \
        pg8::gemm_phase<EPI, pg8::StaticOrder, true, true>(lds, g_, S_, E_); } while (0)

    if (IN(0)) {
        LAS float* scr = (LAS float*)(lds + wave * 16384);
        constexpr int I_GU = 16 * 88, I_DN = 44 * 32, I_IN = 16 * 272, I_C = 16 * 32, I_A = 8 * 32;
        constexpr int NITEMS = 6 * I_GU + I_IN + 2 * I_C + I_A;
        static_assert(I_DN == I_GU, "items");
        for (int it = gw; it < NITEMS; it += NGW) {
            int r = it;
            if (r < I_GU) { transpose_item(args.in[2], D, FF, Wgu1, 1, scr, r, lane); continue; } r -= I_GU;
            if (r < I_GU) { transpose_item(args.in[3], D, FF, Wgu1, 2, scr, r, lane); continue; } r -= I_GU;
            if (r < I_GU) { transpose_item(args.in[4], FF, D, Wd1, 0, scr, r, lane); continue; } r -= I_GU;
            if (r < I_GU) { transpose_item(args.in[15], D, FF, Wgu2, 1, scr, r, lane); continue; } r -= I_GU;
            if (r < I_GU) { transpose_item(args.in[16], D, FF, Wgu2, 2, scr, r, lane); continue; } r -= I_GU;
            if (r < I_GU) { transpose_item(args.in[17], FF, D, Wd2, 0, scr, r, lane); continue; } r -= I_GU;
            if (r < I_IN) { transpose_item(args.in[6], D, NIN, Win, 3, scr, r, lane); continue; } r -= I_IN;
            if (r < I_C) { transpose_item(args.in[11], D, D, Wc, 0, scr, r, lane); continue; } r -= I_C;
            if (r < I_A) { transpose_item(args.in[12], 512, D, Wa, 0, scr, r, lane); continue; } r -= I_A;
            transpose_item(args.in[13], D, D, Wo, 0, scr, r, lane);
        }
        rms_rows<true>(x, args.in[1], H, gw, NGW, lane);
        __syncthreads();
    }
    SEAM(0);
    if (IN(1)) GEMM_PHASE(pg8::EpiPair<0>, H, Wgu1, 2 * FF, D, A1, FF);
    SEAM(1);
    if (IN(2)) GEMM_PHASE(pg8::EpiResid, A1, Wd1, D, FF, x, X, D, 0.5f);
    SEAM(2);
    if (IN(3)) rms_rows<true>(X, args.in[5], H, gw, NGW, lane);
    SEAM(3);
    if (IN(4)) GEMM_PHASE(pg8::EpiPair<1>, H, Win, 2048, D, ZG, D);
    SEAM(4);
    if (IN(5)) conv_phase(ZG, args.in[7], args.in[8], args.in[9], args.in[10], ZC, (LAS float*)lds, vcu, G);
    SEAM(5);
    if (IN(6)) GEMM_PHASE(pg8::EpiQKV, H, Win + (size_t)2048 * D, 3 * AW, D, Qb, (size_t)(WS_K - WS_Q) / 2, 0.08838834764831845f * 1.4426950408889634f);
    SEAM(6);
    if (IN(7)) attn_phase(lds, Qb, Kb, Vb, Qb, LSE, vcu, G);
    SEAM(7);
    if (IN(8)) { merge_rows(Qb, LSE, ATT, gw, NGW, lane); __syncthreads(); }
    if (IN(8)) GEMM_PHASE(pg8::EpiSig, H, Win + (size_t)6656 * D, 2048, D, GT, 2048);
    SEAM(8);
    if (IN(9)) GEMM_PHASE(pg8::EpiGate<false>, ZC, Wc, D, D, nullptr, GT, 2048, T1);
    if (IN(10)) GEMM_PHASE(pg8::EpiGate<true>, ATT, Wa, D, 512, T1, GT + 1024, 2048, MIX);
    SEAM(10);
    if (IN(11)) GEMM_PHASE(pg8::EpiResid, MIX, Wo, D, D, X, X, D, 1.0f);
    SEAM(11);
    if (IN(12)) rms_rows<true>(X, args.in[14], H, gw, NGW, lane);
    SEAM(12);
    if (IN(13)) GEMM_PHASE(pg8::EpiPair<0>, H, Wgu2, 2 * FF, D, A1, FF);
    SEAM(13);
    if (IN(14)) GEMM_PHASE(pg8::EpiResid, A1, Wd2, D, FF, X, X, D, 0.5f);
    SEAM(14);
    if (IN(15)) rms_rows<false>(X, args.in[18], X, gw, NGW, lane);
#undef IN
#undef SEAM
}
constexpr int NPHASES = 16;

extern "C" void kernel_launch(void* const* d_in, const int* in_sizes, int n_in, void* d_out, int out_size, void* d_ws, size_t ws_size, hipStream_t stream) {
    static int grid = 0;
    if (grid == 0) {
        if (n_in != 19 || out_size != M * D || ws_size < WS_END) { fprintf(stderr, "kernel_launch: unexpected shapes (n_in %d out %d ws %zu)\n", n_in, out_size, ws_size); grid = -1; return; }
        int dev = 0, cus = 0, per_cu = 0;
        hipGetDevice(&dev); hipDeviceGetAttribute(&cus, hipDeviceAttributeMultiprocessorCount, dev);
        if (hipFuncSetAttribute((const void*)fwd_kernel, hipFuncAttributeMaxDynamicSharedMemorySize, LDS_BYTES) != hipSuccess) { fprintf(stderr, "kernel_launch: hipFuncSetAttribute failed\n"); grid = -1; return; }
        if (hipOccupancyMaxActiveBlocksPerMultiprocessor(&per_cu, (const void*)fwd_kernel, NTHREADS, LDS_BYTES) != hipSuccess || per_cu < 1) { fprintf(stderr, "kernel_launch: occupancy query says %d\n", per_cu); per_cu = 1; }
        (void)hipGetLastError();
        if (per_cu > 1) per_cu = 1;
        grid = cus * per_cu;
    }
    if (grid < 0) return;
    Args a{};
    for (int i = 0; i < 19; ++i) a.in[i] = (const float*)d_in[i];
    a.out = (float*)d_out; a.ws = (unsigned char*)d_ws;
#if MK_MULTI
    for (int p = 0; p < NPHASES; ++p) { a.ph_lo = p; a.ph_hi = p + 1; hipLaunchKernelGGL(fwd_kernel, dim3(grid), dim3(NTHREADS), LDS_BYTES, stream, a); }
#else
    a.ph_lo = 0; a.ph_hi = NPHASES;
#if MK_CG
    void* kargs[] = {&a};
    hipError_t e = hipLaunchCooperativeKernel((const void*)fwd_kernel, dim3(grid), dim3(NTHREADS), kargs, LDS_BYTES, stream);
    if (e != hipSuccess) fprintf(stderr, "cooperative launch failed: %s (grid %d)\n", hipGetErrorString(e), grid);
#else
    if (hipMemsetAsync((char*)d_ws + WS_CTL, 0, 65536, stream) != hipSuccess) { fprintf(stderr, "kernel_launch: memset failed\n"); return; }
    hipLaunchKernelGGL(fwd_kernel, dim3(grid), dim3(NTHREADS), LDS_BYTES, stream, a);
#endif
#endif
}
```

```cpp
#include <hip/hip_runtime.h>
#include <cstdio>
#include <cstdint>
namespace pg8 {
#define PG8_LAS __attribute__((address_space(3)))
typedef unsigned short bf16_t;
typedef short bf16x8 __attribute__((ext_vector_type(8)));
typedef float f32x4 __attribute__((ext_vector_type(4)));
typedef unsigned u32x4 __attribute__((ext_vector_type(4)));
constexpr int BM = 256, BK = 64, HALF = 128, HTB = HALF * BK * 2  , STAGE_BYTES = 8 * HTB, NXCD = 8, WGM = 8;

__host__ __device__ __forceinline__ int lds_byte(int r, int c) { const int st = (r >> 4) * 2 + (c >> 5), rr = r & 15, cc = c & 31, ob = rr * 64 + cc * 2; return st * 1024 + (ob ^ (((ob >> 9) & 1) << 5)); }
__host__ __device__ __forceinline__ void stage_rc(int b, int& R, int& C) { const int st = b / 1024, sb = b % 1024, swz = sb ^ (((sb >> 9) & 1) << 5); R = (st >> 1) * 16 + swz / 64; C = (st & 1) * 32 + (swz % 64) / 2; }
__host__ __device__ __forceinline__ int perm32(int rho) { const int n = rho >> 4, i = rho & 15; return 8 * (i >> 2) + 4 * n + (i & 3); }

struct Unit { int pm, pn; };
struct Gemm { const bf16_t* A; const bf16_t* Bt; int M, N, K; };

struct StaticOrder {
    int nM, nN, nwg, G, c;
    __host__ __device__ void init(int M, int N, int G_, int c_) { nM = M / BM; nN = N / BM; nwg = nM * nN; G = G_; c = c_; }
    __host__ __device__ bool next(int i, Unit& u) const {
        const long L = (long)i * G + c; if (L >= nwg) return false;
        int wgid = (int)L; { const int q = nwg / NXCD, r = nwg % NXCD, xcd = wgid % NXCD, off = wgid / NXCD; wgid = (xcd < r ? xcd * (q + 1) : r * (q + 1) + (xcd - r) * q) + off; }
        const int nig = WGM * nN, gid = wgid / nig, fm = gid * WGM, gsz = (nM - fm) < WGM ? (nM - fm) : WGM;
        u.pm = fm + ((wgid % nig) % gsz); u.pn = (wgid % nig) / gsz; return true;
    }
    __device__ __forceinline__ void a_ready(const Unit&) const {}
    __device__ __forceinline__ void done(const Unit&) const {}
};

typedef float f32x2_t __attribute__((ext_vector_type(2))); typedef __bf16 bf16x2_t __attribute__((ext_vector_type(2)));
__device__ __forceinline__ unsigned cvt_pk_bf16(float lo, float hi) { const f32x2_t v = {lo, hi}; const bf16x2_t b = __builtin_convertvector(v, bf16x2_t); return __builtin_bit_cast(unsigned, b); }
typedef float f32x2 __attribute__((ext_vector_type(2)));
__device__ __forceinline__ float sigmoid_f(float x) { return __builtin_amdgcn_rcpf(1.0f + __builtin_amdgcn_exp2f(-1.4426950408889634f * x)); }
__device__ __forceinline__ float bf_lo(unsigned u) { return __uint_as_float(u << 16); }
__device__ __forceinline__ float bf_hi(unsigned u) { return __uint_as_float(u & 0xffff0000u); }

template <int ACT> struct EpiPair {
    static constexpr bool PERM = true, AFTER_DRAIN = false;
    bf16_t* O; int ldo;
    __device__ __forceinline__ void operator()(const f32x4 (&acc)[2][2][4][2], const Unit& u, int wr, int wc, int fr, int fq) const {
        const int row0 = u.pm * BM + wr * 64 + fr, col0 = u.pn * HALF + wc * 32 + 8 * fq;
#pragma unroll
        for (int ai = 0; ai < 2; ++ai)
#pragma unroll
            for (int m = 0; m < 4; ++m) {
                float v[8];
#pragma unroll
                for (int n = 0; n < 2; ++n)
#pragma unroll
                    for (int i = 0; i < 4; ++i) { const float a = acc[ai][0][m][n][i], b = acc[ai][1][m][n][i];
                        v[n * 4 + i] = (ACT == 0) ? a * sigmoid_f(a) * b : a * sigmoid_f(b); }
                u32x4 w; w.x = cvt_pk_bf16(v[0], v[1]); w.y = cvt_pk_bf16(v[2], v[3]); w.z = cvt_pk_bf16(v[4], v[5]); w.w = cvt_pk_bf16(v[6], v[7]);
                *(u32x4*)(O + (size_t)(row0 + ai * HALF + m * 16) * ldo + col0) = w; }
    }
};
struct EpiResid {
    static constexpr bool PERM = true, AFTER_DRAIN = false;
    const float* base; float* out; int ldo; float alpha; bf16_t* outb;
    __device__ __forceinline__ void operator()(const f32x4 (&acc)[2][2][4][2], const Unit& u, int wr, int wc, int fr, int fq) const {
        const int row0 = u.pm * BM + wr * 64 + fr, col0 = u.pn * BM + wc * 32 + 8 * fq;
#pragma unroll
        for (int ai = 0; ai < 2; ++ai)
#pragma unroll
            for (int m = 0; m < 4; ++m) { const size_t off = (size_t)(row0 + ai * HALF + m * 16) * ldo + col0;
#pragma unroll
                for (int bj = 0; bj < 2; ++bj) { f32x4 v[2];
#pragma unroll
                    for (int n = 0; n < 2; ++n) { const f32x4 bs = *(const f32x4*)(base + off + bj * HALF + 4 * n); v[n] = bs + acc[ai][bj][m][n] * alpha; }
                    if (outb) { u32x4 w; w.x = cvt_pk_bf16(v[0][0], v[0][1]); w.y = cvt_pk_bf16(v[0][2], v[0][3]); w.z = cvt_pk_bf16(v[1][0], v[1][1]); w.w = cvt_pk_bf16(v[1][2], v[1][3]);
                        *(u32x4*)(outb + off + bj * HALF) = w; }
                    else { *(f32x4*)(out + off + bj * HALF) = v[0]; *(f32x4*)(out + off + bj * HALF + 4) = v[1]; } } }
    }
};
struct EpiQKV {
    static constexpr bool PERM = true, AFTER_DRAIN = false;
    bf16_t* O; size_t tstride; float qscale;
    __device__ __forceinline__ void operator()(const f32x4 (&acc)[2][2][4][2], const Unit& u, int wr, int wc, int fr, int fq) const {
        const int row0 = u.pm * BM + wr * 64 + fr; const int t = u.pn / 6, ct = u.pn - 6 * t, dsh = 2 * (ct >> 1);
        bf16_t* base = O + (size_t)t * tstride + wc * 32 + 8 * fq; const float sc = (t == 0) ? qscale : 1.0f;
#pragma unroll
        for (int ai = 0; ai < 2; ++ai)
#pragma unroll
            for (int m = 0; m < 4; ++m) { const int row = row0 + ai * HALF + m * 16, b = row >> 12, s = row & 4095;
                const int pos = ((s & ((1 << dsh) - 1)) << (12 - dsh)) + (s >> dsh);
#pragma unroll
                for (int bj = 0; bj < 2; ++bj) { const f32x4 v0 = acc[ai][bj][m][0] * sc, v1 = acc[ai][bj][m][1] * sc;
                    u32x4 w; w.x = cvt_pk_bf16(v0[0], v0[1]); w.y = cvt_pk_bf16(v0[2], v0[3]); w.z = cvt_pk_bf16(v1[0], v1[1]); w.w = cvt_pk_bf16(v1[2], v1[3]);
                    *(u32x4*)(base + ((size_t)((b * 12 + 2 * ct + bj) * 4096 + pos)) * 128) = w; } }
    }
};
struct EpiSig {
    static constexpr bool PERM = true, AFTER_DRAIN = false;
    bf16_t* O; int ldo;
    __device__ __forceinline__ void operator()(const f32x4 (&acc)[2][2][4][2], const Unit& u, int wr, int wc, int fr, int fq) const {
        const int row0 = u.pm * BM + wr * 64 + fr, col0 = u.pn * BM + wc * 32 + 8 * fq;
#pragma unroll
        for (int ai = 0; ai < 2; ++ai)
#pragma unroll
            for (int m = 0; m < 4; ++m) { bf16_t* rowp = O + (size_t)(row0 + ai * HALF + m * 16) * ldo + col0;
#pragma unroll
                for (int bj = 0; bj < 2; ++bj) { float v[8];
#pragma unroll
                    for (int n = 0; n < 2; ++n)
#pragma unroll
                        for (int i = 0; i < 4; ++i) v[n * 4 + i] = sigmoid_f(acc[ai][bj][m][n][i]);
                    u32x4 w; w.x = cvt_pk_bf16(v[0], v[1]); w.y = cvt_pk_bf16(v[2], v[3]); w.z = cvt_pk_bf16(v[4], v[5]); w.w = cvt_pk_bf16(v[6], v[7]);
                    *(u32x4*)(rowp + bj * HALF) = w; } }
    }
};
template <bool HAS_BASE> struct EpiGate {
    static constexpr bool PERM = true, AFTER_DRAIN = false;
    const bf16_t* base; const bf16_t* gate; int ldg; bf16_t* O;
    __device__ __forceinline__ void operator()(const f32x4 (&acc)[2][2][4][2], const Unit& u, int wr, int wc, int fr, int fq) const {
        const int row0 = u.pm * BM + wr * 64 + fr, col0 = u.pn * BM + wc * 32 + 8 * fq;
#pragma unroll
        for (int ai = 0; ai < 2; ++ai)
#pragma unroll
            for (int m = 0; m < 4; ++m) { const size_t r = (size_t)(row0 + ai * HALF + m * 16);
#pragma unroll
                for (int bj = 0; bj < 2; ++bj) {
                    const u32x4 gv = *(const u32x4*)(gate + r * ldg + col0 + bj * HALF);
                    u32x4 bv = (u32x4){0u, 0u, 0u, 0u}; if (HAS_BASE) bv = *(const u32x4*)(base + r * 1024 + col0 + bj * HALF);
                    const f32x4 a0 = acc[ai][bj][m][0], a1 = acc[ai][bj][m][1];
                    float v[8];
                    v[0] = bf_lo(bv.x) + bf_lo(gv.x) * a0[0]; v[1] = bf_hi(bv.x) + bf_hi(gv.x) * a0[1];
                    v[2] = bf_lo(bv.y) + bf_lo(gv.y) * a0[2]; v[3] = bf_hi(bv.y) + bf_hi(gv.y) * a0[3];
                    v[4] = bf_lo(bv.z) + bf_lo(gv.z) * a1[0]; v[5] = bf_hi(bv.z) + bf_hi(gv.z) * a1[1];
                    v[6] = bf_lo(bv.w) + bf_lo(gv.w) * a1[2]; v[7] = bf_hi(bv.w) + bf_hi(gv.w) * a1[3];
                    u32x4 w; w.x = cvt_pk_bf16(v[0], v[1]); w.y = cvt_pk_bf16(v[2], v[3]); w.z = cvt_pk_bf16(v[4], v[5]); w.w = cvt_pk_bf16(v[6], v[7]);
                    *(u32x4*)(O + r * 1024 + col0 + bj * HALF) = w; } }
    }
};

template <class Epi, class Sched, bool ALIGN_EPI = false, bool SP2 = false>
__device__ __forceinline__ void gemm_phase(PG8_LAS unsigned char* lds, const Gemm g, const Sched& S, const Epi& E) {
    const int tid = threadIdx.x, wid = __builtin_amdgcn_readfirstlane(tid >> 6), lane = tid & 63, wr = wid >> 2, wc = wid & 3, fr = lane & 15, fq = lane >> 4;
    const int K = g.K, nt = K / BK;
    unsigned voffA[2], voffB[2];
#pragma unroll
    for (int i = 0; i < 2; ++i) { int R, C; stage_rc(tid * 16 + i * 8192, R, C); const int Rb = Epi::PERM ? ((R & ~31) + perm32(R & 31)) : R;
        voffA[i] = (unsigned)(R * K + C) * 2u; voffB[i] = (unsigned)(Rb * K + C) * 2u; }
    const size_t kstep = (size_t)(BK * 2);
    const size_t hstep = (size_t)HALF * K * 2;
    const size_t tstep = 2 * hstep;
    const unsigned ldsw = (unsigned)wid * 1024u;
    const int aoff = lds_byte(wr * 64 + fr, fq * 8), boff = lds_byte(wc * 32 + fr, fq * 8);
#define PG8_SA(b, h) (((b) * 2 + (h)) * HTB)
#define PG8_SB(b, h) ((4 + (b) * 2 + (h)) * HTB)
#define PG8_STAGE(bufoff, gbase, voff) do { _Pragma("unroll") for (int _i = 0; _i < 2; ++_i) \
        __builtin_amdgcn_global_load_lds((const unsigned*)((const char*)(gbase) + (voff)[_i]), (PG8_LAS unsigned*)(lds + (bufoff) + ldsw + _i * 8192), 16, 0, 0); } while (0)
#define PG8_LDA(dst, b, h) do { _Pragma("unroll") for (int m = 0; m < 4; ++m) _Pragma("unroll") for (int k = 0; k < 2; ++k) dst[m][k] = *(const PG8_LAS bf16x8*)(lds + PG8_SA(b, h) + aoff + m * 2048 + k * 1024); } while (0)
#define PG8_LDB(dst, b, h) do { _Pragma("unroll") for (int n = 0; n < 2; ++n) _Pragma("unroll") for (int k = 0; k < 2; ++k) dst[n][k] = *(const PG8_LAS bf16x8*)(lds + PG8_SB(b, h) + boff + n * 2048 + k * 1024); } while (0)
#define PG8_MMA(ai, bj, At, Bt) do { __builtin_amdgcn_s_setprio(1); _Pragma("unroll") for (int m = 0; m < 4; ++m) _Pragma("unroll") for (int n = 0; n < 2; ++n) _Pragma("unroll") for (int k = 0; k < 2; ++k) \
        acc[ai][bj][m][n] = __builtin_amdgcn_mfma_f32_16x16x32_bf16(Bt[n][k], At[m][k], acc[ai][bj][m][n], 0, 0, 0); __builtin_amdgcn_s_setprio(0); } while (0)
#define PG8_WAIT_V(n) asm volatile("s_waitcnt vmcnt(" #n ")" ::: "memory")
#define PG8_WAIT_L(n) asm volatile("s_waitcnt lgkmcnt(" #n ")" ::: "memory")
#define PG8_BAR __builtin_amdgcn_s_barrier()
#define PG8_SCHED __builtin_amdgcn_sched_barrier(0)
    Unit cur, nxt; int ui = 0;
    if (!S.next(0, cur)) return;
    f32x4 acc[2][2][4][2];
#pragma unroll
    for (int a = 0; a < 2; ++a)
#pragma unroll
        for (int b = 0; b < 2; ++b)
#pragma unroll
            for (int m = 0; m < 4; ++m)
#pragma unroll
                for (int n = 0; n < 2; ++n) acc[a][b][m][n] = (f32x4){0.f, 0.f, 0.f, 0.f};
    bf16x8 At[4][2], B0[2][2], B1[2][2];
    const char* cA = (const char*)g.A + (size_t)cur.pm * tstep; const char* cB = (const char*)g.Bt + (size_t)cur.pn * tstep;
    S.a_ready(cur);
    if constexpr (SP2) {
        PG8_STAGE(PG8_SB(0, 0), cB, voffB); PG8_STAGE(PG8_SB(0, 1), cB + hstep, voffB); PG8_STAGE(PG8_SA(0, 0), cA, voffA); PG8_STAGE(PG8_SA(0, 1), cA + hstep, voffA);
        if (wr == 1) PG8_BAR;
        PG8_WAIT_V(2); PG8_BAR;
        PG8_STAGE(PG8_SB(1, 0), cB + kstep, voffB); PG8_STAGE(PG8_SA(1, 0), cA + kstep, voffA); PG8_STAGE(PG8_SB(1, 1), cB + hstep + kstep, voffB);
        PG8_WAIT_V(6); PG8_BAR;
    } else {
        PG8_STAGE(PG8_SB(0, 0), cB, voffB); PG8_STAGE(PG8_SA(0, 0), cA, voffA); PG8_STAGE(PG8_SB(0, 1), cB + hstep, voffB); PG8_STAGE(PG8_SA(0, 1), cA + hstep, voffA);
        if (wr == 1) PG8_BAR;
        PG8_WAIT_V(4); PG8_BAR;
        PG8_STAGE(PG8_SB(1, 0), cB + kstep, voffB); PG8_STAGE(PG8_SA(1, 0), cA + kstep, voffA); PG8_STAGE(PG8_SB(1, 1), cB + hstep + kstep, voffB);
        PG8_WAIT_V(6); PG8_BAR;
    }
    for (;;) {
        const bool has_next = S.next(ui + 1, nxt);
        const char* nA = has_next ? (const char*)g.A + (size_t)nxt.pm * tstep : cA; const char* nB = has_next ? (const char*)g.Bt + (size_t)nxt.pn * tstep : cB;
        for (int t = 0; t < nt; t += 2) {
            const bool last = (t == nt - 2);
            const char* a1 = cA + (size_t)(t + 1) * kstep;
            const char* a2 = last ? nA : cA + (size_t)(t + 2) * kstep; const char* b2 = last ? nB : cB + (size_t)(t + 2) * kstep;
            const char* a3 = a2 + kstep; const char* b3 = b2 + kstep;
            if (last && has_next) S.a_ready(nxt);
            if constexpr (SP2) {
            PG8_LDB(B0, 0, 0); PG8_LDB(B1, 0, 1); PG8_SCHED; PG8_LDA(At, 0, 0); PG8_STAGE(PG8_SA(1, 1), a1 + hstep, voffA);
            PG8_WAIT_V(8); PG8_WAIT_L(0); PG8_BAR; PG8_MMA(0, 0, At, B0); PG8_MMA(0, 1, At, B1); PG8_BAR; PG8_SCHED;
            PG8_LDA(At, 0, 1); PG8_STAGE(PG8_SB(0, 0), b2, voffB); PG8_STAGE(PG8_SB(0, 1), b2 + hstep, voffB); PG8_STAGE(PG8_SA(0, 0), a2, voffA);
            PG8_WAIT_V(8); PG8_WAIT_L(0); PG8_BAR; PG8_MMA(1, 0, At, B0); PG8_MMA(1, 1, At, B1); PG8_BAR; PG8_SCHED;
            PG8_LDB(B0, 1, 0); PG8_LDB(B1, 1, 1); PG8_SCHED; PG8_LDA(At, 1, 0); PG8_STAGE(PG8_SA(0, 1), a2 + hstep, voffA);
            PG8_WAIT_V(8); PG8_WAIT_L(0); PG8_BAR; PG8_MMA(0, 0, At, B0); PG8_MMA(0, 1, At, B1); PG8_BAR; PG8_SCHED;
            PG8_LDA(At, 1, 1); PG8_STAGE(PG8_SB(1, 0), b3, voffB); PG8_STAGE(PG8_SB(1, 1), b3 + hstep, voffB); PG8_STAGE(PG8_SA(1, 0), a3, voffA);
            PG8_WAIT_V(8); PG8_WAIT_L(0); PG8_BAR; PG8_MMA(1, 0, At, B0); PG8_MMA(1, 1, At, B1); PG8_BAR; PG8_SCHED;
            } else {
            PG8_LDB(B0, 0, 0); PG8_SCHED; PG8_LDA(At, 0, 0); PG8_STAGE(PG8_SA(1, 1), a1 + hstep, voffA);
            PG8_WAIT_L(8); PG8_BAR; PG8_WAIT_L(0); PG8_MMA(0, 0, At, B0); PG8_BAR; PG8_SCHED;
            PG8_LDB(B1, 0, 1); PG8_STAGE(PG8_SB(0, 0), b2, voffB);
            PG8_BAR; PG8_WAIT_L(0); PG8_MMA(0, 1, At, B1); PG8_BAR;
            PG8_LDA(At, 0, 1); PG8_STAGE(PG8_SA(0, 0), a2, voffA);
            PG8_BAR; PG8_WAIT_L(0); PG8_MMA(1, 0, At, B0); PG8_BAR; PG8_SCHED;
            PG8_STAGE(PG8_SB(0, 1), b2 + hstep, voffB);
            PG8_WAIT_V(6); PG8_BAR; PG8_MMA(1, 1, At, B1); PG8_BAR;
            PG8_LDB(B0, 1, 0); PG8_SCHED; PG8_LDA(At, 1, 0); PG8_STAGE(PG8_SA(0, 1), a2 + hstep, voffA);
            PG8_WAIT_L(8); PG8_BAR; PG8_WAIT_L(0); PG8_MMA(0, 0, At, B0); PG8_BAR; PG8_SCHED;
            PG8_LDB(B1, 1, 1); PG8_STAGE(PG8_SB(1, 0), b3, voffB);
            PG8_BAR; PG8_WAIT_L(0); PG8_MMA(0, 1, At, B1); PG8_BAR;
            PG8_LDA(At, 1, 1); PG8_STAGE(PG8_SA(1, 0), a3, voffA);
            PG8_BAR; PG8_WAIT_L(0); PG8_MMA(1, 0, At, B0); PG8_BAR; PG8_SCHED;
            PG8_STAGE(PG8_SB(1, 1), b3 + hstep, voffB);
            PG8_WAIT_V(6); PG8_BAR; PG8_MMA(1, 1, At, B1); PG8_BAR;
            }
        }
        if constexpr (ALIGN_EPI) { if (wr == 0) PG8_BAR; }
        if constexpr (!Epi::AFTER_DRAIN) { E(acc, cur, wr, wc, fr, fq); S.done(cur); }
        if (!has_next) break;
#pragma unroll
        for (int a = 0; a < 2; ++a)
#pragma unroll
            for (int b = 0; b < 2; ++b)
#pragma unroll
                for (int m = 0; m < 4; ++m)
#pragma unroll
                    for (int n = 0; n < 2; ++n) acc[a][b][m][n] = (f32x4){0.f, 0.f, 0.f, 0.f};
        cur = nxt; cA = nA; cB = nB; ++ui;
        if constexpr (ALIGN_EPI) { if (wr == 1) PG8_BAR; }
    }
    PG8_WAIT_V(0);
    if constexpr (!ALIGN_EPI) { if (wr == 0) PG8_BAR; }
    PG8_BAR;
    if constexpr (Epi::AFTER_DRAIN) { E.fused(acc, cur, wr, wc, fr, fq, lds, wid, lane); S.done(cur); }
#undef PG8_SA
#undef PG8_SB
#undef PG8_STAGE
#undef PG8_LDA
#undef PG8_LDB
#undef PG8_MMA
#undef PG8_WAIT_V
#undef PG8_WAIT_L
#undef PG8_BAR
#undef PG8_SCHED
}
}

#include <hip/hip_cooperative_groups.h>
namespace cg = cooperative_groups;
using pg8::sigmoid_f; using pg8::bf_lo; using pg8::bf_hi;
#define LAS __attribute__((address_space(3)))
typedef unsigned short bf16;
typedef unsigned v4u __attribute__((ext_vector_type(4)));
typedef unsigned v2u __attribute__((ext_vector_type(2)));
typedef float f32x4 __attribute__((ext_vector_type(4)));
typedef float f32x2 __attribute__((ext_vector_type(2)));
typedef short bf16x8 __attribute__((ext_vector_type(8)));
typedef short v4i16_t __attribute__((ext_vector_type(4)));

constexpr int NWAVES = 8, NTHREADS = 512;
constexpr int SEQ = 4096, BATCH = 8, M = BATCH * SEQ, D = 1024, FF = 2816, NIN = 8704, AW = 1536, CW = 31;
constexpr float EPS = 1e-6f;
constexpr size_t MiB = 1u << 20;
constexpr size_t WS_CTL = 0;
constexpr size_t WS_WGU1 = 1 * MiB, WS_WD1 = 12 * MiB, WS_WGU2 = 18 * MiB, WS_WD2 = 29 * MiB, WS_WIN = 35 * MiB, WS_WC = 52 * MiB, WS_WA = 54 * MiB, WS_WO = 55 * MiB;
constexpr size_t WS_H = 58 * MiB;
constexpr size_t WS_ZC = 122 * MiB;
constexpr size_t WS_Q = 186 * MiB;
constexpr size_t WS_K = 282 * MiB;
constexpr size_t WS_V = 378 * MiB;
constexpr size_t WS_LSE = 474 * MiB;
constexpr size_t WS_ATT = 476 * MiB;
constexpr size_t WS_ZG = WS_K;
constexpr size_t WS_G = WS_K;
constexpr size_t WS_T1 = WS_K + 128 * MiB;
constexpr size_t WS_MIX = WS_H;
constexpr size_t WS_A1 = WS_Q;
constexpr size_t WS_END = 508 * MiB;
static_assert(WS_T1 + 64 * MiB <= WS_LSE && WS_A1 + (size_t)M * FF * 2 <= WS_LSE, "ws map");

constexpr int LDS_BYTES = 147456;

__device__ __forceinline__ float wave_sum(float v) {
#pragma unroll
    for (int o = 1; o < 64; o <<= 1) v += __shfl_xor(v, o);
    return v;
}
__device__ __forceinline__ unsigned pk2(float lo, float hi) { return pg8::cvt_pk_bf16(lo, hi); }

__device__ __forceinline__ int dst_row(int map, int n) {
    if (map == 3) { if (n < 1024) map = 1; else if (n < 2048) { map = 2; n -= 1024; } else map = 0; }
    if (map == 0) return n;
    return 256 * (n >> 7) + (n & 127) + (map == 2 ? 128 : 0);
}
__device__ __forceinline__ void transpose_item(const float* W, int K, int N, bf16* WT, int map, LAS float* scr, int item, int lane) {
    const int nblk = N / 32, kb = item / nblk, nb = item % nblk, k0 = 64 * kb, n0 = 32 * nb;
    float wv[32];
#pragma unroll
    for (int i = 0; i < 32; ++i) wv[i] = W[(size_t)(k0 + 2 * i + (lane >> 5)) * N + n0 + (lane & 31)];
#pragma unroll
    for (int i = 0; i < 32; ++i) scr[(2 * i + (lane >> 5)) * 33 + (lane & 31)] = wv[i];
    asm volatile("s_waitcnt lgkmcnt(0)" ::: "memory");
    const int c = lane & 7; const int r0 = dst_row(map, n0);
#pragma unroll
    for (int j = 0; j < 4; ++j) { const int n = (lane >> 3) + 8 * j; const LAS float* s = scr + (8 * c) * 33 + n;
        v4u o; o.x = pk2(s[0 * 33], s[1 * 33]); o.y = pk2(s[2 * 33], s[3 * 33]); o.z = pk2(s[4 * 33], s[5 * 33]); o.w = pk2(s[6 * 33], s[7 * 33]);
        *(v4u*)(WT + (size_t)(r0 + n) * K + k0 + 8 * c) = o; }
    asm volatile("s_waitcnt lgkmcnt(0)" ::: "memory");
}

template <bool OUT_BF16> __device__ __forceinline__ void rms_rows(const float* X, const float* gain, void* out, int gw, int NGW, int lane) {
    f32x4 gv[4];
#pragma unroll
    for (int j = 0; j < 4; ++j) gv[j] = ((const f32x4*)gain)[lane + 64 * j];
    for (int m0 = gw * 4; m0 < M; m0 += NGW * 4) {
        f32x4 v[4][4]; float s[4];
#pragma unroll
        for (int r = 0; r < 4; ++r) { const f32x4* xr = (const f32x4*)(X + (size_t)(m0 + r) * D) + lane;
#pragma unroll
            for (int j = 0; j < 4; ++j) v[r][j] = xr[64 * j]; }
#pragma unroll
        for (int r = 0; r < 4; ++r) { float a = 0.f;
#pragma unroll
            for (int j = 0; j < 4; ++j) a += (v[r][j].x * v[r][j].x + v[r][j].y * v[r][j].y) + (v[r][j].z * v[r][j].z + v[r][j].w * v[r][j].w);
            s[r] = a; }
#pragma unroll
        for (int o = 1; o < 64; o <<= 1) {
#pragma unroll
            for (int r = 0; r < 4; ++r) s[r] += __shfl_xor(s[r], o); }
#pragma unroll
        for (int r = 0; r < 4; ++r) { const float rstd = 1.0f / sqrtf(s[r] * (1.0f / D) + EPS);
            if (OUT_BF16) { v2u* o8 = (v2u*)((bf16*)out + (size_t)(m0 + r) * D) + lane;
#pragma unroll
                for (int j = 0; j < 4; ++j) { v2u w; w.x = pk2(v[r][j].x * rstd * gv[j].x, v[r][j].y * rstd * gv[j].y); w.y = pk2(v[r][j].z * rstd * gv[j].z, v[r][j].w * rstd * gv[j].w); o8[64 * j] = w; }
            } else { f32x4* o = (f32x4*)((float*)out + (size_t)(m0 + r) * D) + lane;
#pragma unroll
                for (int j = 0; j < 4; ++j) o[64 * j] = v[r][j] * rstd * gv[j]; } }
    }
}

__device__ __forceinline__ void rms_rows_b(const bf16* Xb, const float* gain, float* out, int gw, int NGW, int lane) {
    f32x4 gv[4];
#pragma unroll
    for (int j = 0; j < 4; ++j) gv[j] = ((const f32x4*)gain)[lane + 64 * j];
    for (int m0 = gw * 4; m0 < M; m0 += NGW * 4) {
        v2u raw[4][4]; f32x4 v[4][4]; float s[4];
#pragma unroll
        for (int r = 0; r < 4; ++r) { const v2u* xr = (const v2u*)(Xb + (size_t)(m0 + r) * D) + lane;
#pragma unroll
            for (int j = 0; j < 4; ++j) raw[r][j] = xr[64 * j]; }
#pragma unroll
        for (int r = 0; r < 4; ++r) { float a = 0.f;
#pragma unroll
            for (int j = 0; j < 4; ++j) { v[r][j] = (f32x4){bf_lo(raw[r][j].x), bf_hi(raw[r][j].x), bf_lo(raw[r][j].y), bf_hi(raw[r][j].y)};
                a += (v[r][j].x * v[r][j].x + v[r][j].y * v[r][j].y) + (v[r][j].z * v[r][j].z + v[r][j].w * v[r][j].w); }
            s[r] = a; }
#pragma unroll
        for (int o = 1; o < 64; o <<= 1) {
#pragma unroll
            for (int r = 0; r < 4; ++r) s[r] += __shfl_xor(s[r], o); }
#pragma unroll
        for (int r = 0; r < 4; ++r) { const float rstd = 1.0f / sqrtf(s[r] * (1.0f / D) + EPS); f32x4* o = (f32x4*)(out + (size_t)(m0 + r) * D) + lane;
#pragma unroll
            for (int j = 0; j < 4; ++j) o[64 * j] = v[r][j] * rstd * gv[j]; }
    }
}

constexpr int CT = 16;
__device__ __forceinline__ void conv_phase(const bf16* Zg, const float* dwk, const float* dwb, const float* lng, const float* lnb, bf16* ZC, LAS float* red, int vcu, int G) {
    const int tid = threadIdx.x, lane = tid & 63, wave = tid >> 6, c = 2 * tid;
    float w0[CW], w1[CW];
#pragma unroll
    for (int j = 0; j < CW; ++j) { const f32x2 t = *(const f32x2*)(dwk + j * D + c); w0[j] = t.x; w1[j] = t.y; }
    const f32x2 bb = *(const f32x2*)(dwb + c), gg = *(const f32x2*)(lng + c), lb = *(const f32x2*)(lnb + c);
    constexpr int NT = M / CT; const int tpb = (NT + G - 1) / G; const int tb = vcu * tpb; int te = tb + tpb; if (te > NT) te = NT;
    if (tb >= te) return;
    float z0[CT + CW - 1], z1[CT + CW - 1]; unsigned nx[CT];
    { const int t0 = tb * CT, s0 = t0 & (SEQ - 1);
#pragma unroll
        for (int i = 0; i < CT + CW - 1; ++i) { const bool valid = (s0 + i - (CW - 1)) >= 0; unsigned pk = 0u;
            if (valid) pk = *(const unsigned*)(Zg + (size_t)(t0 + i - (CW - 1)) * D + c);
            z0[i] = bf_lo(pk); z1[i] = bf_hi(pk); } }
    for (int tile = tb; tile < te; ++tile) {
        const int t0 = tile * CT; const bool more = (tile + 1 < te);
        if (more) {
#pragma unroll
            for (int i = 0; i < CT; ++i) nx[i] = *(const unsigned*)(Zg + (size_t)(t0 + CT + i) * D + c); }
        float o0[CT], o1[CT];
#pragma unroll
        for (int t = 0; t < CT; ++t) { o0[t] = bb.x; o1[t] = bb.y; }
#pragma unroll
        for (int j = 0; j < CW; ++j) {
#pragma unroll
            for (int t = 0; t < CT; ++t) { o0[t] += w0[j] * z0[t + j]; o1[t] += w1[j] * z1[t + j]; } }
        { const bool fresh = (((t0 + CT) & (SEQ - 1)) == 0);
#pragma unroll
            for (int i = 0; i < CW - 1; ++i) { z0[i] = fresh ? 0.f : z0[i + CT]; z1[i] = fresh ? 0.f : z1[i + CT]; } }
        { float k32[2 * CT];
#pragma unroll
            for (int t = 0; t < CT; ++t) { k32[2 * t] = o0[t] + o1[t]; k32[2 * t + 1] = o0[t] * o0[t] + o1[t] * o1[t]; }
            float k16[16], k8[8], k4[4], k2[2];
            const bool b5 = (lane & 32) != 0, b4 = (lane & 16) != 0, b3 = (lane & 8) != 0, b2 = (lane & 4) != 0, b1 = (lane & 2) != 0;
#pragma unroll
            for (int k = 0; k < 16; ++k) { const float send = b5 ? k32[k] : k32[16 + k], mine = b5 ? k32[16 + k] : k32[k]; k16[k] = mine + __shfl_xor(send, 32); }
#pragma unroll
            for (int k = 0; k < 8; ++k) { const float send = b4 ? k16[k] : k16[8 + k], mine = b4 ? k16[8 + k] : k16[k]; k8[k] = mine + __shfl_xor(send, 16); }
#pragma unroll
            for (int k = 0; k < 4; ++k) { const float send = b3 ? k8[k] : k8[4 + k], mine = b3 ? k8[4 + k] : k8[k]; k4[k] = mine + __shfl_xor(send, 8); }
#pragma unroll
            for (int k = 0; k < 2; ++k) { const float send = b2 ? k4[k] : k4[2 + k], mine = b2 ? k4[2 + k] : k4[k]; k2[k] = mine + __shfl_xor(send, 4); }
            const float send1 = b1 ? k2[0] : k2[1], mine1 = b1 ? k2[1] : k2[0]; float tot = mine1 + __shfl_xor(send1, 2);
            tot += __shfl_xor(tot, 1);
            if ((lane & 1) == 0) red[(lane >> 1) * 8 + wave] = tot; }
        __syncthreads();
        if (tid < CT) {
            const f32x4 a = *(const LAS f32x4*)(red + (2 * tid) * 8), b = *(const LAS f32x4*)(red + (2 * tid) * 8 + 4);
            const f32x4 p = *(const LAS f32x4*)(red + (2 * tid + 1) * 8), q = *(const LAS f32x4*)(red + (2 * tid + 1) * 8 + 4);
            const float s1 = ((a.x + a.y) + (a.z + a.w)) + ((b.x + b.y) + (b.z + b.w)), s2 = ((p.x + p.y) + (p.z + p.w)) + ((q.x + q.y) + (q.z + q.w));
            const float mu = s1 * (1.0f / D); const float var = fmaxf(s2 * (1.0f / D) - mu * mu, 0.f);
            *(LAS f32x2*)(red + 256 + 2 * tid) = (f32x2){mu, 1.0f / sqrtf(var + EPS)}; }
        __syncthreads();
        unsigned* outp = (unsigned*)(ZC + (size_t)t0 * D + c);
#pragma unroll
        for (int t = 0; t < CT; ++t) { const f32x2 st = *(const LAS f32x2*)(red + 256 + 2 * t);
            float y0 = (o0[t] - st.x) * st.y * gg.x + lb.x, y1 = (o1[t] - st.x) * st.y * gg.y + lb.y;
            y0 = y0 * sigmoid_f(y0); y1 = y1 * sigmoid_f(y1);
            outp[(size_t)t * (D / 2)] = pk2(y0, y1); }
        if (more) {
#pragma unroll
            for (int i = 0; i < CT; ++i) { z0[CW - 1 + i] = bf_lo(nx[i]); z1[CW - 1 + i] = bf_hi(nx[i]); } }
        __syncthreads();
    }
}

constexpr int VROW = 272;
constexpr int ATT_UNITS = BATCH * 12 * 32;
__device__ __forceinline__ v4i16_t tr16(const LAS unsigned char* p) { return __builtin_amdgcn_ds_read_tr16_b64_v4i16((LAS v4i16_t*)p); }
struct AttnPre { v4u k[4], v[4]; bf16x8 q[4]; };
struct AttnIdx { size_t row0; int hg, dsh, n; };
__device__ __forceinline__ AttnIdx attn_decode(int unit) {
    AttnIdx x; const int bh = unit >> 5, j = unit & 31; x.hg = bh % 12; const int gi = x.hg >> 2;
    x.dsh = 2 * gi; const int nbsh = 5 - x.dsh;
    x.n = j & ((1 << nbsh) - 1);
    x.row0 = (size_t)bh * SEQ + (size_t)j * 128; return x;
}
constexpr int ATT_HB = 128 * VROW;
constexpr int ATT_KOFF = 0, ATT_VOFF = 2 * ATT_HB;
__device__ __forceinline__ void attn_load_kv(AttnPre& p, const bf16* K, const bf16* V, size_t r0, int tid) {
#pragma unroll
    for (int i = 0; i < 4; ++i) { const size_t off = r0 * 128 + (size_t)(tid + 512 * i) * 8; p.k[i] = *(const v4u*)(K + off); p.v[i] = *(const v4u*)(V + off); }
}
__device__ __forceinline__ void attn_load(AttnPre& p, const bf16* Q, const bf16* K, const bf16* V, int unit, int tid, int w, int lq, int g) {
    const AttnIdx x = attn_decode(unit);
    attn_load_kv(p, K, V, x.row0, tid);
#pragma unroll
    for (int s = 0; s < 4; ++s) p.q[s] = *(const bf16x8*)(Q + (x.row0 + 16 * w + lq) * 128 + 32 * s + 8 * g);
}
__device__ __forceinline__ void attn_stage(LAS unsigned char* lds, const AttnPre& p, int half, int tid) {
#pragma unroll
    for (int i = 0; i < 4; ++i) { const int cidx = tid + 512 * i, row = cidx >> 4, ch = cidx & 15;
        *(LAS v4u*)(lds + ATT_KOFF + half * ATT_HB + row * VROW + ch * 16) = p.k[i]; *(LAS v4u*)(lds + ATT_VOFF + half * ATT_HB + row * VROW + ch * 16) = p.v[i]; }
}
__device__ __forceinline__ void attn_compute(LAS unsigned char* lds, const bf16x8 (&qf)[4], bf16* O, float* LSE, int unit, int f, int lane, int w, int lq, int g) {
    const AttnIdx x = attn_decode(unit); const int hg = x.hg, n = x.n;
    int rowT[9];
#pragma unroll
    for (int T = 0; T < 9; ++T) { const int kk0 = 16 * w + 16 * T; rowT[T] = ((((kk0 >> 7) ^ f) & 1) << 7) + (kk0 & 127); }
    f32x4 st[9];
    const LAS unsigned char* kb = lds + ATT_KOFF + lq * VROW + 16 * g;
#pragma unroll
    for (int T = 0; T < 9; ++T) { f32x4 a = (f32x4){0.f, 0.f, 0.f, 0.f}; const LAS unsigned char* kp = kb + rowT[T] * VROW;
#pragma unroll
        for (int s = 0; s < 4; ++s) { const bf16x8 kf = *(const LAS bf16x8*)(kp + 64 * s); a = __builtin_amdgcn_mfma_f32_16x16x32_bf16(kf, qf[s], a, 0, 0, 0); }
        st[T] = a; }
    const float slope2 = __builtin_amdgcn_exp2f(-(float)(8 * (hg + 1)) * (1.0f / 12.0f)) * (float)(1 << x.dsh) * 1.4426950408889634f;
    float mx = -__builtin_inff();
#pragma unroll
    for (int T = 0; T < 9; ++T)
#pragma unroll
        for (int reg = 0; reg < 4; ++reg) { const int steps = 128 + lq - 16 * T - 4 * g - reg, ki = 16 * w + 16 * T + 4 * g + reg;
            const bool valid = (steps >= 0) && (steps <= 128) && (n > 0 || ki >= 128);
            const float v = valid ? st[T][reg] - slope2 * (float)steps : -__builtin_inff(); st[T][reg] = v; mx = fmaxf(mx, v); }
    mx = fmaxf(mx, __shfl_xor(mx, 16)); mx = fmaxf(mx, __shfl_xor(mx, 32));
    float sum = 0.f;
#pragma unroll
    for (int T = 0; T < 9; ++T)
#pragma unroll
        for (int reg = 0; reg < 4; ++reg) { const float p = __builtin_amdgcn_exp2f(st[T][reg] - mx); st[T][reg] = p; sum += p; }
    sum += __shfl_xor(sum, 16); sum += __shfl_xor(sum, 32);
    bf16x8 pf[5];
#pragma unroll
    for (int u = 0; u < 5; ++u) { v4u t; t.x = pk2(st[2 * u][0], st[2 * u][1]); t.y = pk2(st[2 * u][2], st[2 * u][3]);
        if (u < 4) { t.z = pk2(st[2 * u + 1][0], st[2 * u + 1][1]); t.w = pk2(st[2 * u + 1][2], st[2 * u + 1][3]); } else { t.z = 0u; t.w = 0u; }
        pf[u] = __builtin_bit_cast(bf16x8, t); }
    const LAS unsigned char* vb = lds + ATT_VOFF + (4 * g + ((lane & 15) >> 2)) * VROW + (lane & 3) * 16;
    f32x4 o[4][2];
#pragma unroll
    for (int cp = 0; cp < 4; ++cp) { o[cp][0] = (f32x4){0.f, 0.f, 0.f, 0.f}; o[cp][1] = (f32x4){0.f, 0.f, 0.f, 0.f}; }
#pragma unroll
    for (int u = 0; u < 5; ++u) { const LAS unsigned char* vlo = vb + rowT[2 * u] * VROW; const LAS unsigned char* vhi = vb + rowT[u < 4 ? 2 * u + 1 : 8] * VROW;
#pragma unroll
        for (int cp = 0; cp < 4; ++cp)
#pragma unroll
            for (int h2 = 0; h2 < 2; ++h2) {
                const v4i16_t lo = tr16(vlo + cp * 64 + h2 * 8), hi = tr16(vhi + cp * 64 + h2 * 8);
                const bf16x8 vf = (bf16x8){lo[0], lo[1], lo[2], lo[3], hi[0], hi[1], hi[2], hi[3]};
                o[cp][h2] = __builtin_amdgcn_mfma_f32_16x16x32_bf16(vf, pf[u], o[cp][h2], 0, 0, 0); } }
    const float inv = 1.0f / sum;
    const size_t rq = x.row0 + 16 * w + lq;
    bf16* op = O + rq * 128 + 8 * g;
#pragma unroll
    for (int cp = 0; cp < 4; ++cp) { const f32x4 a = o[cp][0] * inv, c = o[cp][1] * inv;
        v4u t; t.x = pk2(a[0], a[1]); t.y = pk2(a[2], a[3]); t.z = pk2(c[0], c[1]); t.w = pk2(c[2], c[3]);
        *(v4u*)(op + 32 * cp) = t; }
    if (g == 0) LSE[rq] = mx + __builtin_amdgcn_logf(sum);
}
__device__ __forceinline__ void attn_phase(LAS unsigned char* lds, const bf16* Q, const bf16* K, const bf16* V, bf16* O, float* LSE, int vcu, int G) {
    const int tid = threadIdx.x, lane = tid & 63, w = __builtin_amdgcn_readfirstlane(tid >> 6), lq = lane & 15, g = lane >> 4;
    const int upb = (ATT_UNITS + G - 1) / G; const int u0 = vcu * upb; int u1 = u0 + upb; if (u1 > ATT_UNITS) u1 = ATT_UNITS;
    if (u0 >= u1) return;
    for (int i = tid; i < 4 * ATT_HB / 16; i += NTHREADS) ((LAS v4u*)lds)[i] = (v4u){0u, 0u, 0u, 0u};
    __syncthreads();
    AttnPre pre; int f = 0;
    { const AttnIdx x0 = attn_decode(u0); if (x0.n > 0) { attn_load_kv(pre, K, V, x0.row0 - 128, tid); attn_stage(lds, pre, f, tid); } }
    attn_load(pre, Q, K, V, u0, tid, w, lq, g);
    for (int u = u0; u < u1; ++u) {
        bf16x8 qf[4];
#pragma unroll
        for (int s = 0; s < 4; ++s) qf[s] = pre.q[s];
        attn_stage(lds, pre, f ^ 1, tid);
        __syncthreads();
        if (u + 1 < u1) attn_load(pre, Q, K, V, u + 1, tid, w, lq, g);
        attn_compute(lds, qf, O, LSE, u, f, lane, w, lq, g);
        __syncthreads();
        f ^= 1;
    }
}

__device__ __forceinline__ void merge_rows(const bf16* OG, const float* LSE, bf16* ATT, int gw, int NGW, int lane) {
    const int hh = lane >> 4, c0 = (lane & 15) * 8;
    for (int m0 = gw * 4; m0 < M; m0 += NGW * 4) {
        float l[4][3]; v4u a[4][3];
#pragma unroll
        for (int r = 0; r < 4; ++r) { const int m = m0 + r, b = m >> 12, s = m & 4095;
#pragma unroll
            for (int gi = 0; gi < 3; ++gi) { const int dsh = 2 * gi; const int pos = ((s & ((1 << dsh) - 1)) << (12 - dsh)) + (s >> dsh);
                const size_t row = (size_t)(b * 12 + gi * 4 + hh) * 4096 + pos; l[r][gi] = LSE[row]; a[r][gi] = *(const v4u*)(OG + row * 128 + c0); } }
#pragma unroll
        for (int r = 0; r < 4; ++r) {
            const float mx = fmaxf(l[r][0], fmaxf(l[r][1], l[r][2]));
            float e0 = __builtin_amdgcn_exp2f(l[r][0] - mx), e1 = __builtin_amdgcn_exp2f(l[r][1] - mx), e2 = __builtin_amdgcn_exp2f(l[r][2] - mx);
            const float inv = 1.0f / (e0 + e1 + e2); e0 *= inv; e1 *= inv; e2 *= inv;
            const v4u A = a[r][0], B = a[r][1], C = a[r][2]; v4u o;
            o.x = pk2(e0 * bf_lo(A.x) + e1 * bf_lo(B.x) + e2 * bf_lo(C.x), e0 * bf_hi(A.x) + e1 * bf_hi(B.x) + e2 * bf_hi(C.x));
            o.y = pk2(e0 * bf_lo(A.y) + e1 * bf_lo(B.y) + e2 * bf_lo(C.y), e0 * bf_hi(A.y) + e1 * bf_hi(B.y) + e2 * bf_hi(C.y));
            o.z = pk2(e0 * bf_lo(A.z) + e1 * bf_lo(B.z) + e2 * bf_lo(C.z), e0 * bf_hi(A.z) + e1 * bf_hi(B.z) + e2 * bf_hi(C.z));
            o.w = pk2(e0 * bf_lo(A.w) + e1 * bf_lo(B.w) + e2 * bf_lo(C.w), e0 * bf_hi(A.w) + e1 * bf_hi(B.w) + e2 * bf_hi(C.w));
            *(v4u*)(ATT + (size_t)(m0 + r) * 512 + hh * 128 + c0) = o; }
    }
}

#define XB_TMO      128
#define XB_XCNT(j)  (256  + 64 * (j))
#define XB_XSUB(j)  (1280 + 64 * (j))
#define XB_XGEN(j)  (2304 + 64 * (j))
#define XB_TOP      3328
#define XB_TOPGEN   3392
#define XCD_BAR_WORDS 3456
#define XB_SPIN_CAP (1u << 18)

__device__ __forceinline__ unsigned xb_ld(unsigned* p)              { return __hip_atomic_load(p, __ATOMIC_RELAXED, __HIP_MEMORY_SCOPE_AGENT); }
__device__ __forceinline__ unsigned xb_add(unsigned* p, unsigned v) { return __hip_atomic_fetch_add(p, v, __ATOMIC_RELAXED, __HIP_MEMORY_SCOPE_AGENT); }
__device__ __forceinline__ unsigned xb_xcc_id() { return (unsigned)__builtin_amdgcn_s_getreg((3 << 11) | 20) & 0xFu; }
#define XB_SPIN(cond, bar) do { unsigned _sp = 0; while (cond) { __builtin_amdgcn_s_sleep(1); \
    if ((++_sp & 255u) == 0u) { if (xb_ld(&(bar)[XB_TMO])) break; if (_sp > XB_SPIN_CAP) { atomicAdd(&(bar)[XB_TMO], 1u); break; } } } } while (0)

struct XcdBarrier {
    unsigned* bar; unsigned x;
    volatile LAS unsigned* st;
};

__device__ __forceinline__ XcdBarrier xcd_barrier_post(unsigned* bar, volatile LAS unsigned* st) {
    XcdBarrier b; b.bar = bar; b.x = xb_xcc_id(); b.st = st;
    if (threadIdx.x == 0) (void)xb_add(&bar[XB_XCNT(b.x)], 1u);
    return b;
}
__device__ __forceinline__ void xcd_barrier_complete(unsigned* bar, unsigned x, unsigned& nloc, unsigned& nx) {
    const unsigned G = gridDim.x * gridDim.y * gridDim.z;
    unsigned sum, cnt, mine, sp = 0u;
    for (;;) {
        sum = 0u; cnt = 0u; mine = 0u;
#pragma unroll
        for (unsigned j = 0; j < 16; ++j) { const unsigned c = xb_ld(&bar[XB_XCNT(j)]); sum += c; cnt += (c > 0u) ? 1u : 0u; mine = (j == x) ? c : mine; }
        if (sum == G) break;
        __builtin_amdgcn_s_sleep(1);
        if ((++sp & 255u) == 0u) { if (xb_ld(&bar[XB_TMO])) break; if (sp > XB_SPIN_CAP) { atomicAdd(&bar[XB_TMO], 1u); break; } }
    }
    nloc = mine > 0u ? mine : 1u; nx = cnt > 0u ? cnt : 1u;
}

__device__ __forceinline__ void xcd_barrier(const XcdBarrier& b) {
    asm volatile("s_waitcnt vmcnt(0)" ::: "memory");
    __syncthreads();
    if (threadIdx.x == 0) {
        unsigned* bar = b.bar;
        __builtin_amdgcn_s_waitcnt(0);
        unsigned nloc = b.st[0], nx = b.st[1];
        if (nloc == 0u) { xcd_barrier_complete(bar, b.x, nloc, nx); b.st[0] = nloc; b.st[1] = nx; }
        const unsigned old = xb_add(&bar[XB_XSUB(b.x)], 1u);
        const unsigned gen = old / nloc;
        if (old + 1u == (gen + 1u) * nloc) {
            __builtin_amdgcn_fence(__ATOMIC_RELEASE, "agent");
            asm volatile("s_waitcnt vmcnt(0)" ::: "memory");
            const unsigned og = xb_add(&bar[XB_TOP], 1u);
            const unsigned tg = og / nx;
            if (og + 1u == (tg + 1u) * nx) xb_add(&bar[XB_TOPGEN], 1u);
            else XB_SPIN(xb_ld(&bar[XB_TOPGEN]) == tg, bar);
            __builtin_amdgcn_fence(__ATOMIC_ACQUIRE, "agent");
            xb_add(&bar[XB_XGEN(b.x)], 1u);
            asm volatile("s_waitcnt vmcnt(0)" ::: "memory");
        } else {
            XB_SPIN(xb_ld(&bar[XB_XGEN(b.x)]) == gen, bar);
            __builtin_amdgcn_fence(__ATOMIC_ACQUIRE, "agent");
            asm volatile("s_waitcnt vmcnt(0)" ::: "memory");
        }
    }
    __syncthreads();
}

struct Args { const float* in[19]; float* out; unsigned char* ws; int ph_lo, ph_hi; };
#ifndef MK_MULTI
#define MK_MULTI 0
#endif
#if MK_MULTI
#define GRID_SYNC() do { } while (0)
#else
#ifndef MK_CG
#define MK_CG 0
#endif
#if MK_CG
#define GRID_SYNC() do { __threadfence(); cg::this_grid().sync(); } while (0)
#else
#define GRID_SYNC() xcd_barrier(xbar)
#endif
#endif

__global__ void __launch_bounds__(NTHREADS, 2) fwd_kernel(Args args) {
    extern __shared__ __attribute__((aligned(16))) unsigned char lds_raw[];
    LAS unsigned char* lds = (LAS unsigned char*)lds_raw;
    const int tid = threadIdx.x, lane = tid & 63, wave = __builtin_amdgcn_readfirstlane(tid >> 6);
    const int G = gridDim.x, bx = blockIdx.x; const int vcu = (G % 8 == 0) ? (bx % 8) * (G / 8) + bx / 8 : bx;
    const int gw = vcu * NWAVES + wave, NGW = G * NWAVES;
    unsigned char* ws = args.ws;
#if !MK_MULTI && !MK_CG
    volatile LAS unsigned* xst = (volatile LAS unsigned*)(lds + LDS_BYTES - 128);
    if (tid < 2) xst[tid] = 0u;
    __syncthreads();
    XcdBarrier xbar = xcd_barrier_post((unsigned*)(ws + WS_CTL), xst);
#endif
    const float* x = args.in[0];
    float* X = args.out;
    bf16* Wgu1 = (bf16*)(ws + WS_WGU1); bf16* Wd1 = (bf16*)(ws + WS_WD1); bf16* Wgu2 = (bf16*)(ws + WS_WGU2); bf16* Wd2 = (bf16*)(ws + WS_WD2);
    bf16* Win = (bf16*)(ws + WS_WIN); bf16* Wc = (bf16*)(ws + WS_WC); bf16* Wa = (bf16*)(ws + WS_WA); bf16* Wo = (bf16*)(ws + WS_WO);
    bf16* H = (bf16*)(ws + WS_H); bf16* ZC = (bf16*)(ws + WS_ZC); bf16* Qb = (bf16*)(ws + WS_Q); bf16* Kb = (bf16*)(ws + WS_K); bf16* Vb = (bf16*)(ws + WS_V);
    float* LSE = (float*)(ws + WS_LSE); bf16* ATT = (bf16*)(ws + WS_ATT); bf16* ZG = (bf16*)(ws + WS_ZG); bf16* GT = (bf16*)(ws + WS_G);
    bf16* T1 = (bf16*)(ws + WS_T1); bf16* MIX = (bf16*)(ws + WS_MIX); bf16* A1 = (bf16*)(ws + WS_A1);
    const int lo = args.ph_lo, hi = args.ph_hi;
#define IN(k) (lo <= (k) && (k) < hi)
#define SEAM(k) do { if (IN(k) && IN((k) + 1)) GRID_SYNC(); } while (0)
#define GEMM_PHASE(EPI, Aptr, Bptr, Nn, Kk, ...) do { pg8::Gemm g_{Aptr, Bptr, M, Nn, Kk}; pg8::StaticOrder S_; S_.init(M, Nn, G, bx); EPI E_{__VA_ARGS__}; \
        pg8::gemm_phase<EPI, pg8::StaticOrder, true, true>(lds, g_, S_, E_); } while (0)

    if (IN(0)) {
        LAS float* scr = (LAS float*)(lds + wave * 16384);
        constexpr int I_GU = 16 * 88, I_DN = 44 * 32, I_IN = 16 * 272, I_C = 16 * 32, I_A = 8 * 32;
        constexpr int NITEMS = 6 * I_GU + I_IN + 2 * I_C + I_A;
        static_assert(I_DN == I_GU, "items");
        for (int it = gw; it < NITEMS; it += NGW) {
            int r = it;
            if (r < I_GU) { transpose_item(args.in[2], D, FF, Wgu1, 1, scr, r, lane); continue; } r -= I_GU;
            if (r < I_GU) { transpose_item(args.in[3], D, FF, Wgu1, 2, scr, r, lane); continue; } r -= I_GU;
            if (r < I_GU) { transpose_item(args.in[4], FF, D, Wd1, 0, scr, r, lane); continue; } r -= I_GU;
            if (r < I_GU) { transpose_item(args.in[15], D, FF, Wgu2, 1, scr, r, lane); continue; } r -= I_GU;
            if (r < I_GU) { transpose_item(args.in[16], D, FF, Wgu2, 2, scr, r, lane); continue; } r -= I_GU;
            if (r < I_GU) { transpose_item(args.in[17], FF, D, Wd2, 0, scr, r, lane); continue; } r -= I_GU;
            if (r < I_IN) { transpose_item(args.in[6], D, NIN, Win, 3, scr, r, lane); continue; } r -= I_IN;
            if (r < I_C) { transpose_item(args.in[11], D, D, Wc, 0, scr, r, lane); continue; } r -= I_C;
            if (r < I_A) { transpose_item(args.in[12], 512, D, Wa, 0, scr, r, lane); continue; } r -= I_A;
            transpose_item(args.in[13], D, D, Wo, 0, scr, r, lane);
        }
        rms_rows<true>(x, args.in[1], H, gw, NGW, lane);
        __syncthreads();
    }
    SEAM(0);
    if (IN(1)) GEMM_PHASE(pg8::EpiPair<0>, H, Wgu1, 2 * FF, D, A1, FF);
    SEAM(1);
    if (IN(2)) GEMM_PHASE(pg8::EpiResid, A1, Wd1, D, FF, x, X, D, 0.5f, nullptr);
    SEAM(2);
    if (IN(3)) rms_rows<true>(X, args.in[5], H, gw, NGW, lane);
    SEAM(3);
    if (IN(4)) GEMM_PHASE(pg8::EpiPair<1>, H, Win, 2048, D, ZG, D);
    SEAM(4);
    if (IN(5)) conv_phase(ZG, args.in[7], args.in[8], args.in[9], args.in[10], ZC, (LAS float*)lds, vcu, G);
    SEAM(5);
    if (IN(6)) GEMM_PHASE(pg8::EpiQKV, H, Win + (size_t)2048 * D, 3 * AW, D, Qb, (size_t)(WS_K - WS_Q) / 2, 0.08838834764831845f * 1.4426950408889634f);
    SEAM(6);
    if (IN(7)) attn_phase(lds, Qb, Kb, Vb, Qb, LSE, vcu, G);
    SEAM(7);
    if (IN(8)) { merge_rows(Qb, LSE, ATT, gw, NGW, lane); __syncthreads(); }
    if (IN(8)) GEMM_PHASE(pg8::EpiSig, H, Win + (size_t)6656 * D, 2048, D, GT, 2048);
    SEAM(8);
    if (IN(9)) GEMM_PHASE(pg8::EpiGate<false>, ZC, Wc, D, D, nullptr, GT, 2048, T1);
    if (IN(10)) GEMM_PHASE(pg8::EpiGate<true>, ATT, Wa, D, 512, T1, GT + 1024, 2048, MIX);
    SEAM(10);
    if (IN(11)) GEMM_PHASE(pg8::EpiResid, MIX, Wo, D, D, X, X, D, 1.0f, nullptr);
    SEAM(11);
    if (IN(12)) rms_rows<true>(X, args.in[14], H, gw, NGW, lane);
    SEAM(12);
    if (IN(13)) GEMM_PHASE(pg8::EpiPair<0>, H, Wgu2, 2 * FF, D, A1, FF);
    SEAM(13);
    if (IN(14)) GEMM_PHASE(pg8::EpiResid, A1, Wd2, D, FF, X, X, D, 0.5f, H);
    SEAM(14);
    if (IN(15)) rms_rows_b(H, args.in[18], X, gw, NGW, lane);
#undef IN
#undef SEAM
}
constexpr int NPHASES = 16;

extern "C" void kernel_launch(void* const* d_in, const int* in_sizes, int n_in, void* d_out, int out_size, void* d_ws, size_t ws_size, hipStream_t stream) {
    static int grid = 0;
    if (grid == 0) {
        if (n_in != 19 || out_size != M * D || ws_size < WS_END) { fprintf(stderr, "kernel_launch: unexpected shapes (n_in %d out %d ws %zu)\n", n_in, out_size, ws_size); grid = -1; return; }
        int dev = 0, cus = 0, per_cu = 0;
        hipGetDevice(&dev); hipDeviceGetAttribute(&cus, hipDeviceAttributeMultiprocessorCount, dev);
        if (hipFuncSetAttribute((const void*)fwd_kernel, hipFuncAttributeMaxDynamicSharedMemorySize, LDS_BYTES) != hipSuccess) { fprintf(stderr, "kernel_launch: hipFuncSetAttribute failed\n"); grid = -1; return; }
        if (hipOccupancyMaxActiveBlocksPerMultiprocessor(&per_cu, (const void*)fwd_kernel, NTHREADS, LDS_BYTES) != hipSuccess || per_cu < 1) { fprintf(stderr, "kernel_launch: occupancy query says %d\n", per_cu); per_cu = 1; }
        (void)hipGetLastError();
        if (per_cu > 1) per_cu = 1;
        grid = cus * per_cu;
    }
    if (grid < 0) return;
    Args a{};
    for (int i = 0; i < 19; ++i) a.in[i] = (const float*)d_in[i];
    a.out = (float*)d_out; a.ws = (unsigned char*)d_ws;
#if MK_MULTI
    for (int p = 0; p < NPHASES; ++p) { a.ph_lo = p; a.ph_hi = p + 1; hipLaunchKernelGGL(fwd_kernel, dim3(grid), dim3(NTHREADS), LDS_BYTES, stream, a); }
#else
    a.ph_lo = 0; a.ph_hi = NPHASES;
#if MK_CG
    void* kargs[] = {&a};
    hipError_t e = hipLaunchCooperativeKernel((const void*)fwd_kernel, dim3(grid), dim3(NTHREADS), kargs, LDS_BYTES, stream);
    if (e != hipSuccess) fprintf(stderr, "cooperative launch failed: %s (grid %d)\n", hipGetErrorString(e), grid);
#else
    if (hipMemsetAsync((char*)d_ws + WS_CTL, 0, 65536, stream) != hipSuccess) { fprintf(stderr, "kernel_launch: memset failed\n"); return; }
    hipLaunchKernelGGL(fwd_kernel, dim3(grid), dim3(NTHREADS), LDS_BYTES, stream, a);
#endif
#endif
}
```

```cpp
#include <hip/hip_runtime.h>
#include <cstdio>
#include <cstdint>
namespace pg8 {
#define PG8_LAS __attribute__((address_space(3)))
typedef unsigned short bf16_t;
typedef short bf16x8 __attribute__((ext_vector_type(8)));
typedef float f32x4 __attribute__((ext_vector_type(4)));
typedef unsigned u32x4 __attribute__((ext_vector_type(4)));
constexpr int BM = 256, BK = 64, HALF = 128, HTB = HALF * BK * 2  , STAGE_BYTES = 8 * HTB, NXCD = 8, WGM = 8;

__host__ __device__ __forceinline__ int lds_byte(int r, int c) { const int st = (r >> 4) * 2 + (c >> 5), rr = r & 15, cc = c & 31, ob = rr * 64 + cc * 2; return st * 1024 + (ob ^ (((ob >> 9) & 1) << 5)); }
__host__ __device__ __forceinline__ void stage_rc(int b, int& R, int& C) { const int st = b / 1024, sb = b % 1024, swz = sb ^ (((sb >> 9) & 1) << 5); R = (st >> 1) * 16 + swz / 64; C = (st & 1) * 32 + (swz % 64) / 2; }
__host__ __device__ __forceinline__ int perm32(int rho) { const int n = rho >> 4, i = rho & 15; return 8 * (i >> 2) + 4 * n + (i & 3); }

struct Unit { int pm, pn; };
struct Gemm { const bf16_t* A; const bf16_t* Bt; int M, N, K; };

struct StaticOrder {
    int nM, nN, nwg, G, c;
    __host__ __device__ void init(int M, int N, int G_, int c_) { nM = M / BM; nN = N / BM; nwg = nM * nN; G = G_; c = c_; }
    __host__ __device__ bool next(int i, Unit& u) const {
        const long L = (long)i * G + c; if (L >= nwg) return false;
        int wgid = (int)L; { const int q = nwg / NXCD, r = nwg % NXCD, xcd = wgid % NXCD, off = wgid / NXCD; wgid = (xcd < r ? xcd * (q + 1) : r * (q + 1) + (xcd - r) * q) + off; }
        const int nig = WGM * nN, gid = wgid / nig, fm = gid * WGM, gsz = (nM - fm) < WGM ? (nM - fm) : WGM;
        u.pm = fm + ((wgid % nig) % gsz); u.pn = (wgid % nig) / gsz; return true;
    }
    __device__ __forceinline__ void a_ready(const Unit&) const {}
    __device__ __forceinline__ void done(const Unit&) const {}
};

typedef float f32x2_t __attribute__((ext_vector_type(2))); typedef __bf16 bf16x2_t __attribute__((ext_vector_type(2)));
__device__ __forceinline__ unsigned cvt_pk_bf16(float lo, float hi) { const f32x2_t v = {lo, hi}; const bf16x2_t b = __builtin_convertvector(v, bf16x2_t); return __builtin_bit_cast(unsigned, b); }
typedef float f32x2 __attribute__((ext_vector_type(2)));
__device__ __forceinline__ float sigmoid_f(float x) { return __builtin_amdgcn_rcpf(1.0f + __builtin_amdgcn_exp2f(-1.4426950408889634f * x)); }
__device__ __forceinline__ float bf_lo(unsigned u) { return __uint_as_float(u << 16); }
__device__ __forceinline__ float bf_hi(unsigned u) { return __uint_as_float(u & 0xffff0000u); }

template <int ACT> struct EpiPair {
    static constexpr bool PERM = true, AFTER_DRAIN = false;
    bf16_t* O; int ldo;
    __device__ __forceinline__ void operator()(const f32x4 (&acc)[2][2][4][2], const Unit& u, int wr, int wc, int fr, int fq) const {
        const int row0 = u.pm * BM + wr * 64 + fr, col0 = u.pn * HALF + wc * 32 + 8 * fq;
#pragma unroll
        for (int ai = 0; ai < 2; ++ai)
#pragma unroll
            for (int m = 0; m < 4; ++m) {
                float v[8];
#pragma unroll
                for (int n = 0; n < 2; ++n)
#pragma unroll
                    for (int i = 0; i < 4; ++i) { const float a = acc[ai][0][m][n][i], b = acc[ai][1][m][n][i];
                        v[n * 4 + i] = (ACT == 0) ? a * sigmoid_f(a) * b : a * sigmoid_f(b); }
                u32x4 w; w.x = cvt_pk_bf16(v[0], v[1]); w.y = cvt_pk_bf16(v[2], v[3]); w.z = cvt_pk_bf16(v[4], v[5]); w.w = cvt_pk_bf16(v[6], v[7]);
                *(u32x4*)(O + (size_t)(row0 + ai * HALF + m * 16) * ldo + col0) = w; }
    }
};
template <bool BASE_BF16> struct EpiResid {
    static constexpr bool PERM = true, AFTER_DRAIN = false;
    const void* base; bf16_t* outb; float alpha;
    __device__ __forceinline__ void operator()(const f32x4 (&acc)[2][2][4][2], const Unit& u, int wr, int wc, int fr, int fq) const {
        const int row0 = u.pm * BM + wr * 64 + fr, col0 = u.pn * BM + wc * 32 + 8 * fq;
#pragma unroll
        for (int ai = 0; ai < 2; ++ai)
#pragma unroll
            for (int m = 0; m < 4; ++m) { const size_t off = (size_t)(row0 + ai * HALF + m * 16) * 1024 + col0;
#pragma unroll
                for (int bj = 0; bj < 2; ++bj) { f32x4 b0, b1;
                    if (BASE_BF16) { const u32x4 r = *(const u32x4*)((const bf16_t*)base + off + bj * HALF);
                        b0 = (f32x4){bf_lo(r.x), bf_hi(r.x), bf_lo(r.y), bf_hi(r.y)}; b1 = (f32x4){bf_lo(r.z), bf_hi(r.z), bf_lo(r.w), bf_hi(r.w)}; }
                    else { b0 = *(const f32x4*)((const float*)base + off + bj * HALF); b1 = *(const f32x4*)((const float*)base + off + bj * HALF + 4); }
                    const f32x4 v0 = b0 + acc[ai][bj][m][0] * alpha, v1 = b1 + acc[ai][bj][m][1] * alpha;
                    u32x4 w; w.x = cvt_pk_bf16(v0[0], v0[1]); w.y = cvt_pk_bf16(v0[2], v0[3]); w.z = cvt_pk_bf16(v1[0], v1[1]); w.w = cvt_pk_bf16(v1[2], v1[3]);
                    *(u32x4*)(outb + off + bj * HALF) = w; } }
    }
};
struct EpiQKV {
    static constexpr bool PERM = true, AFTER_DRAIN = false;
    bf16_t* O; size_t tstride; float qscale;
    __device__ __forceinline__ void operator()(const f32x4 (&acc)[2][2][4][2], const Unit& u, int wr, int wc, int fr, int fq) const {
        const int row0 = u.pm * BM + wr * 64 + fr; const int t = u.pn / 6, ct = u.pn - 6 * t, dsh = 2 * (ct >> 1);
        bf16_t* base = O + (size_t)t * tstride + wc * 32 + 8 * fq; const float sc = (t == 0) ? qscale : 1.0f;
#pragma unroll
        for (int ai = 0; ai < 2; ++ai)
#pragma unroll
            for (int m = 0; m < 4; ++m) { const int row = row0 + ai * HALF + m * 16, b = row >> 12, s = row & 4095;
                const int pos = ((s & ((1 << dsh) - 1)) << (12 - dsh)) + (s >> dsh);
#pragma unroll
                for (int bj = 0; bj < 2; ++bj) { const f32x4 v0 = acc[ai][bj][m][0] * sc, v1 = acc[ai][bj][m][1] * sc;
                    u32x4 w; w.x = cvt_pk_bf16(v0[0], v0[1]); w.y = cvt_pk_bf16(v0[2], v0[3]); w.z = cvt_pk_bf16(v1[0], v1[1]); w.w = cvt_pk_bf16(v1[2], v1[3]);
                    *(u32x4*)(base + ((size_t)((b * 12 + 2 * ct + bj) * 4096 + pos)) * 128) = w; } }
    }
};
struct EpiSig {
    static constexpr bool PERM = true, AFTER_DRAIN = false;
    bf16_t* O; int ldo;
    __device__ __forceinline__ void operator()(const f32x4 (&acc)[2][2][4][2], const Unit& u, int wr, int wc, int fr, int fq) const {
        const int row0 = u.pm * BM + wr * 64 + fr, col0 = u.pn * BM + wc * 32 + 8 * fq;
#pragma unroll
        for (int ai = 0; ai < 2; ++ai)
#pragma unroll
            for (int m = 0; m < 4; ++m) { bf16_t* rowp = O + (size_t)(row0 + ai * HALF + m * 16) * ldo + col0;
#pragma unroll
                for (int bj = 0; bj < 2; ++bj) { float v[8];
#pragma unroll
                    for (int n = 0; n < 2; ++n)
#pragma unroll
                        for (int i = 0; i < 4; ++i) v[n * 4 + i] = sigmoid_f(acc[ai][bj][m][n][i]);
                    u32x4 w; w.x = cvt_pk_bf16(v[0], v[1]); w.y = cvt_pk_bf16(v[2], v[3]); w.z = cvt_pk_bf16(v[4], v[5]); w.w = cvt_pk_bf16(v[6], v[7]);
                    *(u32x4*)(rowp + bj * HALF) = w; } }
    }
};
template <bool HAS_BASE> struct EpiGate {
    static constexpr bool PERM = true, AFTER_DRAIN = false;
    const bf16_t* base; const bf16_t* gate; int ldg; bf16_t* O;
    __device__ __forceinline__ void operator()(const f32x4 (&acc)[2][2][4][2], const Unit& u, int wr, int wc, int fr, int fq) const {
        const int row0 = u.pm * BM + wr * 64 + fr, col0 = u.pn * BM + wc * 32 + 8 * fq;
#pragma unroll
        for (int ai = 0; ai < 2; ++ai)
#pragma unroll
            for (int m = 0; m < 4; ++m) { const size_t r = (size_t)(row0 + ai * HALF + m * 16);
#pragma unroll
                for (int bj = 0; bj < 2; ++bj) {
                    const u32x4 gv = *(const u32x4*)(gate + r * ldg + col0 + bj * HALF);
                    u32x4 bv = (u32x4){0u, 0u, 0u, 0u}; if (HAS_BASE) bv = *(const u32x4*)(base + r * 1024 + col0 + bj * HALF);
                    const f32x4 a0 = acc[ai][bj][m][0], a1 = acc[ai][bj][m][1];
                    float v[8];
                    v[0] = bf_lo(bv.x) + bf_lo(gv.x) * a0[0]; v[1] = bf_hi(bv.x) + bf_hi(gv.x) * a0[1];
                    v[2] = bf_lo(bv.y) + bf_lo(gv.y) * a0[2]; v[3] = bf_hi(bv.y) + bf_hi(gv.y) * a0[3];
                    v[4] = bf_lo(bv.z) + bf_lo(gv.z) * a1[0]; v[5] = bf_hi(bv.z) + bf_hi(gv.z) * a1[1];
                    v[6] = bf_lo(bv.w) + bf_lo(gv.w) * a1[2]; v[7] = bf_hi(bv.w) + bf_hi(gv.w) * a1[3];
                    u32x4 w; w.x = cvt_pk_bf16(v[0], v[1]); w.y = cvt_pk_bf16(v[2], v[3]); w.z = cvt_pk_bf16(v[4], v[5]); w.w = cvt_pk_bf16(v[6], v[7]);
                    *(u32x4*)(O + r * 1024 + col0 + bj * HALF) = w; } }
    }
};

template <class Epi, class Sched, bool ALIGN_EPI = false, bool SP2 = false>
__device__ __forceinline__ void gemm_phase(PG8_LAS unsigned char* lds, const Gemm g, const Sched& S, const Epi& E) {
    const int tid = threadIdx.x, wid = __builtin_amdgcn_readfirstlane(tid >> 6), lane = tid & 63, wr = wid >> 2, wc = wid & 3, fr = lane & 15, fq = lane >> 4;
    const int K = g.K, nt = K / BK;
    unsigned voffA[2], voffB[2];
#pragma unroll
    for (int i = 0; i < 2; ++i) { int R, C; stage_rc(tid * 16 + i * 8192, R, C); const int Rb = Epi::PERM ? ((R & ~31) + perm32(R & 31)) : R;
        voffA[i] = (unsigned)(R * K + C) * 2u; voffB[i] = (unsigned)(Rb * K + C) * 2u; }
    const size_t kstep = (size_t)(BK * 2);
    const size_t hstep = (size_t)HALF * K * 2;
    const size_t tstep = 2 * hstep;
    const unsigned ldsw = (unsigned)wid * 1024u;
    const int aoff = lds_byte(wr * 64 + fr, fq * 8), boff = lds_byte(wc * 32 + fr, fq * 8);
#define PG8_SA(b, h) (((b) * 2 + (h)) * HTB)
#define PG8_SB(b, h) ((4 + (b) * 2 + (h)) * HTB)
#define PG8_STAGE(bufoff, gbase, voff) do { _Pragma("unroll") for (int _i = 0; _i < 2; ++_i) \
        __builtin_amdgcn_global_load_lds((const unsigned*)((const char*)(gbase) + (voff)[_i]), (PG8_LAS unsigned*)(lds + (bufoff) + ldsw + _i * 8192), 16, 0, 0); } while (0)
#define PG8_LDA(dst, b, h) do { _Pragma("unroll") for (int m = 0; m < 4; ++m) _Pragma("unroll") for (int k = 0; k < 2; ++k) dst[m][k] = *(const PG8_LAS bf16x8*)(lds + PG8_SA(b, h) + aoff + m * 2048 + k * 1024); } while (0)
#define PG8_LDB(dst, b, h) do { _Pragma("unroll") for (int n = 0; n < 2; ++n) _Pragma("unroll") for (int k = 0; k < 2; ++k) dst[n][k] = *(const PG8_LAS bf16x8*)(lds + PG8_SB(b, h) + boff + n * 2048 + k * 1024); } while (0)
#define PG8_MMA(ai, bj, At, Bt) do { __builtin_amdgcn_s_setprio(1); _Pragma("unroll") for (int m = 0; m < 4; ++m) _Pragma("unroll") for (int n = 0; n < 2; ++n) _Pragma("unroll") for (int k = 0; k < 2; ++k) \
        acc[ai][bj][m][n] = __builtin_amdgcn_mfma_f32_16x16x32_bf16(Bt[n][k], At[m][k], acc[ai][bj][m][n], 0, 0, 0); __builtin_amdgcn_s_setprio(0); } while (0)
#define PG8_WAIT_V(n) asm volatile("s_waitcnt vmcnt(" #n ")" ::: "memory")
#define PG8_WAIT_L(n) asm volatile("s_waitcnt lgkmcnt(" #n ")" ::: "memory")
#define PG8_BAR __builtin_amdgcn_s_barrier()
#define PG8_SCHED __builtin_amdgcn_sched_barrier(0)
    Unit cur, nxt; int ui = 0;
    if (!S.next(0, cur)) return;
    f32x4 acc[2][2][4][2];
#pragma unroll
    for (int a = 0; a < 2; ++a)
#pragma unroll
        for (int b = 0; b < 2; ++b)
#pragma unroll
            for (int m = 0; m < 4; ++m)
#pragma unroll
                for (int n = 0; n < 2; ++n) acc[a][b][m][n] = (f32x4){0.f, 0.f, 0.f, 0.f};
    bf16x8 At[4][2], B0[2][2], B1[2][2];
    const char* cA = (const char*)g.A + (size_t)cur.pm * tstep; const char* cB = (const char*)g.Bt + (size_t)cur.pn * tstep;
    S.a_ready(cur);
    if constexpr (SP2) {
        PG8_STAGE(PG8_SB(0, 0), cB, voffB); PG8_STAGE(PG8_SB(0, 1), cB + hstep, voffB); PG8_STAGE(PG8_SA(0, 0), cA, voffA); PG8_STAGE(PG8_SA(0, 1), cA + hstep, voffA);
        if (wr == 1) PG8_BAR;
        PG8_WAIT_V(2); PG8_BAR;
        PG8_STAGE(PG8_SB(1, 0), cB + kstep, voffB); PG8_STAGE(PG8_SA(1, 0), cA + kstep, voffA); PG8_STAGE(PG8_SB(1, 1), cB + hstep + kstep, voffB);
        PG8_WAIT_V(6); PG8_BAR;
    } else {
        PG8_STAGE(PG8_SB(0, 0), cB, voffB); PG8_STAGE(PG8_SA(0, 0), cA, voffA); PG8_STAGE(PG8_SB(0, 1), cB + hstep, voffB); PG8_STAGE(PG8_SA(0, 1), cA + hstep, voffA);
        if (wr == 1) PG8_BAR;
        PG8_WAIT_V(4); PG8_BAR;
        PG8_STAGE(PG8_SB(1, 0), cB + kstep, voffB); PG8_STAGE(PG8_SA(1, 0), cA + kstep, voffA); PG8_STAGE(PG8_SB(1, 1), cB + hstep + kstep, voffB);
        PG8_WAIT_V(6); PG8_BAR;
    }
    for (;;) {
        const bool has_next = S.next(ui + 1, nxt);
        const char* nA = has_next ? (const char*)g.A + (size_t)nxt.pm * tstep : cA; const char* nB = has_next ? (const char*)g.Bt + (size_t)nxt.pn * tstep : cB;
        for (int t = 0; t < nt; t += 2) {
            const bool last = (t == nt - 2);
            const char* a1 = cA + (size_t)(t + 1) * kstep;
            const char* a2 = last ? nA : cA + (size_t)(t + 2) * kstep; const char* b2 = last ? nB : cB + (size_t)(t + 2) * kstep;
            const char* a3 = a2 + kstep; const char* b3 = b2 + kstep;
            if (last && has_next) S.a_ready(nxt);
            if constexpr (SP2) {
            PG8_LDB(B0, 0, 0); PG8_LDB(B1, 0, 1); PG8_SCHED; PG8_LDA(At, 0, 0); PG8_STAGE(PG8_SA(1, 1), a1 + hstep, voffA);
            PG8_WAIT_V(8); PG8_WAIT_L(0); PG8_BAR; PG8_MMA(0, 0, At, B0); PG8_MMA(0, 1, At, B1); PG8_BAR; PG8_SCHED;
            PG8_LDA(At, 0, 1); PG8_STAGE(PG8_SB(0, 0), b2, voffB); PG8_STAGE(PG8_SB(0, 1), b2 + hstep, voffB); PG8_STAGE(PG8_SA(0, 0), a2, voffA);
            PG8_WAIT_V(8); PG8_WAIT_L(0); PG8_BAR; PG8_MMA(1, 0, At, B0); PG8_MMA(1, 1, At, B1); PG8_BAR; PG8_SCHED;
            PG8_LDB(B0, 1, 0); PG8_LDB(B1, 1, 1); PG8_SCHED; PG8_LDA(At, 1, 0); PG8_STAGE(PG8_SA(0, 1), a2 + hstep, voffA);
            PG8_WAIT_V(8); PG8_WAIT_L(0); PG8_BAR; PG8_MMA(0, 0, At, B0); PG8_MMA(0, 1, At, B1); PG8_BAR; PG8_SCHED;
            PG8_LDA(At, 1, 1); PG8_STAGE(PG8_SB(1, 0), b3, voffB); PG8_STAGE(PG8_SB(1, 1), b3 + hstep, voffB); PG8_STAGE(PG8_SA(1, 0), a3, voffA);
            PG8_WAIT_V(8); PG8_WAIT_L(0); PG8_BAR; PG8_MMA(1, 0, At, B0); PG8_MMA(1, 1, At, B1); PG8_BAR; PG8_SCHED;
            } else {
            PG8_LDB(B0, 0, 0); PG8_SCHED; PG8_LDA(At, 0, 0); PG8_STAGE(PG8_SA(1, 1), a1 + hstep, voffA);
            PG8_WAIT_L(8); PG8_BAR; PG8_WAIT_L(0); PG8_MMA(0, 0, At, B0); PG8_BAR; PG8_SCHED;
            PG8_LDB(B1, 0, 1); PG8_STAGE(PG8_SB(0, 0), b2, voffB);
            PG8_BAR; PG8_WAIT_L(0); PG8_MMA(0, 1, At, B1); PG8_BAR;
            PG8_LDA(At, 0, 1); PG8_STAGE(PG8_SA(0, 0), a2, voffA);
            PG8_BAR; PG8_WAIT_L(0); PG8_MMA(1, 0, At, B0); PG8_BAR; PG8_SCHED;
            PG8_STAGE(PG8_SB(0, 1), b2 + hstep, voffB);
            PG8_WAIT_V(6); PG8_BAR; PG8_MMA(1, 1, At, B1); PG8_BAR;
            PG8_LDB(B0, 1, 0); PG8_SCHED; PG8_LDA(At, 1, 0); PG8_STAGE(PG8_SA(0, 1), a2 + hstep, voffA);
            PG8_WAIT_L(8); PG8_BAR; PG8_WAIT_L(0); PG8_MMA(0, 0, At, B0); PG8_BAR; PG8_SCHED;
            PG8_LDB(B1, 1, 1); PG8_STAGE(PG8_SB(1, 0), b3, voffB);
            PG8_BAR; PG8_WAIT_L(0); PG8_MMA(0, 1, At, B1); PG8_BAR;
            PG8_LDA(At, 1, 1); PG8_STAGE(PG8_SA(1, 0), a3, voffA);
            PG8_BAR; PG8_WAIT_L(0); PG8_MMA(1, 0, At, B0); PG8_BAR; PG8_SCHED;
            PG8_STAGE(PG8_SB(1, 1), b3 + hstep, voffB);
            PG8_WAIT_V(6); PG8_BAR; PG8_MMA(1, 1, At, B1); PG8_BAR;
            }
        }
        if constexpr (ALIGN_EPI) { if (wr == 0) PG8_BAR; }
        if constexpr (!Epi::AFTER_DRAIN) { E(acc, cur, wr, wc, fr, fq); S.done(cur); }
        if (!has_next) break;
#pragma unroll
        for (int a = 0; a < 2; ++a)
#pragma unroll
            for (int b = 0; b < 2; ++b)
#pragma unroll
                for (int m = 0; m < 4; ++m)
#pragma unroll
                    for (int n = 0; n < 2; ++n) acc[a][b][m][n] = (f32x4){0.f, 0.f, 0.f, 0.f};
        cur = nxt; cA = nA; cB = nB; ++ui;
        if constexpr (ALIGN_EPI) { if (wr == 1) PG8_BAR; }
    }
    PG8_WAIT_V(0);
    if constexpr (!ALIGN_EPI) { if (wr == 0) PG8_BAR; }
    PG8_BAR;
    if constexpr (Epi::AFTER_DRAIN) { E.fused(acc, cur, wr, wc, fr, fq, lds, wid, lane); S.done(cur); }
#undef PG8_SA
#undef PG8_SB
#undef PG8_STAGE
#undef PG8_LDA
#undef PG8_LDB
#undef PG8_MMA
#undef PG8_WAIT_V
#undef PG8_WAIT_L
#undef PG8_BAR
#undef PG8_SCHED
}
}

#include <hip/hip_cooperative_groups.h>
namespace cg = cooperative_groups;
using pg8::sigmoid_f; using pg8::bf_lo; using pg8::bf_hi;
#define LAS __attribute__((address_space(3)))
typedef unsigned short bf16;
typedef unsigned v4u __attribute__((ext_vector_type(4)));
typedef unsigned v2u __attribute__((ext_vector_type(2)));
typedef float f32x4 __attribute__((ext_vector_type(4)));
typedef float f32x2 __attribute__((ext_vector_type(2)));
typedef short bf16x8 __attribute__((ext_vector_type(8)));
typedef short v4i16_t __attribute__((ext_vector_type(4)));

constexpr int NWAVES = 8, NTHREADS = 512;
constexpr int SEQ = 4096, BATCH = 8, M = BATCH * SEQ, D = 1024, FF = 2816, NIN = 8704, AW = 1536, CW = 31;
constexpr float EPS = 1e-6f;
constexpr size_t MiB = 1u << 20;
constexpr size_t WS_CTL = 0;
constexpr size_t WS_WGU1 = 1 * MiB, WS_WD1 = 12 * MiB, WS_WGU2 = 18 * MiB, WS_WD2 = 29 * MiB, WS_WIN = 35 * MiB, WS_WC = 52 * MiB, WS_WA = 54 * MiB, WS_WO = 55 * MiB;
constexpr size_t WS_H = 58 * MiB;
constexpr size_t WS_ZC = 122 * MiB;
constexpr size_t WS_Q = 186 * MiB;
constexpr size_t WS_K = 282 * MiB;
constexpr size_t WS_V = 378 * MiB;
constexpr size_t WS_LSE = 474 * MiB;
constexpr size_t WS_ATT = 476 * MiB;
constexpr size_t WS_ZG = WS_K;
constexpr size_t WS_G = WS_K;
constexpr size_t WS_T1 = WS_K + 128 * MiB;
constexpr size_t WS_MIX = WS_H;
constexpr size_t WS_A1 = WS_Q;
constexpr size_t WS_END = 508 * MiB;
static_assert(WS_T1 + 64 * MiB <= WS_LSE && WS_A1 + (size_t)M * FF * 2 <= WS_LSE, "ws map");

constexpr int LDS_BYTES = 147456;

__device__ __forceinline__ float wave_sum(float v) {
#pragma unroll
    for (int o = 1; o < 64; o <<= 1) v += __shfl_xor(v, o);
    return v;
}
__device__ __forceinline__ unsigned pk2(float lo, float hi) { return pg8::cvt_pk_bf16(lo, hi); }

__device__ __forceinline__ int dst_row(int map, int n) {
    if (map == 3) { if (n < 1024) map = 1; else if (n < 2048) { map = 2; n -= 1024; } else map = 0; }
    if (map == 0) return n;
    return 256 * (n >> 7) + (n & 127) + (map == 2 ? 128 : 0);
}
__device__ __forceinline__ void transpose_item(const float* W, int K, int N, bf16* WT, int map, LAS float* scr, int item, int lane) {
    const int nblk = N / 32, kb = item / nblk, nb = item % nblk, k0 = 64 * kb, n0 = 32 * nb;
    float wv[32];
#pragma unroll
    for (int i = 0; i < 32; ++i) wv[i] = W[(size_t)(k0 + 2 * i + (lane >> 5)) * N + n0 + (lane & 31)];
#pragma unroll
    for (int i = 0; i < 32; ++i) scr[(2 * i + (lane >> 5)) * 33 + (lane & 31)] = wv[i];
    asm volatile("s_waitcnt lgkmcnt(0)" ::: "memory");
    const int c = lane & 7; const int r0 = dst_row(map, n0);
#pragma unroll
    for (int j = 0; j < 4; ++j) { const int n = (lane >> 3) + 8 * j; const LAS float* s = scr + (8 * c) * 33 + n;
        v4u o; o.x = pk2(s[0 * 33], s[1 * 33]); o.y = pk2(s[2 * 33], s[3 * 33]); o.z = pk2(s[4 * 33], s[5 * 33]); o.w = pk2(s[6 * 33], s[7 * 33]);
        *(v4u*)(WT + (size_t)(r0 + n) * K + k0 + 8 * c) = o; }
    asm volatile("s_waitcnt lgkmcnt(0)" ::: "memory");
}

template <bool OUT_BF16> __device__ __forceinline__ void rms_rows(const float* X, const float* gain, void* out, int gw, int NGW, int lane) {
    f32x4 gv[4];
#pragma unroll
    for (int j = 0; j < 4; ++j) gv[j] = ((const f32x4*)gain)[lane + 64 * j];
    for (int m0 = gw * 4; m0 < M; m0 += NGW * 4) {
        f32x4 v[4][4]; float s[4];
#pragma unroll
        for (int r = 0; r < 4; ++r) { const f32x4* xr = (const f32x4*)(X + (size_t)(m0 + r) * D) + lane;
#pragma unroll
            for (int j = 0; j < 4; ++j) v[r][j] = xr[64 * j]; }
#pragma unroll
        for (int r = 0; r < 4; ++r) { float a = 0.f;
#pragma unroll
            for (int j = 0; j < 4; ++j) a += (v[r][j].x * v[r][j].x + v[r][j].y * v[r][j].y) + (v[r][j].z * v[r][j].z + v[r][j].w * v[r][j].w);
            s[r] = a; }
#pragma unroll
        for (int o = 1; o < 64; o <<= 1) {
#pragma unroll
            for (int r = 0; r < 4; ++r) s[r] += __shfl_xor(s[r], o); }
#pragma unroll
        for (int r = 0; r < 4; ++r) { const float rstd = 1.0f / sqrtf(s[r] * (1.0f / D) + EPS);
            if (OUT_BF16) { v2u* o8 = (v2u*)((bf16*)out + (size_t)(m0 + r) * D) + lane;
#pragma unroll
                for (int j = 0; j < 4; ++j) { v2u w; w.x = pk2(v[r][j].x * rstd * gv[j].x, v[r][j].y * rstd * gv[j].y); w.y = pk2(v[r][j].z * rstd * gv[j].z, v[r][j].w * rstd * gv[j].w); o8[64 * j] = w; }
            } else { f32x4* o = (f32x4*)((float*)out + (size_t)(m0 + r) * D) + lane;
#pragma unroll
                for (int j = 0; j < 4; ++j) o[64 * j] = v[r][j] * rstd * gv[j]; } }
    }
}

__device__ __forceinline__ void rms_rows_bb(const bf16* Xb, const float* gain, bf16* out, int gw, int NGW, int lane) {
    f32x4 gv[4];
#pragma unroll
    for (int j = 0; j < 4; ++j) gv[j] = ((const f32x4*)gain)[lane + 64 * j];
    for (int m0 = gw * 4; m0 < M; m0 += NGW * 4) {
        v2u raw[4][4]; f32x4 v[4][4]; float s[4];
#pragma unroll
        for (int r = 0; r < 4; ++r) { const v2u* xr = (const v2u*)(Xb + (size_t)(m0 + r) * D) + lane;
#pragma unroll
            for (int j = 0; j < 4; ++j) raw[r][j] = xr[64 * j]; }
#pragma unroll
        for (int r = 0; r < 4; ++r) { float a = 0.f;
#pragma unroll
            for (int j = 0; j < 4; ++j) { v[r][j] = (f32x4){bf_lo(raw[r][j].x), bf_hi(raw[r][j].x), bf_lo(raw[r][j].y), bf_hi(raw[r][j].y)};
                a += (v[r][j].x * v[r][j].x + v[r][j].y * v[r][j].y) + (v[r][j].z * v[r][j].z + v[r][j].w * v[r][j].w); }
            s[r] = a; }
#pragma unroll
        for (int o = 1; o < 64; o <<= 1) {
#pragma unroll
            for (int r = 0; r < 4; ++r) s[r] += __shfl_xor(s[r], o); }
#pragma unroll
        for (int r = 0; r < 4; ++r) { const float rstd = 1.0f / sqrtf(s[r] * (1.0f / D) + EPS); v2u* o8 = (v2u*)(out + (size_t)(m0 + r) * D) + lane;
#pragma unroll
            for (int j = 0; j < 4; ++j) { v2u w; w.x = pk2(v[r][j].x * rstd * gv[j].x, v[r][j].y * rstd * gv[j].y); w.y = pk2(v[r][j].z * rstd * gv[j].z, v[r][j].w * rstd * gv[j].w); o8[64 * j] = w; } }
    }
}

__device__ __forceinline__ void rms_rows_b(const bf16* Xb, const float* gain, float* out, int gw, int NGW, int lane) {
    f32x4 gv[4];
#pragma unroll
    for (int j = 0; j < 4; ++j) gv[j] = ((const f32x4*)gain)[lane + 64 * j];
    for (int m0 = gw * 4; m0 < M; m0 += NGW * 4) {
        v2u raw[4][4]; f32x4 v[4][4]; float s[4];
#pragma unroll
        for (int r = 0; r < 4; ++r) { const v2u* xr = (const v2u*)(Xb + (size_t)(m0 + r) * D) + lane;
#pragma unroll
            for (int j = 0; j < 4; ++j) raw[r][j] = xr[64 * j]; }
#pragma unroll
        for (int r = 0; r < 4; ++r) { float a = 0.f;
#pragma unroll
            for (int j = 0; j < 4; ++j) { v[r][j] = (f32x4){bf_lo(raw[r][j].x), bf_hi(raw[r][j].x), bf_lo(raw[r][j].y), bf_hi(raw[r][j].y)};
                a += (v[r][j].x * v[r][j].x + v[r][j].y * v[r][j].y) + (v[r][j].z * v[r][j].z + v[r][j].w * v[r][j].w); }
            s[r] = a; }
#pragma unroll
        for (int o = 1; o < 64; o <<= 1) {
#pragma unroll
            for (int r = 0; r < 4; ++r) s[r] += __shfl_xor(s[r], o); }
#pragma unroll
        for (int r = 0; r < 4; ++r) { const float rstd = 1.0f / sqrtf(s[r] * (1.0f / D) + EPS); f32x4* o = (f32x4*)(out + (size_t)(m0 + r) * D) + lane;
#pragma unroll
            for (int j = 0; j < 4; ++j) o[64 * j] = v[r][j] * rstd * gv[j]; }
    }
}

constexpr int CT = 16;
__device__ __forceinline__ void conv_phase(const bf16* Zg, const float* dwk, const float* dwb, const float* lng, const float* lnb, bf16* ZC, LAS float* red, int vcu, int G) {
    const int tid = threadIdx.x, lane = tid & 63, wave = tid >> 6, c = 2 * tid;
    float w0[CW], w1[CW];
#pragma unroll
    for (int j = 0; j < CW; ++j) { const f32x2 t = *(const f32x2*)(dwk + j * D + c); w0[j] = t.x; w1[j] = t.y; }
    const f32x2 bb = *(const f32x2*)(dwb + c), gg = *(const f32x2*)(lng + c), lb = *(const f32x2*)(lnb + c);
    constexpr int NT = M / CT; const int tpb = (NT + G - 1) / G; const int tb = vcu * tpb; int te = tb + tpb; if (te > NT) te = NT;
    if (tb >= te) return;
    float z0[CT + CW - 1], z1[CT + CW - 1]; unsigned nx[CT];
    { const int t0 = tb * CT, s0 = t0 & (SEQ - 1);
#pragma unroll
        for (int i = 0; i < CT + CW - 1; ++i) { const bool valid = (s0 + i - (CW - 1)) >= 0; unsigned pk = 0u;
            if (valid) pk = *(const unsigned*)(Zg + (size_t)(t0 + i - (CW - 1)) * D + c);
            z0[i] = bf_lo(pk); z1[i] = bf_hi(pk); } }
    for (int tile = tb; tile < te; ++tile) {
        const int t0 = tile * CT; const bool more = (tile + 1 < te);
        if (more) {
#pragma unroll
            for (int i = 0; i < CT; ++i) nx[i] = *(const unsigned*)(Zg + (size_t)(t0 + CT + i) * D + c); }
        float o0[CT], o1[CT];
#pragma unroll
        for (int t = 0; t < CT; ++t) { o0[t] = bb.x; o1[t] = bb.y; }
#pragma unroll
        for (int j = 0; j < CW; ++j) {
#pragma unroll
            for (int t = 0; t < CT; ++t) { o0[t] += w0[j] * z0[t + j]; o1[t] += w1[j] * z1[t + j]; } }
        { const bool fresh = (((t0 + CT) & (SEQ - 1)) == 0);
#pragma unroll
            for (int i = 0; i < CW - 1; ++i) { z0[i] = fresh ? 0.f : z0[i + CT]; z1[i] = fresh ? 0.f : z1[i + CT]; } }
        { float k32[2 * CT];
#pragma unroll
            for (int t = 0; t < CT; ++t) { k32[2 * t] = o0[t] + o1[t]; k32[2 * t + 1] = o0[t] * o0[t] + o1[t] * o1[t]; }
            float k16[16], k8[8], k4[4], k2[2];
            const bool b5 = (lane & 32) != 0, b4 = (lane & 16) != 0, b3 = (lane & 8) != 0, b2 = (lane & 4) != 0, b1 = (lane & 2) != 0;
#pragma unroll
            for (int k = 0; k < 16; ++k) { const float send = b5 ? k32[k] : k32[16 + k], mine = b5 ? k32[16 + k] : k32[k]; k16[k] = mine + __shfl_xor(send, 32); }
#pragma unroll
            for (int k = 0; k < 8; ++k) { const float send = b4 ? k16[k] : k16[8 + k], mine = b4 ? k16[8 + k] : k16[k]; k8[k] = mine + __shfl_xor(send, 16); }
#pragma unroll
            for (int k = 0; k < 4; ++k) { const float send = b3 ? k8[k] : k8[4 + k], mine = b3 ? k8[4 + k] : k8[k]; k4[k] = mine + __shfl_xor(send, 8); }
#pragma unroll
            for (int k = 0; k < 2; ++k) { const float send = b2 ? k4[k] : k4[2 + k], mine = b2 ? k4[2 + k] : k4[k]; k2[k] = mine + __shfl_xor(send, 4); }
            const float send1 = b1 ? k2[0] : k2[1], mine1 = b1 ? k2[1] : k2[0]; float tot = mine1 + __shfl_xor(send1, 2);
            tot += __shfl_xor(tot, 1);
            if ((lane & 1) == 0) red[(lane >> 1) * 8 + wave] = tot; }
        __syncthreads();
        if (tid < CT) {
            const f32x4 a = *(const LAS f32x4*)(red + (2 * tid) * 8), b = *(const LAS f32x4*)(red + (2 * tid) * 8 + 4);
            const f32x4 p = *(const LAS f32x4*)(red + (2 * tid + 1) * 8), q = *(const LAS f32x4*)(red + (2 * tid + 1) * 8 + 4);
            const float s1 = ((a.x + a.y) + (a.z + a.w)) + ((b.x + b.y) + (b.z + b.w)), s2 = ((p.x + p.y) + (p.z + p.w)) + ((q.x + q.y) + (q.z + q.w));
            const float mu = s1 * (1.0f / D); const float var = fmaxf(s2 * (1.0f / D) - mu * mu, 0.f);
            *(LAS f32x2*)(red + 256 + 2 * tid) = (f32x2){mu, 1.0f / sqrtf(var + EPS)}; }
        __syncthreads();
        unsigned* outp = (unsigned*)(ZC + (size_t)t0 * D + c);
#pragma unroll
        for (int t = 0; t < CT; ++t) { const f32x2 st = *(const LAS f32x2*)(red + 256 + 2 * t);
            float y0 = (o0[t] - st.x) * st.y * gg.x + lb.x, y1 = (o1[t] - st.x) * st.y * gg.y + lb.y;
            y0 = y0 * sigmoid_f(y0); y1 = y1 * sigmoid_f(y1);
            outp[(size_t)t * (D / 2)] = pk2(y0, y1); }
        if (more) {
#pragma unroll
            for (int i = 0; i < CT; ++i) { z0[CW - 1 + i] = bf_lo(nx[i]); z1[CW - 1 + i] = bf_hi(nx[i]); } }
        __syncthreads();
    }
}

constexpr int VROW = 272;
constexpr int ATT_UNITS = BATCH * 12 * 32;
__device__ __forceinline__ v4i16_t tr16(const LAS unsigned char* p) { return __builtin_amdgcn_ds_read_tr16_b64_v4i16((LAS v4i16_t*)p); }
struct AttnPre { v4u k[4], v[4]; bf16x8 q[4]; };
struct AttnIdx { size_t row0; int hg, dsh, n; };
__device__ __forceinline__ AttnIdx attn_decode(int unit) {
    AttnIdx x; const int bh = unit >> 5, j = unit & 31; x.hg = bh % 12; const int gi = x.hg >> 2;
    x.dsh = 2 * gi; const int nbsh = 5 - x.dsh;
    x.n = j & ((1 << nbsh) - 1);
    x.row0 = (size_t)bh * SEQ + (size_t)j * 128; return x;
}
constexpr int ATT_HB = 128 * VROW;
constexpr int ATT_KOFF = 0, ATT_VOFF = 2 * ATT_HB;
__device__ __forceinline__ void attn_load_kv(AttnPre& p, const bf16* K, const bf16* V, size_t r0, int tid) {
#pragma unroll
    for (int i = 0; i < 4; ++i) { const size_t off = r0 * 128 + (size_t)(tid + 512 * i) * 8; p.k[i] = *(const v4u*)(K + off); p.v[i] = *(const v4u*)(V + off); }
}
__device__ __forceinline__ void attn_load(AttnPre& p, const bf16* Q, const bf16* K, const bf16* V, int unit, int tid, int w, int lq, int g) {
    const AttnIdx x = attn_decode(unit);
    attn_load_kv(p, K, V, x.row0, tid);
#pragma unroll
    for (int s = 0; s < 4; ++s) p.q[s] = *(const bf16x8*)(Q + (x.row0 + 16 * w + lq) * 128 + 32 * s + 8 * g);
}
__device__ __forceinline__ void attn_stage(LAS unsigned char* lds, const AttnPre& p, int half, int tid) {
#pragma unroll
    for (int i = 0; i < 4; ++i) { const int cidx = tid + 512 * i, row = cidx >> 4, ch = cidx & 15;
        *(LAS v4u*)(lds + ATT_KOFF + half * ATT_HB + row * VROW + ch * 16) = p.k[i]; *(LAS v4u*)(lds + ATT_VOFF + half * ATT_HB + row * VROW + ch * 16) = p.v[i]; }
}
__device__ __forceinline__ void attn_compute(LAS unsigned char* lds, const bf16x8 (&qf)[4], bf16* O, float* LSE, int unit, int f, int lane, int w, int lq, int g) {
    const AttnIdx x = attn_decode(unit); const int hg = x.hg, n = x.n;
    int rowT[9];
#pragma unroll
    for (int T = 0; T < 9; ++T) { const int kk0 = 16 * w + 16 * T; rowT[T] = ((((kk0 >> 7) ^ f) & 1) << 7) + (kk0 & 127); }
    f32x4 st[9];
    const LAS unsigned char* kb = lds + ATT_KOFF + lq * VROW + 16 * g;
#pragma unroll
    for (int T = 0; T < 9; ++T) { f32x4 a = (f32x4){0.f, 0.f, 0.f, 0.f}; const LAS unsigned char* kp = kb + rowT[T] * VROW;
#pragma unroll
        for (int s = 0; s < 4; ++s) { const bf16x8 kf = *(const LAS bf16x8*)(kp + 64 * s); a = __builtin_amdgcn_mfma_f32_16x16x32_bf16(kf, qf[s], a, 0, 0, 0); }
        st[T] = a; }
    const float slope2 = __builtin_amdgcn_exp2f(-(float)(8 * (hg + 1)) * (1.0f / 12.0f)) * (float)(1 << x.dsh) * 1.4426950408889634f;
    float mx = -__builtin_inff();
#pragma unroll
    for (int T = 0; T < 9; ++T)
#pragma unroll
        for (int reg = 0; reg < 4; ++reg) { const int steps = 128 + lq - 16 * T - 4 * g - reg, ki = 16 * w + 16 * T + 4 * g + reg;
            const bool valid = (steps >= 0) && (steps <= 128) && (n > 0 || ki >= 128);
            const float v = valid ? st[T][reg] - slope2 * (float)steps : -__builtin_inff(); st[T][reg] = v; mx = fmaxf(mx, v); }
    mx = fmaxf(mx, __shfl_xor(mx, 16)); mx = fmaxf(mx, __shfl_xor(mx, 32));
    float sum = 0.f;
#pragma unroll
    for (int T = 0; T < 9; ++T)
#pragma unroll
        for (int reg = 0; reg < 4; ++reg) { const float p = __builtin_amdgcn_exp2f(st[T][reg] - mx); st[T][reg] = p; sum += p; }
    sum += __shfl_xor(sum, 16); sum += __shfl_xor(sum, 32);
    bf16x8 pf[5];
#pragma unroll
    for (int u = 0; u < 5; ++u) { v4u t; t.x = pk2(st[2 * u][0], st[2 * u][1]); t.y = pk2(st[2 * u][2], st[2 * u][3]);
        if (u < 4) { t.z = pk2(st[2 * u + 1][0], st[2 * u + 1][1]); t.w = pk2(st[2 * u + 1][2], st[2 * u + 1][3]); } else { t.z = 0u; t.w = 0u; }
        pf[u] = __builtin_bit_cast(bf16x8, t); }
    const LAS unsigned char* vb = lds + ATT_VOFF + (4 * g + ((lane & 15) >> 2)) * VROW + (lane & 3) * 16;
    f32x4 o[4][2];
#pragma unroll
    for (int cp = 0; cp < 4; ++cp) { o[cp][0] = (f32x4){0.f, 0.f, 0.f, 0.f}; o[cp][1] = (f32x4){0.f, 0.f, 0.f, 0.f}; }
#pragma unroll
    for (int u = 0; u < 5; ++u) { const LAS unsigned char* vlo = vb + rowT[2 * u] * VROW; const LAS unsigned char* vhi = vb + rowT[u < 4 ? 2 * u + 1 : 8] * VROW;
#pragma unroll
        for (int cp = 0; cp < 4; ++cp)
#pragma unroll
            for (int h2 = 0; h2 < 2; ++h2) {
                const v4i16_t lo = tr16(vlo + cp * 64 + h2 * 8), hi = tr16(vhi + cp * 64 + h2 * 8);
                const bf16x8 vf = (bf16x8){lo[0], lo[1], lo[2], lo[3], hi[0], hi[1], hi[2], hi[3]};
                o[cp][h2] = __builtin_amdgcn_mfma_f32_16x16x32_bf16(vf, pf[u], o[cp][h2], 0, 0, 0); } }
    const float inv = 1.0f / sum;
    const size_t rq = x.row0 + 16 * w + lq;
    bf16* op = O + rq * 128 + 8 * g;
#pragma unroll
    for (int cp = 0; cp < 4; ++cp) { const f32x4 a = o[cp][0] * inv, c = o[cp][1] * inv;
        v4u t; t.x = pk2(a[0], a[1]); t.y = pk2(a[2], a[3]); t.z = pk2(c[0], c[1]); t.w = pk2(c[2], c[3]);
        *(v4u*)(op + 32 * cp) = t; }
    if (g == 0) LSE[rq] = mx + __builtin_amdgcn_logf(sum);
}
__device__ __forceinline__ void attn_phase(LAS unsigned char* lds, const bf16* Q, const bf16* K, const bf16* V, bf16* O, float* LSE, int vcu, int G) {
    const int tid = threadIdx.x, lane = tid & 63, w = __builtin_amdgcn_readfirstlane(tid >> 6), lq = lane & 15, g = lane >> 4;
    const int upb = (ATT_UNITS + G - 1) / G; const int u0 = vcu * upb; int u1 = u0 + upb; if (u1 > ATT_UNITS) u1 = ATT_UNITS;
    if (u0 >= u1) return;
    for (int i = tid; i < 4 * ATT_HB / 16; i += NTHREADS) ((LAS v4u*)lds)[i] = (v4u){0u, 0u, 0u, 0u};
    __syncthreads();
    AttnPre pre; int f = 0;
    { const AttnIdx x0 = attn_decode(u0); if (x0.n > 0) { attn_load_kv(pre, K, V, x0.row0 - 128, tid); attn_stage(lds, pre, f, tid); } }
    attn_load(pre, Q, K, V, u0, tid, w, lq, g);
    for (int u = u0; u < u1; ++u) {
        bf16x8 qf[4];
#pragma unroll
        for (int s = 0; s < 4; ++s) qf[s] = pre.q[s];
        attn_stage(lds, pre, f ^ 1, tid);
        __syncthreads();
        if (u + 1 < u1) attn_load(pre, Q, K, V, u + 1, tid, w, lq, g);
        attn_compute(lds, qf, O, LSE, u, f, lane, w, lq, g);
        __syncthreads();
        f ^= 1;
    }
}

__device__ __forceinline__ void merge_rows(const bf16* OG, const float* LSE, bf16* ATT, int gw, int NGW, int lane) {
    const int hh = lane >> 4, c0 = (lane & 15) * 8;
    for (int m0 = gw * 4; m0 < M; m0 += NGW * 4) {
        float l[4][3]; v4u a[4][3];
#pragma unroll
        for (int r = 0; r < 4; ++r) { const int m = m0 + r, b = m >> 12, s = m & 4095;
#pragma unroll
            for (int gi = 0; gi < 3; ++gi) { const int dsh = 2 * gi; const int pos = ((s & ((1 << dsh) - 1)) << (12 - dsh)) + (s >> dsh);
                const size_t row = (size_t)(b * 12 + gi * 4 + hh) * 4096 + pos; l[r][gi] = LSE[row]; a[r][gi] = *(const v4u*)(OG + row * 128 + c0); } }
#pragma unroll
        for (int r = 0; r < 4; ++r) {
            const float mx = fmaxf(l[r][0], fmaxf(l[r][1], l[r][2]));
            float e0 = __builtin_amdgcn_exp2f(l[r][0] - mx), e1 = __builtin_amdgcn_exp2f(l[r][1] - mx), e2 = __builtin_amdgcn_exp2f(l[r][2] - mx);
            const float inv = 1.0f / (e0 + e1 + e2); e0 *= inv; e1 *= inv; e2 *= inv;
            const v4u A = a[r][0], B = a[r][1], C = a[r][2]; v4u o;
            o.x = pk2(e0 * bf_lo(A.x) + e1 * bf_lo(B.x) + e2 * bf_lo(C.x), e0 * bf_hi(A.x) + e1 * bf_hi(B.x) + e2 * bf_hi(C.x));
            o.y = pk2(e0 * bf_lo(A.y) + e1 * bf_lo(B.y) + e2 * bf_lo(C.y), e0 * bf_hi(A.y) + e1 * bf_hi(B.y) + e2 * bf_hi(C.y));
            o.z = pk2(e0 * bf_lo(A.z) + e1 * bf_lo(B.z) + e2 * bf_lo(C.z), e0 * bf_hi(A.z) + e1 * bf_hi(B.z) + e2 * bf_hi(C.z));
            o.w = pk2(e0 * bf_lo(A.w) + e1 * bf_lo(B.w) + e2 * bf_lo(C.w), e0 * bf_hi(A.w) + e1 * bf_hi(B.w) + e2 * bf_hi(C.w));
            *(v4u*)(ATT + (size_t)(m0 + r) * 512 + hh * 128 + c0) = o; }
    }
}

#define XB_TMO      128
#define XB_XCNT(j)  (256  + 64 * (j))
#define XB_XSUB(j)  (1280 + 64 * (j))
#define XB_XGEN(j)  (2304 + 64 * (j))
#define XB_TOP      3328
#define XB_TOPGEN   3392
#define XCD_BAR_WORDS 3456
#define XB_SPIN_CAP (1u << 18)

__device__ __forceinline__ unsigned xb_ld(unsigned* p)              { return __hip_atomic_load(p, __ATOMIC_RELAXED, __HIP_MEMORY_SCOPE_AGENT); }
__device__ __forceinline__ unsigned xb_add(unsigned* p, unsigned v) { return __hip_atomic_fetch_add(p, v, __ATOMIC_RELAXED, __HIP_MEMORY_SCOPE_AGENT); }
__device__ __forceinline__ unsigned xb_xcc_id() { return (unsigned)__builtin_amdgcn_s_getreg((3 << 11) | 20) & 0xFu; }
#define XB_SPIN(cond, bar) do { unsigned _sp = 0; while (cond) { __builtin_amdgcn_s_sleep(1); \
    if ((++_sp & 255u) == 0u) { if (xb_ld(&(bar)[XB_TMO])) break; if (_sp > XB_SPIN_CAP) { atomicAdd(&(bar)[XB_TMO], 1u); break; } } } } while (0)

struct XcdBarrier {
    unsigned* bar; unsigned x;
    volatile LAS unsigned* st;
};

__device__ __forceinline__ XcdBarrier xcd_barrier_post(unsigned* bar, volatile LAS unsigned* st) {
    XcdBarrier b; b.bar = bar; b.x = xb_xcc_id(); b.st = st;
    if (threadIdx.x == 0) (void)xb_add(&bar[XB_XCNT(b.x)], 1u);
    return b;
}
__device__ __forceinline__ void xcd_barrier_complete(unsigned* bar, unsigned x, unsigned& nloc, unsigned& nx) {
    const unsigned G = gridDim.x * gridDim.y * gridDim.z;
    unsigned sum, cnt, mine, sp = 0u;
    for (;;) {
        sum = 0u; cnt = 0u; mine = 0u;
#pragma unroll
        for (unsigned j = 0; j < 16; ++j) { const unsigned c = xb_ld(&bar[XB_XCNT(j)]); sum += c; cnt += (c > 0u) ? 1u : 0u; mine = (j == x) ? c : mine; }
        if (sum == G) break;
        __builtin_amdgcn_s_sleep(1);
        if ((++sp & 255u) == 0u) { if (xb_ld(&bar[XB_TMO])) break; if (sp > XB_SPIN_CAP) { atomicAdd(&bar[XB_TMO], 1u); break; } }
    }
    nloc = mine > 0u ? mine : 1u; nx = cnt > 0u ? cnt : 1u;
}

__device__ __forceinline__ void xcd_barrier(const XcdBarrier& b) {
    asm volatile("s_waitcnt vmcnt(0)" ::: "memory");
    __syncthreads();
    if (threadIdx.x == 0) {
        unsigned* bar = b.bar;
        __builtin_amdgcn_s_waitcnt(0);
        unsigned nloc = b.st[0], nx = b.st[1];
        if (nloc == 0u) { xcd_barrier_complete(bar, b.x, nloc, nx); b.st[0] = nloc; b.st[1] = nx; }
        const unsigned old = xb_add(&bar[XB_XSUB(b.x)], 1u);
        const unsigned gen = old / nloc;
        if (old + 1u == (gen + 1u) * nloc) {
            __builtin_amdgcn_fence(__ATOMIC_RELEASE, "agent");
            asm volatile("s_waitcnt vmcnt(0)" ::: "memory");
            const unsigned og = xb_add(&bar[XB_TOP], 1u);
            const unsigned tg = og / nx;
            if (og + 1u == (tg + 1u) * nx) xb_add(&bar[XB_TOPGEN], 1u);
            else XB_SPIN(xb_ld(&bar[XB_TOPGEN]) == tg, bar);
            __builtin_amdgcn_fence(__ATOMIC_ACQUIRE, "agent");
            xb_add(&bar[XB_XGEN(b.x)], 1u);
            asm volatile("s_waitcnt vmcnt(0)" ::: "memory");
        } else {
            XB_SPIN(xb_ld(&bar[XB_XGEN(b.x)]) == gen, bar);
            __builtin_amdgcn_fence(__ATOMIC_ACQUIRE, "agent");
            asm volatile("s_waitcnt vmcnt(0)" ::: "memory");
        }
    }
    __syncthreads();
}

struct Args { const float* in[19]; float* out; unsigned char* ws; int ph_lo, ph_hi; };
#ifndef MK_MULTI
#define MK_MULTI 0
#endif
#if MK_MULTI
#define GRID_SYNC() do { } while (0)
#else
#ifndef MK_CG
#define MK_CG 0
#endif
#if MK_CG
#define GRID_SYNC() do { __threadfence(); cg::this_grid().sync(); } while (0)
#else
#define GRID_SYNC() xcd_barrier(xbar)
#endif
#endif

__global__ void __launch_bounds__(NTHREADS, 2) fwd_kernel(Args args) {
    extern __shared__ __attribute__((aligned(16))) unsigned char lds_raw[];
    LAS unsigned char* lds = (LAS unsigned char*)lds_raw;
    const int tid = threadIdx.x, lane = tid & 63, wave = __builtin_amdgcn_readfirstlane(tid >> 6);
    const int G = gridDim.x, bx = blockIdx.x; const int vcu = (G % 8 == 0) ? (bx % 8) * (G / 8) + bx / 8 : bx;
    const int gw = vcu * NWAVES + wave, NGW = G * NWAVES;
    unsigned char* ws = args.ws;
#if !MK_MULTI && !MK_CG
    volatile LAS unsigned* xst = (volatile LAS unsigned*)(lds + LDS_BYTES - 128);
    if (tid < 2) xst[tid] = 0u;
    __syncthreads();
    XcdBarrier xbar = xcd_barrier_post((unsigned*)(ws + WS_CTL), xst);
#endif
    const float* x = args.in[0];
    float* X = args.out; bf16* XB = (bf16*)args.out;
    bf16* Wgu1 = (bf16*)(ws + WS_WGU1); bf16* Wd1 = (bf16*)(ws + WS_WD1); bf16* Wgu2 = (bf16*)(ws + WS_WGU2); bf16* Wd2 = (bf16*)(ws + WS_WD2);
    bf16* Win = (bf16*)(ws + WS_WIN); bf16* Wc = (bf16*)(ws + WS_WC); bf16* Wa = (bf16*)(ws + WS_WA); bf16* Wo = (bf16*)(ws + WS_WO);
    bf16* H = (bf16*)(ws + WS_H); bf16* ZC = (bf16*)(ws + WS_ZC); bf16* Qb = (bf16*)(ws + WS_Q); bf16* Kb = (bf16*)(ws + WS_K); bf16* Vb = (bf16*)(ws + WS_V);
    float* LSE = (float*)(ws + WS_LSE); bf16* ATT = (bf16*)(ws + WS_ATT); bf16* ZG = (bf16*)(ws + WS_ZG); bf16* GT = (bf16*)(ws + WS_G);
    bf16* T1 = (bf16*)(ws + WS_T1); bf16* MIX = (bf16*)(ws + WS_MIX); bf16* A1 = (bf16*)(ws + WS_A1);
    const int lo = args.ph_lo, hi = args.ph_hi;
#define IN(k) (lo <= (k) && (k) < hi)
#define SEAM(k) do { if (IN(k) && IN((k) + 1)) GRID_SYNC(); } while (0)
#define GEMM_PHASE(EPI, Aptr, Bptr, Nn, Kk, ...) do { pg8::Gemm g_{Aptr, Bptr, M, Nn, Kk}; pg8::StaticOrder S_; S_.init(M, Nn, G, bx); EPI E_{__VA_ARGS__}; \
        pg8::gemm_phase<EPI, pg8::StaticOrder, true, true>(lds, g_, S_, E_); } while (0)

    if (IN(0)) {
        LAS float* scr = (LAS float*)(lds + wave * 16384);
        constexpr int I_GU = 16 * 88, I_DN = 44 * 32, I_IN = 16 * 272, I_C = 16 * 32, I_A = 8 * 32;
        constexpr int NITEMS = 6 * I_GU + I_IN + 2 * I_C + I_A;
        static_assert(I_DN == I_GU, "items");
        for (int it = gw; it < NITEMS; it += NGW) {
            int r = it;
            if (r < I_GU) { transpose_item(args.in[2], D, FF, Wgu1, 1, scr, r, lane); continue; } r -= I_GU;
            if (r < I_GU) { transpose_item(args.in[3], D, FF, Wgu1, 2, scr, r, lane); continue; } r -= I_GU;
            if (r < I_GU) { transpose_item(args.in[4], FF, D, Wd1, 0, scr, r, lane); continue; } r -= I_GU;
            if (r < I_GU) { transpose_item(args.in[15], D, FF, Wgu2, 1, scr, r, lane); continue; } r -= I_GU;
            if (r < I_GU) { transpose_item(args.in[16], D, FF, Wgu2, 2, scr, r, lane); continue; } r -= I_GU;
            if (r < I_GU) { transpose_item(args.in[17], FF, D, Wd2, 0, scr, r, lane); continue; } r -= I_GU;
            if (r < I_IN) { transpose_item(args.in[6], D, NIN, Win, 3, scr, r, lane); continue; } r -= I_IN;
            if (r < I_C) { transpose_item(args.in[11], D, D, Wc, 0, scr, r, lane); continue; } r -= I_C;
            if (r < I_A) { transpose_item(args.in[12], 512, D, Wa, 0, scr, r, lane); continue; } r -= I_A;
            transpose_item(args.in[13], D, D, Wo, 0, scr, r, lane);
        }
        rms_rows<true>(x, args.in[1], H, gw, NGW, lane);
        __syncthreads();
    }
    SEAM(0);
    if (IN(1)) GEMM_PHASE(pg8::EpiPair<0>, H, Wgu1, 2 * FF, D, A1, FF);
    SEAM(1);
    if (IN(2)) GEMM_PHASE(pg8::EpiResid<false>, A1, Wd1, D, FF, x, XB, 0.5f);
    SEAM(2);
    if (IN(3)) rms_rows_bb(XB, args.in[5], H, gw, NGW, lane);
    SEAM(3);
    if (IN(4)) GEMM_PHASE(pg8::EpiPair<1>, H, Win, 2048, D, ZG, D);
    SEAM(4);
    if (IN(5)) conv_phase(ZG, args.in[7], args.in[8], args.in[9], args.in[10], ZC, (LAS float*)lds, vcu, G);
    SEAM(5);
    if (IN(6)) GEMM_PHASE(pg8::EpiQKV, H, Win + (size_t)2048 * D, 3 * AW, D, Qb, (size_t)(WS_K - WS_Q) / 2, 0.08838834764831845f * 1.4426950408889634f);
    SEAM(6);
    if (IN(7)) attn_phase(lds, Qb, Kb, Vb, Qb, LSE, vcu, G);
    SEAM(7);
    if (IN(8)) { merge_rows(Qb, LSE, ATT, gw, NGW, lane); __syncthreads(); }
    if (IN(8)) GEMM_PHASE(pg8::EpiSig, H, Win + (size_t)6656 * D, 2048, D, GT, 2048);
    SEAM(8);
    if (IN(9)) GEMM_PHASE(pg8::EpiGate<false>, ZC, Wc, D, D, nullptr, GT, 2048, T1);
    if (IN(10)) GEMM_PHASE(pg8::EpiGate<true>, ATT, Wa, D, 512, T1, GT + 1024, 2048, MIX);
    SEAM(10);
    if (IN(11)) GEMM_PHASE(pg8::EpiResid<true>, MIX, Wo, D, D, XB, XB, 1.0f);
    SEAM(11);
    if (IN(12)) rms_rows_bb(XB, args.in[14], H, gw, NGW, lane);
    SEAM(12);
    if (IN(13)) GEMM_PHASE(pg8::EpiPair<0>, H, Wgu2, 2 * FF, D, A1, FF);
    SEAM(13);
    if (IN(14)) GEMM_PHASE(pg8::EpiResid<true>, A1, Wd2, D, FF, XB, H, 0.5f);
    SEAM(14);
    if (IN(15)) rms_rows_b(H, args.in[18], X, gw, NGW, lane);
#undef IN
#undef SEAM
}
constexpr int NPHASES = 16;

extern "C" void kernel_launch(void* const* d_in, const int* in_sizes, int n_in, void* d_out, int out_size, void* d_ws, size_t ws_size, hipStream_t stream) {
    static int grid = 0;
    if (grid == 0) {
        if (n_in != 19 || out_size != M * D || ws_size < WS_END) { fprintf(stderr, "kernel_launch: unexpected shapes (n_in %d out %d ws %zu)\n", n_in, out_size, ws_size); grid = -1; return; }
        int dev = 0, cus = 0, per_cu = 0;
        hipGetDevice(&dev); hipDeviceGetAttribute(&cus, hipDeviceAttributeMultiprocessorCount, dev);
        if (hipFuncSetAttribute((const void*)fwd_kernel, hipFuncAttributeMaxDynamicSharedMemorySize, LDS_BYTES) != hipSuccess) { fprintf(stderr, "kernel_launch: hipFuncSetAttribute failed\n"); grid = -1; return; }
        if (hipOccupancyMaxActiveBlocksPerMultiprocessor(&per_cu, (const void*)fwd_kernel, NTHREADS, LDS_BYTES) != hipSuccess || per_cu < 1) { fprintf(stderr, "kernel_launch: occupancy query says %d\n", per_cu); per_cu = 1; }
        (void)hipGetLastError();
        if (per_cu > 1) per_cu = 1;
        grid = cus * per_cu;
    }
    if (grid < 0) return;
    Args a{};
    for (int i = 0; i < 19; ++i) a.in[i] = (const float*)d_in[i];
    a.out = (float*)d_out; a.ws = (unsigned char*)d_ws;
#if MK_MULTI
    for (int p = 0; p < NPHASES; ++p) { a.ph_lo = p; a.ph_hi = p + 1; hipLaunchKernelGGL(fwd_kernel, dim3(grid), dim3(NTHREADS), LDS_BYTES, stream, a); }
#else
    a.ph_lo = 0; a.ph_hi = NPHASES;
#if MK_CG
    void* kargs[] = {&a};
    hipError_t e = hipLaunchCooperativeKernel((const void*)fwd_kernel, dim3(grid), dim3(NTHREADS), kargs, LDS_BYTES, stream);
    if (e != hipSuccess) fprintf(stderr, "cooperative launch failed: %s (grid %d)\n", hipGetErrorString(e), grid);
#else
    if (hipMemsetAsync((char*)d_ws + WS_CTL, 0, 65536, stream) != hipSuccess) { fprintf(stderr, "kernel_launch: memset failed\n"); return; }
    hipLaunchKernelGGL(fwd_kernel, dim3(grid), dim3(NTHREADS), LDS_BYTES, stream, a);
#endif
#endif
}
```

```cpp
#include <hip/hip_runtime.h>
#include <cstdio>
#include <cstdint>
namespace pg8 {
#define PG8_LAS __attribute__((address_space(3)))
typedef unsigned short bf16_t;
typedef short bf16x8 __attribute__((ext_vector_type(8)));
typedef float f32x4 __attribute__((ext_vector_type(4)));
typedef unsigned u32x4 __attribute__((ext_vector_type(4)));
constexpr int BM = 256, BK = 64, HALF = 128, HTB = HALF * BK * 2  , STAGE_BYTES = 8 * HTB, NXCD = 8, WGM = 8;

__host__ __device__ __forceinline__ int lds_byte(int r, int c) { const int st = (r >> 4) * 2 + (c >> 5), rr = r & 15, cc = c & 31, ob = rr * 64 + cc * 2; return st * 1024 + (ob ^ (((ob >> 9) & 1) << 5)); }
__host__ __device__ __forceinline__ void stage_rc(int b, int& R, int& C) { const int st = b / 1024, sb = b % 1024, swz = sb ^ (((sb >> 9) & 1) << 5); R = (st >> 1) * 16 + swz / 64; C = (st & 1) * 32 + (swz % 64) / 2; }
__host__ __device__ __forceinline__ int perm32(int rho) { const int n = rho >> 4, i = rho & 15; return 8 * (i >> 2) + 4 * n + (i & 3); }

struct Unit { int pm, pn; };
struct Gemm { const bf16_t* A; const bf16_t* Bt; int M, N, K; };

struct StaticOrder {
    int nM, nN, nwg, G, c;
    __host__ __device__ void init(int M, int N, int G_, int c_) { nM = M / BM; nN = N / BM; nwg = nM * nN; G = G_; c = c_; }
    __host__ __device__ bool next(int i, Unit& u) const {
        const long L = (long)i * G + c; if (L >= nwg) return false;
        int wgid = (int)L; { const int q = nwg / NXCD, r = nwg % NXCD, xcd = wgid % NXCD, off = wgid / NXCD; wgid = (xcd < r ? xcd * (q + 1) : r * (q + 1) + (xcd - r) * q) + off; }
        const int nig = WGM * nN, gid = wgid / nig, fm = gid * WGM, gsz = (nM - fm) < WGM ? (nM - fm) : WGM;
        u.pm = fm + ((wgid % nig) % gsz); u.pn = (wgid % nig) / gsz; return true;
    }
    __device__ __forceinline__ void a_ready(const Unit&) const {}
    __device__ __forceinline__ void done(const Unit&) const {}
};

typedef float f32x2_t __attribute__((ext_vector_type(2))); typedef __bf16 bf16x2_t __attribute__((ext_vector_type(2)));
__device__ __forceinline__ unsigned cvt_pk_bf16(float lo, float hi) { const f32x2_t v = {lo, hi}; const bf16x2_t b = __builtin_convertvector(v, bf16x2_t); return __builtin_bit_cast(unsigned, b); }
typedef float f32x2 __attribute__((ext_vector_type(2)));
__device__ __forceinline__ float sigmoid_f(float x) { return __builtin_amdgcn_rcpf(1.0f + __builtin_amdgcn_exp2f(-1.4426950408889634f * x)); }
__device__ __forceinline__ float bf_lo(unsigned u) { return __uint_as_float(u << 16); }
__device__ __forceinline__ float bf_hi(unsigned u) { return __uint_as_float(u & 0xffff0000u); }

template <int ACT> struct EpiPair {
    static constexpr bool PERM = true, AFTER_DRAIN = false;
    bf16_t* O; int ldo;
    __device__ __forceinline__ void operator()(const f32x4 (&acc)[2][2][4][2], const Unit& u, int wr, int wc, int fr, int fq, int ui, PG8_LAS unsigned char* lds) const {
        const PG8_LAS float* rs = (const PG8_LAS float*)(lds + 131072);
        const int row0 = u.pm * BM + wr * 64 + fr, col0 = u.pn * HALF + wc * 32 + 8 * fq;
#pragma unroll
        for (int ai = 0; ai < 2; ++ai)
#pragma unroll
            for (int m = 0; m < 4; ++m) { const float rsv = rs[ui * 256 + ai * HALF + wr * 64 + m * 16 + fr];
                float v[8];
#pragma unroll
                for (int n = 0; n < 2; ++n)
#pragma unroll
                    for (int i = 0; i < 4; ++i) { const float a = acc[ai][0][m][n][i] * rsv, b = acc[ai][1][m][n][i] * rsv;
                        v[n * 4 + i] = (ACT == 0) ? a * sigmoid_f(a) * b : a * sigmoid_f(b); }
                u32x4 w; w.x = cvt_pk_bf16(v[0], v[1]); w.y = cvt_pk_bf16(v[2], v[3]); w.z = cvt_pk_bf16(v[4], v[5]); w.w = cvt_pk_bf16(v[6], v[7]);
                *(u32x4*)(O + (size_t)(row0 + ai * HALF + m * 16) * ldo + col0) = w; }
    }
};
template <bool BASE_BF16> struct EpiResid {
    static constexpr bool PERM = true, AFTER_DRAIN = false;
    const void* base; bf16_t* outb; float* ss; float alpha;
    __device__ __forceinline__ void operator()(const f32x4 (&acc)[2][2][4][2], const Unit& u, int wr, int wc, int fr, int fq, int, PG8_LAS unsigned char*) const {
        const int row0 = u.pm * BM + wr * 64 + fr, col0 = u.pn * BM + wc * 32 + 8 * fq;
#pragma unroll
        for (int ai = 0; ai < 2; ++ai)
#pragma unroll
            for (int m = 0; m < 4; ++m) { const size_t off = (size_t)(row0 + ai * HALF + m * 16) * 1024 + col0; float sq = 0.f;
#pragma unroll
                for (int bj = 0; bj < 2; ++bj) { f32x4 b0, b1;
                    if (BASE_BF16) { const u32x4 r = *(const u32x4*)((const bf16_t*)base + off + bj * HALF);
                        b0 = (f32x4){bf_lo(r.x), bf_hi(r.x), bf_lo(r.y), bf_hi(r.y)}; b1 = (f32x4){bf_lo(r.z), bf_hi(r.z), bf_lo(r.w), bf_hi(r.w)}; }
                    else { b0 = *(const f32x4*)((const float*)base + off + bj * HALF); b1 = *(const f32x4*)((const float*)base + off + bj * HALF + 4); }
                    const f32x4 v0 = b0 + acc[ai][bj][m][0] * alpha, v1 = b1 + acc[ai][bj][m][1] * alpha;
                    u32x4 w; w.x = cvt_pk_bf16(v0[0], v0[1]); w.y = cvt_pk_bf16(v0[2], v0[3]); w.z = cvt_pk_bf16(v1[0], v1[1]); w.w = cvt_pk_bf16(v1[2], v1[3]);
                    *(u32x4*)(outb + off + bj * HALF) = w;
                    { const float r0 = bf_lo(w.x), r1 = bf_hi(w.x), r2 = bf_lo(w.y), r3 = bf_hi(w.y), r4 = bf_lo(w.z), r5 = bf_hi(w.z), r6 = bf_lo(w.w), r7 = bf_hi(w.w);
                      sq += ((r0 * r0 + r1 * r1) + (r2 * r2 + r3 * r3)) + ((r4 * r4 + r5 * r5) + (r6 * r6 + r7 * r7)); } }
                if (ss) { sq += __shfl_xor(sq, 16); sq += __shfl_xor(sq, 32); if (fq == 0) ss[(size_t)(row0 + ai * HALF + m * 16) * 16 + u.pn * 4 + wc] = sq; } }
    }
};
struct EpiQKV {
    static constexpr bool PERM = true, AFTER_DRAIN = false;
    bf16_t* O; size_t tstride; float qscale;
    __device__ __forceinline__ void operator()(const f32x4 (&acc)[2][2][4][2], const Unit& u, int wr, int wc, int fr, int fq, int ui, PG8_LAS unsigned char* lds) const {
        const PG8_LAS float* rs = (const PG8_LAS float*)(lds + 131072);
        const int row0 = u.pm * BM + wr * 64 + fr; const int t = u.pn / 6, ct = u.pn - 6 * t, dsh = 2 * (ct >> 1);
        bf16_t* base = O + (size_t)t * tstride + wc * 32 + 8 * fq; const float sc0 = (t == 0) ? qscale : 1.0f;
#pragma unroll
        for (int ai = 0; ai < 2; ++ai)
#pragma unroll
            for (int m = 0; m < 4; ++m) { const int row = row0 + ai * HALF + m * 16, b = row >> 12, s = row & 4095;
                const int pos = ((s & ((1 << dsh) - 1)) << (12 - dsh)) + (s >> dsh);
                const float sc = sc0 * rs[ui * 256 + ai * HALF + wr * 64 + m * 16 + fr];
#pragma unroll
                for (int bj = 0; bj < 2; ++bj) { const f32x4 v0 = acc[ai][bj][m][0] * sc, v1 = acc[ai][bj][m][1] * sc;
                    u32x4 w; w.x = cvt_pk_bf16(v0[0], v0[1]); w.y = cvt_pk_bf16(v0[2], v0[3]); w.z = cvt_pk_bf16(v1[0], v1[1]); w.w = cvt_pk_bf16(v1[2], v1[3]);
                    *(u32x4*)(base + ((size_t)((b * 12 + 2 * ct + bj) * 4096 + pos)) * 128) = w; } }
    }
};
struct EpiSig {
    static constexpr bool PERM = true, AFTER_DRAIN = false;
    bf16_t* O; int ldo;
    __device__ __forceinline__ void operator()(const f32x4 (&acc)[2][2][4][2], const Unit& u, int wr, int wc, int fr, int fq, int ui, PG8_LAS unsigned char* lds) const {
        const PG8_LAS float* rs = (const PG8_LAS float*)(lds + 131072);
        const int row0 = u.pm * BM + wr * 64 + fr, col0 = u.pn * BM + wc * 32 + 8 * fq;
#pragma unroll
        for (int ai = 0; ai < 2; ++ai)
#pragma unroll
            for (int m = 0; m < 4; ++m) { bf16_t* rowp = O + (size_t)(row0 + ai * HALF + m * 16) * ldo + col0; const float rsv = rs[ui * 256 + ai * HALF + wr * 64 + m * 16 + fr];
#pragma unroll
                for (int bj = 0; bj < 2; ++bj) { float v[8];
#pragma unroll
                    for (int n = 0; n < 2; ++n)
#pragma unroll
                        for (int i = 0; i < 4; ++i) v[n * 4 + i] = sigmoid_f(acc[ai][bj][m][n][i] * rsv);
                    u32x4 w; w.x = cvt_pk_bf16(v[0], v[1]); w.y = cvt_pk_bf16(v[2], v[3]); w.z = cvt_pk_bf16(v[4], v[5]); w.w = cvt_pk_bf16(v[6], v[7]);
                    *(u32x4*)(rowp + bj * HALF) = w; } }
    }
};
template <bool HAS_BASE> struct EpiGate {
    static constexpr bool PERM = true, AFTER_DRAIN = false;
    const bf16_t* base; const bf16_t* gate; int ldg; bf16_t* O;
    __device__ __forceinline__ void operator()(const f32x4 (&acc)[2][2][4][2], const Unit& u, int wr, int wc, int fr, int fq, int, PG8_LAS unsigned char*) const {
        const int row0 = u.pm * BM + wr * 64 + fr, col0 = u.pn * BM + wc * 32 + 8 * fq;
#pragma unroll
        for (int ai = 0; ai < 2; ++ai)
#pragma unroll
            for (int m = 0; m < 4; ++m) { const size_t r = (size_t)(row0 + ai * HALF + m * 16);
#pragma unroll
                for (int bj = 0; bj < 2; ++bj) {
                    const u32x4 gv = *(const u32x4*)(gate + r * ldg + col0 + bj * HALF);
                    u32x4 bv = (u32x4){0u, 0u, 0u, 0u}; if (HAS_BASE) bv = *(const u32x4*)(base + r * 1024 + col0 + bj * HALF);
                    const f32x4 a0 = acc[ai][bj][m][0], a1 = acc[ai][bj][m][1];
                    float v[8];
                    v[0] = bf_lo(bv.x) + bf_lo(gv.x) * a0[0]; v[1] = bf_hi(bv.x) + bf_hi(gv.x) * a0[1];
                    v[2] = bf_lo(bv.y) + bf_lo(gv.y) * a0[2]; v[3] = bf_hi(bv.y) + bf_hi(gv.y) * a0[3];
                    v[4] = bf_lo(bv.z) + bf_lo(gv.z) * a1[0]; v[5] = bf_hi(bv.z) + bf_hi(gv.z) * a1[1];
                    v[6] = bf_lo(bv.w) + bf_lo(gv.w) * a1[2]; v[7] = bf_hi(bv.w) + bf_hi(gv.w) * a1[3];
                    u32x4 w; w.x = cvt_pk_bf16(v[0], v[1]); w.y = cvt_pk_bf16(v[2], v[3]); w.z = cvt_pk_bf16(v[4], v[5]); w.w = cvt_pk_bf16(v[6], v[7]);
                    *(u32x4*)(O + r * 1024 + col0 + bj * HALF) = w; } }
    }
};

template <class Epi, class Sched, bool ALIGN_EPI = false, bool SP2 = false>
__device__ __forceinline__ void gemm_phase(PG8_LAS unsigned char* lds, const Gemm g, const Sched& S, const Epi& E) {
    const int tid = threadIdx.x, wid = __builtin_amdgcn_readfirstlane(tid >> 6), lane = tid & 63, wr = wid >> 2, wc = wid & 3, fr = lane & 15, fq = lane >> 4;
    const int K = g.K, nt = K / BK;
    unsigned voffA[2], voffB[2];
#pragma unroll
    for (int i = 0; i < 2; ++i) { int R, C; stage_rc(tid * 16 + i * 8192, R, C); const int Rb = Epi::PERM ? ((R & ~31) + perm32(R & 31)) : R;
        voffA[i] = (unsigned)(R * K + C) * 2u; voffB[i] = (unsigned)(Rb * K + C) * 2u; }
    const size_t kstep = (size_t)(BK * 2);
    const size_t hstep = (size_t)HALF * K * 2;
    const size_t tstep = 2 * hstep;
    const unsigned ldsw = (unsigned)wid * 1024u;
    const int aoff = lds_byte(wr * 64 + fr, fq * 8), boff = lds_byte(wc * 32 + fr, fq * 8);
#define PG8_SA(b, h) (((b) * 2 + (h)) * HTB)
#define PG8_SB(b, h) ((4 + (b) * 2 + (h)) * HTB)
#define PG8_STAGE(bufoff, gbase, voff) do { _Pragma("unroll") for (int _i = 0; _i < 2; ++_i) \
        __builtin_amdgcn_global_load_lds((const unsigned*)((const char*)(gbase) + (voff)[_i]), (PG8_LAS unsigned*)(lds + (bufoff) + ldsw + _i * 8192), 16, 0, 0); } while (0)
#define PG8_LDA(dst, b, h) do { _Pragma("unroll") for (int m = 0; m < 4; ++m) _Pragma("unroll") for (int k = 0; k < 2; ++k) dst[m][k] = *(const PG8_LAS bf16x8*)(lds + PG8_SA(b, h) + aoff + m * 2048 + k * 1024); } while (0)
#define PG8_LDB(dst, b, h) do { _Pragma("unroll") for (int n = 0; n < 2; ++n) _Pragma("unroll") for (int k = 0; k < 2; ++k) dst[n][k] = *(const PG8_LAS bf16x8*)(lds + PG8_SB(b, h) + boff + n * 2048 + k * 1024); } while (0)
#define PG8_MMA(ai, bj, At, Bt) do { __builtin_amdgcn_s_setprio(1); _Pragma("unroll") for (int m = 0; m < 4; ++m) _Pragma("unroll") for (int n = 0; n < 2; ++n) _Pragma("unroll") for (int k = 0; k < 2; ++k) \
        acc[ai][bj][m][n] = __builtin_amdgcn_mfma_f32_16x16x32_bf16(Bt[n][k], At[m][k], acc[ai][bj][m][n], 0, 0, 0); __builtin_amdgcn_s_setprio(0); } while (0)
#define PG8_WAIT_V(n) asm volatile("s_waitcnt vmcnt(" #n ")" ::: "memory")
#define PG8_WAIT_L(n) asm volatile("s_waitcnt lgkmcnt(" #n ")" ::: "memory")
#define PG8_BAR __builtin_amdgcn_s_barrier()
#define PG8_SCHED __builtin_amdgcn_sched_barrier(0)
    Unit cur, nxt; int ui = 0;
    if (!S.next(0, cur)) return;
    f32x4 acc[2][2][4][2];
#pragma unroll
    for (int a = 0; a < 2; ++a)
#pragma unroll
        for (int b = 0; b < 2; ++b)
#pragma unroll
            for (int m = 0; m < 4; ++m)
#pragma unroll
                for (int n = 0; n < 2; ++n) acc[a][b][m][n] = (f32x4){0.f, 0.f, 0.f, 0.f};
    bf16x8 At[4][2], B0[2][2], B1[2][2];
    const char* cA = (const char*)g.A + (size_t)cur.pm * tstep; const char* cB = (const char*)g.Bt + (size_t)cur.pn * tstep;
    S.a_ready(cur);
    if constexpr (SP2) {
        PG8_STAGE(PG8_SB(0, 0), cB, voffB); PG8_STAGE(PG8_SB(0, 1), cB + hstep, voffB); PG8_STAGE(PG8_SA(0, 0), cA, voffA); PG8_STAGE(PG8_SA(0, 1), cA + hstep, voffA);
        if (wr == 1) PG8_BAR;
        PG8_WAIT_V(2); PG8_BAR;
        PG8_STAGE(PG8_SB(1, 0), cB + kstep, voffB); PG8_STAGE(PG8_SA(1, 0), cA + kstep, voffA); PG8_STAGE(PG8_SB(1, 1), cB + hstep + kstep, voffB);
        PG8_WAIT_V(6); PG8_BAR;
    } else {
        PG8_STAGE(PG8_SB(0, 0), cB, voffB); PG8_STAGE(PG8_SA(0, 0), cA, voffA); PG8_STAGE(PG8_SB(0, 1), cB + hstep, voffB); PG8_STAGE(PG8_SA(0, 1), cA + hstep, voffA);
        if (wr == 1) PG8_BAR;
        PG8_WAIT_V(4); PG8_BAR;
        PG8_STAGE(PG8_SB(1, 0), cB + kstep, voffB); PG8_STAGE(PG8_SA(1, 0), cA + kstep, voffA); PG8_STAGE(PG8_SB(1, 1), cB + hstep + kstep, voffB);
        PG8_WAIT_V(6); PG8_BAR;
    }
    for (;;) {
        const bool has_next = S.next(ui + 1, nxt);
        const char* nA = has_next ? (const char*)g.A + (size_t)nxt.pm * tstep : cA; const char* nB = has_next ? (const char*)g.Bt + (size_t)nxt.pn * tstep : cB;
        for (int t = 0; t < nt; t += 2) {
            const bool last = (t == nt - 2);
            const char* a1 = cA + (size_t)(t + 1) * kstep;
            const char* a2 = last ? nA : cA + (size_t)(t + 2) * kstep; const char* b2 = last ? nB : cB + (size_t)(t + 2) * kstep;
            const char* a3 = a2 + kstep; const char* b3 = b2 + kstep;
            if (last && has_next) S.a_ready(nxt);
            if constexpr (SP2) {
            PG8_LDB(B0, 0, 0); PG8_LDB(B1, 0, 1); PG8_SCHED; PG8_LDA(At, 0, 0); PG8_STAGE(PG8_SA(1, 1), a1 + hstep, voffA);
            PG8_WAIT_V(8); PG8_WAIT_L(0); PG8_BAR; PG8_MMA(0, 0, At, B0); PG8_MMA(0, 1, At, B1); PG8_BAR; PG8_SCHED;
            PG8_LDA(At, 0, 1); PG8_STAGE(PG8_SB(0, 0), b2, voffB); PG8_STAGE(PG8_SB(0, 1), b2 + hstep, voffB); PG8_STAGE(PG8_SA(0, 0), a2, voffA);
            PG8_WAIT_V(8); PG8_WAIT_L(0); PG8_BAR; PG8_MMA(1, 0, At, B0); PG8_MMA(1, 1, At, B1); PG8_BAR; PG8_SCHED;
            PG8_LDB(B0, 1, 0); PG8_LDB(B1, 1, 1); PG8_SCHED; PG8_LDA(At, 1, 0); PG8_STAGE(PG8_SA(0, 1), a2 + hstep, voffA);
            PG8_WAIT_V(8); PG8_WAIT_L(0); PG8_BAR; PG8_MMA(0, 0, At, B0); PG8_MMA(0, 1, At, B1); PG8_BAR; PG8_SCHED;
            PG8_LDA(At, 1, 1); PG8_STAGE(PG8_SB(1, 0), b3, voffB); PG8_STAGE(PG8_SB(1, 1), b3 + hstep, voffB); PG8_STAGE(PG8_SA(1, 0), a3, voffA);
            PG8_WAIT_V(8); PG8_WAIT_L(0); PG8_BAR; PG8_MMA(1, 0, At, B0); PG8_MMA(1, 1, At, B1); PG8_BAR; PG8_SCHED;
            } else {
            PG8_LDB(B0, 0, 0); PG8_SCHED; PG8_LDA(At, 0, 0); PG8_STAGE(PG8_SA(1, 1), a1 + hstep, voffA);
            PG8_WAIT_L(8); PG8_BAR; PG8_WAIT_L(0); PG8_MMA(0, 0, At, B0); PG8_BAR; PG8_SCHED;
            PG8_LDB(B1, 0, 1); PG8_STAGE(PG8_SB(0, 0), b2, voffB);
            PG8_BAR; PG8_WAIT_L(0); PG8_MMA(0, 1, At, B1); PG8_BAR;
            PG8_LDA(At, 0, 1); PG8_STAGE(PG8_SA(0, 0), a2, voffA);
            PG8_BAR; PG8_WAIT_L(0); PG8_MMA(1, 0, At, B0); PG8_BAR; PG8_SCHED;
            PG8_STAGE(PG8_SB(0, 1), b2 + hstep, voffB);
            PG8_WAIT_V(6); PG8_BAR; PG8_MMA(1, 1, At, B1); PG8_BAR;
            PG8_LDB(B0, 1, 0); PG8_SCHED; PG8_LDA(At, 1, 0); PG8_STAGE(PG8_SA(0, 1), a2 + hstep, voffA);
            PG8_WAIT_L(8); PG8_BAR; PG8_WAIT_L(0); PG8_MMA(0, 0, At, B0); PG8_BAR; PG8_SCHED;
            PG8_LDB(B1, 1, 1); PG8_STAGE(PG8_SB(1, 0), b3, voffB);
            PG8_BAR; PG8_WAIT_L(0); PG8_MMA(0, 1, At, B1); PG8_BAR;
            PG8_LDA(At, 1, 1); PG8_STAGE(PG8_SA(1, 0), a3, voffA);
            PG8_BAR; PG8_WAIT_L(0); PG8_MMA(1, 0, At, B0); PG8_BAR; PG8_SCHED;
            PG8_STAGE(PG8_SB(1, 1), b3 + hstep, voffB);
            PG8_WAIT_V(6); PG8_BAR; PG8_MMA(1, 1, At, B1); PG8_BAR;
            }
        }
        if constexpr (ALIGN_EPI) { if (wr == 0) PG8_BAR; }
        if constexpr (!Epi::AFTER_DRAIN) { E(acc, cur, wr, wc, fr, fq, ui, lds); S.done(cur); }
        if (!has_next) break;
#pragma unroll
        for (int a = 0; a < 2; ++a)
#pragma unroll
            for (int b = 0; b < 2; ++b)
#pragma unroll
                for (int m = 0; m < 4; ++m)
#pragma unroll
                    for (int n = 0; n < 2; ++n) acc[a][b][m][n] = (f32x4){0.f, 0.f, 0.f, 0.f};
        cur = nxt; cA = nA; cB = nB; ++ui;
        if constexpr (ALIGN_EPI) { if (wr == 1) PG8_BAR; }
    }
    PG8_WAIT_V(0);
    if constexpr (!ALIGN_EPI) { if (wr == 0) PG8_BAR; }
    PG8_BAR;
    if constexpr (Epi::AFTER_DRAIN) { E.fused(acc, cur, wr, wc, fr, fq, lds, wid, lane); S.done(cur); }
#undef PG8_SA
#undef PG8_SB
#undef PG8_STAGE
#undef PG8_LDA
#undef PG8_LDB
#undef PG8_MMA
#undef PG8_WAIT_V
#undef PG8_WAIT_L
#undef PG8_BAR
#undef PG8_SCHED
}
}

#include <hip/hip_cooperative_groups.h>
namespace cg = cooperative_groups;
using pg8::sigmoid_f; using pg8::bf_lo; using pg8::bf_hi;
#define LAS __attribute__((address_space(3)))
typedef unsigned short bf16;
typedef unsigned v4u __attribute__((ext_vector_type(4)));
typedef unsigned v2u __attribute__((ext_vector_type(2)));
typedef float f32x4 __attribute__((ext_vector_type(4)));
typedef float f32x2 __attribute__((ext_vector_type(2)));
typedef short bf16x8 __attribute__((ext_vector_type(8)));
typedef short v4i16_t __attribute__((ext_vector_type(4)));

constexpr int NWAVES = 8, NTHREADS = 512;
constexpr int SEQ = 4096, BATCH = 8, M = BATCH * SEQ, D = 1024, FF = 2816, NIN = 8704, AW = 1536, CW = 31;
constexpr float EPS = 1e-6f;
constexpr size_t MiB = 1u << 20;
constexpr size_t WS_CTL = 0;
constexpr size_t WS_SS = 256 * 1024;
constexpr size_t WS_WGU1 = 1 * MiB, WS_WD1 = 12 * MiB, WS_WGU2 = 18 * MiB, WS_WD2 = 29 * MiB, WS_WIN = 35 * MiB, WS_WC = 52 * MiB, WS_WA = 54 * MiB, WS_WO = 55 * MiB;
constexpr size_t WS_H = 58 * MiB;
constexpr size_t WS_ZC = 122 * MiB;
constexpr size_t WS_Q = 186 * MiB;
constexpr size_t WS_K = 282 * MiB;
constexpr size_t WS_V = 378 * MiB;
constexpr size_t WS_LSE = 474 * MiB;
constexpr size_t WS_ATT = 476 * MiB;
constexpr size_t WS_ZG = WS_K;
constexpr size_t WS_G = WS_K;
constexpr size_t WS_T1 = WS_K + 128 * MiB;
constexpr size_t WS_MIX = WS_H;
constexpr size_t WS_A1 = WS_Q;
constexpr size_t WS_SSP = 508 * MiB;
constexpr size_t WS_END = 512 * MiB;
static_assert(WS_T1 + 64 * MiB <= WS_LSE && WS_A1 + (size_t)M * FF * 2 <= WS_LSE, "ws map");

constexpr int LDS_BYTES = 147456;

__device__ __forceinline__ float wave_sum(float v) {
#pragma unroll
    for (int o = 1; o < 64; o <<= 1) v += __shfl_xor(v, o);
    return v;
}
__device__ __forceinline__ unsigned pk2(float lo, float hi) { return pg8::cvt_pk_bf16(lo, hi); }

__device__ __forceinline__ int dst_row(int map, int n) {
    if (map == 3) { if (n < 1024) map = 1; else if (n < 2048) { map = 2; n -= 1024; } else map = 0; }
    if (map == 0) return n;
    return 256 * (n >> 7) + (n & 127) + (map == 2 ? 128 : 0);
}
__device__ __forceinline__ void transpose_item(const float* W, int K, int N, bf16* WT, int map, LAS float* scr, int item, int lane, const float* gain = nullptr) {
    const int nblk = N / 32, kb = item / nblk, nb = item % nblk, k0 = 64 * kb, n0 = 32 * nb;
    float wv[32];
#pragma unroll
    for (int i = 0; i < 32; ++i) wv[i] = W[(size_t)(k0 + 2 * i + (lane >> 5)) * N + n0 + (lane & 31)];
#pragma unroll
    for (int i = 0; i < 32; ++i) scr[(2 * i + (lane >> 5)) * 33 + (lane & 31)] = wv[i] * (gain ? gain[k0 + 2 * i + (lane >> 5)] : 1.0f);
    asm volatile("s_waitcnt lgkmcnt(0)" ::: "memory");
    const int c = lane & 7; const int r0 = dst_row(map, n0);
#pragma unroll
    for (int j = 0; j < 4; ++j) { const int n = (lane >> 3) + 8 * j; const LAS float* s = scr + (8 * c) * 33 + n;
        v4u o; o.x = pk2(s[0 * 33], s[1 * 33]); o.y = pk2(s[2 * 33], s[3 * 33]); o.z = pk2(s[4 * 33], s[5 * 33]); o.w = pk2(s[6 * 33], s[7 * 33]);
        *(v4u*)(WT + (size_t)(r0 + n) * K + k0 + 8 * c) = o; }
    asm volatile("s_waitcnt lgkmcnt(0)" ::: "memory");
}

template <bool OUT_BF16> __device__ __forceinline__ void rms_rows(const float* X, const float* gain, void* out, int gw, int NGW, int lane) {
    f32x4 gv[4];
#pragma unroll
    for (int j = 0; j < 4; ++j) gv[j] = ((const f32x4*)gain)[lane + 64 * j];
    for (int m0 = gw * 4; m0 < M; m0 += NGW * 4) {
        f32x4 v[4][4]; float s[4];
#pragma unroll
        for (int r = 0; r < 4; ++r) { const f32x4* xr = (const f32x4*)(X + (size_t)(m0 + r) * D) + lane;
#pragma unroll
            for (int j = 0; j < 4; ++j) v[r][j] = xr[64 * j]; }
#pragma unroll
        for (int r = 0; r < 4; ++r) { float a = 0.f;
#pragma unroll
            for (int j = 0; j < 4; ++j) a += (v[r][j].x * v[r][j].x + v[r][j].y * v[r][j].y) + (v[r][j].z * v[r][j].z + v[r][j].w * v[r][j].w);
            s[r] = a; }
#pragma unroll
        for (int o = 1; o < 64; o <<= 1) {
#pragma unroll
            for (int r = 0; r < 4; ++r) s[r] += __shfl_xor(s[r], o); }
#pragma unroll
        for (int r = 0; r < 4; ++r) { const float rstd = 1.0f / sqrtf(s[r] * (1.0f / D) + EPS);
            if (OUT_BF16) { v2u* o8 = (v2u*)((bf16*)out + (size_t)(m0 + r) * D) + lane;
#pragma unroll
                for (int j = 0; j < 4; ++j) { v2u w; w.x = pk2(v[r][j].x * rstd * gv[j].x, v[r][j].y * rstd * gv[j].y); w.y = pk2(v[r][j].z * rstd * gv[j].z, v[r][j].w * rstd * gv[j].w); o8[64 * j] = w; }
            } else { f32x4* o = (f32x4*)((float*)out + (size_t)(m0 + r) * D) + lane;
#pragma unroll
                for (int j = 0; j < 4; ++j) o[64 * j] = v[r][j] * rstd * gv[j]; } }
    }
}

__device__ __forceinline__ void rms_rows_bb(const bf16* Xb, const float* gain, bf16* out, int gw, int NGW, int lane) {
    f32x4 gv[4];
#pragma unroll
    for (int j = 0; j < 4; ++j) gv[j] = ((const f32x4*)gain)[lane + 64 * j];
    for (int m0 = gw * 4; m0 < M; m0 += NGW * 4) {
        v2u raw[4][4]; f32x4 v[4][4]; float s[4];
#pragma unroll
        for (int r = 0; r < 4; ++r) { const v2u* xr = (const v2u*)(Xb + (size_t)(m0 + r) * D) + lane;
#pragma unroll
            for (int j = 0; j < 4; ++j) raw[r][j] = xr[64 * j]; }
#pragma unroll
        for (int r = 0; r < 4; ++r) { float a = 0.f;
#pragma unroll
            for (int j = 0; j < 4; ++j) { v[r][j] = (f32x4){bf_lo(raw[r][j].x), bf_hi(raw[r][j].x), bf_lo(raw[r][j].y), bf_hi(raw[r][j].y)};
                a += (v[r][j].x * v[r][j].x + v[r][j].y * v[r][j].y) + (v[r][j].z * v[r][j].z + v[r][j].w * v[r][j].w); }
            s[r] = a; }
#pragma unroll
        for (int o = 1; o < 64; o <<= 1) {
#pragma unroll
            for (int r = 0; r < 4; ++r) s[r] += __shfl_xor(s[r], o); }
#pragma unroll
        for (int r = 0; r < 4; ++r) { const float rstd = 1.0f / sqrtf(s[r] * (1.0f / D) + EPS); v2u* o8 = (v2u*)(out + (size_t)(m0 + r) * D) + lane;
#pragma unroll
            for (int j = 0; j < 4; ++j) { v2u w; w.x = pk2(v[r][j].x * rstd * gv[j].x, v[r][j].y * rstd * gv[j].y); w.y = pk2(v[r][j].z * rstd * gv[j].z, v[r][j].w * rstd * gv[j].w); o8[64 * j] = w; } }
    }
}

__device__ __forceinline__ void rms_rows_b(const bf16* Xb, const float* gain, float* out, int gw, int NGW, int lane) {
    f32x4 gv[4];
#pragma unroll
    for (int j = 0; j < 4; ++j) gv[j] = ((const f32x4*)gain)[lane + 64 * j];
    for (int m0 = gw * 4; m0 < M; m0 += NGW * 4) {
        v2u raw[4][4]; f32x4 v[4][4]; float s[4];
#pragma unroll
        for (int r = 0; r < 4; ++r) { const v2u* xr = (const v2u*)(Xb + (size_t)(m0 + r) * D) + lane;
#pragma unroll
            for (int j = 0; j < 4; ++j) raw[r][j] = xr[64 * j]; }
#pragma unroll
        for (int r = 0; r < 4; ++r) { float a = 0.f;
#pragma unroll
            for (int j = 0; j < 4; ++j) { v[r][j] = (f32x4){bf_lo(raw[r][j].x), bf_hi(raw[r][j].x), bf_lo(raw[r][j].y), bf_hi(raw[r][j].y)};
                a += (v[r][j].x * v[r][j].x + v[r][j].y * v[r][j].y) + (v[r][j].z * v[r][j].z + v[r][j].w * v[r][j].w); }
            s[r] = a; }
#pragma unroll
        for (int o = 1; o < 64; o <<= 1) {
#pragma unroll
            for (int r = 0; r < 4; ++r) s[r] += __shfl_xor(s[r], o); }
#pragma unroll
        for (int r = 0; r < 4; ++r) { const float rstd = 1.0f / sqrtf(s[r] * (1.0f / D) + EPS); f32x4* o = (f32x4*)(out + (size_t)(m0 + r) * D) + lane;
#pragma unroll
            for (int j = 0; j < 4; ++j) o[64 * j] = v[r][j] * rstd * gv[j]; }
    }
}

__device__ __forceinline__ void raw_rows(const float* X, bf16* out, float* ss, int gw, int NGW, int lane) {
    for (int m0 = gw * 4; m0 < M; m0 += NGW * 4) {
        f32x4 v[4][4]; float s[4];
#pragma unroll
        for (int r = 0; r < 4; ++r) { const f32x4* xr = (const f32x4*)(X + (size_t)(m0 + r) * D) + lane;
#pragma unroll
            for (int j = 0; j < 4; ++j) v[r][j] = xr[64 * j]; }
#pragma unroll
        for (int r = 0; r < 4; ++r) { float a = 0.f;
#pragma unroll
            for (int j = 0; j < 4; ++j) a += (v[r][j].x * v[r][j].x + v[r][j].y * v[r][j].y) + (v[r][j].z * v[r][j].z + v[r][j].w * v[r][j].w);
            s[r] = a; }
#pragma unroll
        for (int o = 1; o < 64; o <<= 1) {
#pragma unroll
            for (int r = 0; r < 4; ++r) s[r] += __shfl_xor(s[r], o); }
#pragma unroll
        for (int r = 0; r < 4; ++r) { if (lane == 0) ss[m0 + r] = s[r];
            v2u* o8 = (v2u*)(out + (size_t)(m0 + r) * D) + lane;
#pragma unroll
            for (int j = 0; j < 4; ++j) { v2u w; w.x = pk2(v[r][j].x, v[r][j].y); w.y = pk2(v[r][j].z, v[r][j].w); o8[64 * j] = w; } }
    }
}

constexpr int CT = 16;
__device__ __forceinline__ void conv_phase(const bf16* Zg, const float* dwk, const float* dwb, const float* lng, const float* lnb, bf16* ZC, LAS float* red, int vcu, int G) {
    const int tid = threadIdx.x, lane = tid & 63, wave = tid >> 6, c = 2 * tid;
    float w0[CW], w1[CW];
#pragma unroll
    for (int j = 0; j < CW; ++j) { const f32x2 t = *(const f32x2*)(dwk + j * D + c); w0[j] = t.x; w1[j] = t.y; }
    const f32x2 bb = *(const f32x2*)(dwb + c), gg = *(const f32x2*)(lng + c), lb = *(const f32x2*)(lnb + c);
    constexpr int NT = M / CT; const int tpb = (NT + G - 1) / G; const int tb = vcu * tpb; int te = tb + tpb; if (te > NT) te = NT;
    if (tb >= te) return;
    float z0[CT + CW - 1], z1[CT + CW - 1]; unsigned nx[CT];
    { const int t0 = tb * CT, s0 = t0 & (SEQ - 1);
#pragma unroll
        for (int i = 0; i < CT + CW - 1; ++i) { const bool valid = (s0 + i - (CW - 1)) >= 0; unsigned pk = 0u;
            if (valid) pk = *(const unsigned*)(Zg + (size_t)(t0 + i - (CW - 1)) * D + c);
            z0[i] = bf_lo(pk); z1[i] = bf_hi(pk); } }
    for (int tile = tb; tile < te; ++tile) {
        const int t0 = tile * CT; const bool more = (tile + 1 < te);
        if (more) {
#pragma unroll
            for (int i = 0; i < CT; ++i) nx[i] = *(const unsigned*)(Zg + (size_t)(t0 + CT + i) * D + c); }
        float o0[CT], o1[CT];
#pragma unroll
        for (int t = 0; t < CT; ++t) { o0[t] = bb.x; o1[t] = bb.y; }
#pragma unroll
        for (int j = 0; j < CW; ++j) {
#pragma unroll
            for (int t = 0; t < CT; ++t) { o0[t] += w0[j] * z0[t + j]; o1[t] += w1[j] * z1[t + j]; } }
        { const bool fresh = (((t0 + CT) & (SEQ - 1)) == 0);
#pragma unroll
            for (int i = 0; i < CW - 1; ++i) { z0[i] = fresh ? 0.f : z0[i + CT]; z1[i] = fresh ? 0.f : z1[i + CT]; } }
        { float k32[2 * CT];
#pragma unroll
            for (int t = 0; t < CT; ++t) { k32[2 * t] = o0[t] + o1[t]; k32[2 * t + 1] = o0[t] * o0[t] + o1[t] * o1[t]; }
            float k16[16], k8[8], k4[4], k2[2];
            const bool b5 = (lane & 32) != 0, b4 = (lane & 16) != 0, b3 = (lane & 8) != 0, b2 = (lane & 4) != 0, b1 = (lane & 2) != 0;
#pragma unroll
            for (int k = 0; k < 16; ++k) { const float send = b5 ? k32[k] : k32[16 + k], mine = b5 ? k32[16 + k] : k32[k]; k16[k] = mine + __shfl_xor(send, 32); }
#pragma unroll
            for (int k = 0; k < 8; ++k) { const float send = b4 ? k16[k] : k16[8 + k], mine = b4 ? k16[8 + k] : k16[k]; k8[k] = mine + __shfl_xor(send, 16); }
#pragma unroll
            for (int k = 0; k < 4; ++k) { const float send = b3 ? k8[k] : k8[4 + k], mine = b3 ? k8[4 + k] : k8[k]; k4[k] = mine + __shfl_xor(send, 8); }
#pragma unroll
            for (int k = 0; k < 2; ++k) { const float send = b2 ? k4[k] : k4[2 + k], mine = b2 ? k4[2 + k] : k4[k]; k2[k] = mine + __shfl_xor(send, 4); }
            const float send1 = b1 ? k2[0] : k2[1], mine1 = b1 ? k2[1] : k2[0]; float tot = mine1 + __shfl_xor(send1, 2);
            tot += __shfl_xor(tot, 1);
            if ((lane & 1) == 0) red[(lane >> 1) * 8 + wave] = tot; }
        __syncthreads();
        if (tid < CT) {
            const f32x4 a = *(const LAS f32x4*)(red + (2 * tid) * 8), b = *(const LAS f32x4*)(red + (2 * tid) * 8 + 4);
            const f32x4 p = *(const LAS f32x4*)(red + (2 * tid + 1) * 8), q = *(const LAS f32x4*)(red + (2 * tid + 1) * 8 + 4);
            const float s1 = ((a.x + a.y) + (a.z + a.w)) + ((b.x + b.y) + (b.z + b.w)), s2 = ((p.x + p.y) + (p.z + p.w)) + ((q.x + q.y) + (q.z + q.w));
            const float mu = s1 * (1.0f / D); const float var = fmaxf(s2 * (1.0f / D) - mu * mu, 0.f);
            *(LAS f32x2*)(red + 256 + 2 * tid) = (f32x2){mu, 1.0f / sqrtf(var + EPS)}; }
        __syncthreads();
        unsigned* outp = (unsigned*)(ZC + (size_t)t0 * D + c);
#pragma unroll
        for (int t = 0; t < CT; ++t) { const f32x2 st = *(const LAS f32x2*)(red + 256 + 2 * t);
            float y0 = (o0[t] - st.x) * st.y * gg.x + lb.x, y1 = (o1[t] - st.x) * st.y * gg.y + lb.y;
            y0 = y0 * sigmoid_f(y0); y1 = y1 * sigmoid_f(y1);
            outp[(size_t)t * (D / 2)] = pk2(y0, y1); }
        if (more) {
#pragma unroll
            for (int i = 0; i < CT; ++i) { z0[CW - 1 + i] = bf_lo(nx[i]); z1[CW - 1 + i] = bf_hi(nx[i]); } }
        __syncthreads();
    }
}

constexpr int VROW = 272;
constexpr int ATT_UNITS = BATCH * 12 * 32;
__device__ __forceinline__ v4i16_t tr16(const LAS unsigned char* p) { return __builtin_amdgcn_ds_read_tr16_b64_v4i16((LAS v4i16_t*)p); }
struct AttnPre { v4u k[4], v[4]; bf16x8 q[4]; };
struct AttnIdx { size_t row0; int hg, dsh, n; };
__device__ __forceinline__ AttnIdx attn_decode(int unit) {
    AttnIdx x; const int bh = unit >> 5, j = unit & 31; x.hg = bh % 12; const int gi = x.hg >> 2;
    x.dsh = 2 * gi; const int nbsh = 5 - x.dsh;
    x.n = j & ((1 << nbsh) - 1);
    x.row0 = (size_t)bh * SEQ + (size_t)j * 128; return x;
}
constexpr int ATT_HB = 128 * VROW;
constexpr int ATT_KOFF = 0, ATT_VOFF = 2 * ATT_HB;
__device__ __forceinline__ void attn_load_kv(AttnPre& p, const bf16* K, const bf16* V, size_t r0, int tid) {
#pragma unroll
    for (int i = 0; i < 4; ++i) { const size_t off = r0 * 128 + (size_t)(tid + 512 * i) * 8; p.k[i] = *(const v4u*)(K + off); p.v[i] = *(const v4u*)(V + off); }
}
__device__ __forceinline__ void attn_load(AttnPre& p, const bf16* Q, const bf16* K, const bf16* V, int unit, int tid, int w, int lq, int g) {
    const AttnIdx x = attn_decode(unit);
    attn_load_kv(p, K, V, x.row0, tid);
#pragma unroll
    for (int s = 0; s < 4; ++s) p.q[s] = *(const bf16x8*)(Q + (x.row0 + 16 * w + lq) * 128 + 32 * s + 8 * g);
}
__device__ __forceinline__ void attn_stage(LAS unsigned char* lds, const AttnPre& p, int half, int tid) {
#pragma unroll
    for (int i = 0; i < 4; ++i) { const int cidx = tid + 512 * i, row = cidx >> 4, ch = cidx & 15;
        *(LAS v4u*)(lds + ATT_KOFF + half * ATT_HB + row * VROW + ch * 16) = p.k[i]; *(LAS v4u*)(lds + ATT_VOFF + half * ATT_HB + row * VROW + ch * 16) = p.v[i]; }
}
__device__ __forceinline__ void attn_compute(LAS unsigned char* lds, const bf16x8 (&qf)[4], bf16* O, float* LSE, int unit, int f, int lane, int w, int lq, int g) {
    const AttnIdx x = attn_decode(unit); const int hg = x.hg, n = x.n;
    int rowT[9];
#pragma unroll
    for (int T = 0; T < 9; ++T) { const int kk0 = 16 * w + 16 * T; rowT[T] = ((((kk0 >> 7) ^ f) & 1) << 7) + (kk0 & 127); }
    f32x4 st[9];
    const LAS unsigned char* kb = lds + ATT_KOFF + lq * VROW + 16 * g;
#pragma unroll
    for (int T = 0; T < 9; ++T) { f32x4 a = (f32x4){0.f, 0.f, 0.f, 0.f}; const LAS unsigned char* kp = kb + rowT[T] * VROW;
#pragma unroll
        for (int s = 0; s < 4; ++s) { const bf16x8 kf = *(const LAS bf16x8*)(kp + 64 * s); a = __builtin_amdgcn_mfma_f32_16x16x32_bf16(kf, qf[s], a, 0, 0, 0); }
        st[T] = a; }
    const float slope2 = __builtin_amdgcn_exp2f(-(float)(8 * (hg + 1)) * (1.0f / 12.0f)) * (float)(1 << x.dsh) * 1.4426950408889634f;
    float mx = -__builtin_inff();
#pragma unroll
    for (int T = 0; T < 9; ++T)
#pragma unroll
        for (int reg = 0; reg < 4; ++reg) { const int steps = 128 + lq - 16 * T - 4 * g - reg, ki = 16 * w + 16 * T + 4 * g + reg;
            const bool valid = (steps >= 0) && (steps <= 128) && (n > 0 || ki >= 128);
            const float v = valid ? st[T][reg] - slope2 * (float)steps : -__builtin_inff(); st[T][reg] = v; mx = fmaxf(mx, v); }
    mx = fmaxf(mx, __shfl_xor(mx, 16)); mx = fmaxf(mx, __shfl_xor(mx, 32));
    float sum = 0.f;
#pragma unroll
    for (int T = 0; T < 9; ++T)
#pragma unroll
        for (int reg = 0; reg < 4; ++reg) { const float p = __builtin_amdgcn_exp2f(st[T][reg] - mx); st[T][reg] = p; sum += p; }
    sum += __shfl_xor(sum, 16); sum += __shfl_xor(sum, 32);
    bf16x8 pf[5];
#pragma unroll
    for (int u = 0; u < 5; ++u) { v4u t; t.x = pk2(st[2 * u][0], st[2 * u][1]); t.y = pk2(st[2 * u][2], st[2 * u][3]);
        if (u < 4) { t.z = pk2(st[2 * u + 1][0], st[2 * u + 1][1]); t.w = pk2(st[2 * u + 1][2], st[2 * u + 1][3]); } else { t.z = 0u; t.w = 0u; }
        pf[u] = __builtin_bit_cast(bf16x8, t); }
    const LAS unsigned char* vb = lds + ATT_VOFF + (4 * g + ((lane & 15) >> 2)) * VROW + (lane & 3) * 16;
    f32x4 o[4][2];
#pragma unroll
    for (int cp = 0; cp < 4; ++cp) { o[cp][0] = (f32x4){0.f, 0.f, 0.f, 0.f}; o[cp][1] = (f32x4){0.f, 0.f, 0.f, 0.f}; }
#pragma unroll
    for (int u = 0; u < 5; ++u) { const LAS unsigned char* vlo = vb + rowT[2 * u] * VROW; const LAS unsigned char* vhi = vb + rowT[u < 4 ? 2 * u + 1 : 8] * VROW;
#pragma unroll
        for (int cp = 0; cp < 4; ++cp)
#pragma unroll
            for (int h2 = 0; h2 < 2; ++h2) {
                const v4i16_t lo = tr16(vlo + cp * 64 + h2 * 8), hi = tr16(vhi + cp * 64 + h2 * 8);
                const bf16x8 vf = (bf16x8){lo[0], lo[1], lo[2], lo[3], hi[0], hi[1], hi[2], hi[3]};
                o[cp][h2] = __builtin_amdgcn_mfma_f32_16x16x32_bf16(vf, pf[u], o[cp][h2], 0, 0, 0); } }
    const float inv = 1.0f / sum;
    const size_t rq = x.row0 + 16 * w + lq;
    bf16* op = O + rq * 128 + 8 * g;
#pragma unroll
    for (int cp = 0; cp < 4; ++cp) { const f32x4 a = o[cp][0] * inv, c = o[cp][1] * inv;
        v4u t; t.x = pk2(a[0], a[1]); t.y = pk2(a[2], a[3]); t.z = pk2(c[0], c[1]); t.w = pk2(c[2], c[3]);
        *(v4u*)(op + 32 * cp) = t; }
    if (g == 0) LSE[rq] = mx + __builtin_amdgcn_logf(sum);
}
__device__ __forceinline__ void attn_phase(LAS unsigned char* lds, const bf16* Q, const bf16* K, const bf16* V, bf16* O, float* LSE, int vcu, int G) {
    const int tid = threadIdx.x, lane = tid & 63, w = __builtin_amdgcn_readfirstlane(tid >> 6), lq = lane & 15, g = lane >> 4;
    const int upb = (ATT_UNITS + G - 1) / G; const int u0 = vcu * upb; int u1 = u0 + upb; if (u1 > ATT_UNITS) u1 = ATT_UNITS;
    if (u0 >= u1) return;
    for (int i = tid; i < 4 * ATT_HB / 16; i += NTHREADS) ((LAS v4u*)lds)[i] = (v4u){0u, 0u, 0u, 0u};
    __syncthreads();
    AttnPre pre; int f = 0;
    { const AttnIdx x0 = attn_decode(u0); if (x0.n > 0) { attn_load_kv(pre, K, V, x0.row0 - 128, tid); attn_stage(lds, pre, f, tid); } }
    attn_load(pre, Q, K, V, u0, tid, w, lq, g);
    for (int u = u0; u < u1; ++u) {
        bf16x8 qf[4];
#pragma unroll
        for (int s = 0; s < 4; ++s) qf[s] = pre.q[s];
        attn_stage(lds, pre, f ^ 1, tid);
        __syncthreads();
        if (u + 1 < u1) attn_load(pre, Q, K, V, u + 1, tid, w, lq, g);
        attn_compute(lds, qf, O, LSE, u, f, lane, w, lq, g);
        __syncthreads();
        f ^= 1;
    }
}

__device__ __forceinline__ void merge_rows(const bf16* OG, const float* LSE, bf16* ATT, int gw, int NGW, int lane) {
    const int hh = lane >> 4, c0 = (lane & 15) * 8;
    for (int m0 = gw * 4; m0 < M; m0 += NGW * 4) {
        float l[4][3]; v4u a[4][3];
#pragma unroll
        for (int r = 0; r < 4; ++r) { const int m = m0 + r, b = m >> 12, s = m & 4095;
#pragma unroll
            for (int gi = 0; gi < 3; ++gi) { const int dsh = 2 * gi; const int pos = ((s & ((1 << dsh) - 1)) << (12 - dsh)) + (s >> dsh);
                const size_t row = (size_t)(b * 12 + gi * 4 + hh) * 4096 + pos; l[r][gi] = LSE[row]; a[r][gi] = *(const v4u*)(OG + row * 128 + c0); } }
#pragma unroll
        for (int r = 0; r < 4; ++r) {
            const float mx = fmaxf(l[r][0], fmaxf(l[r][1], l[r][2]));
            float e0 = __builtin_amdgcn_exp2f(l[r][0] - mx), e1 = __builtin_amdgcn_exp2f(l[r][1] - mx), e2 = __builtin_amdgcn_exp2f(l[r][2] - mx);
            const float inv = 1.0f / (e0 + e1 + e2); e0 *= inv; e1 *= inv; e2 *= inv;
            const v4u A = a[r][0], B = a[r][1], C = a[r][2]; v4u o;
            o.x = pk2(e0 * bf_lo(A.x) + e1 * bf_lo(B.x) + e2 * bf_lo(C.x), e0 * bf_hi(A.x) + e1 * bf_hi(B.x) + e2 * bf_hi(C.x));
            o.y = pk2(e0 * bf_lo(A.y) + e1 * bf_lo(B.y) + e2 * bf_lo(C.y), e0 * bf_hi(A.y) + e1 * bf_hi(B.y) + e2 * bf_hi(C.y));
            o.z = pk2(e0 * bf_lo(A.z) + e1 * bf_lo(B.z) + e2 * bf_lo(C.z), e0 * bf_hi(A.z) + e1 * bf_hi(B.z) + e2 * bf_hi(C.z));
            o.w = pk2(e0 * bf_lo(A.w) + e1 * bf_lo(B.w) + e2 * bf_lo(C.w), e0 * bf_hi(A.w) + e1 * bf_hi(B.w) + e2 * bf_hi(C.w));
            *(v4u*)(ATT + (size_t)(m0 + r) * 512 + hh * 128 + c0) = o; }
    }
}

#define XB_TMO      128
#define XB_XCNT(j)  (256  + 64 * (j))
#define XB_XSUB(j)  (1280 + 64 * (j))
#define XB_XGEN(j)  (2304 + 64 * (j))
#define XB_TOP      3328
#define XB_TOPGEN   3392
#define XCD_BAR_WORDS 3456
#define XB_SPIN_CAP (1u << 18)

__device__ __forceinline__ unsigned xb_ld(unsigned* p)              { return __hip_atomic_load(p, __ATOMIC_RELAXED, __HIP_MEMORY_SCOPE_AGENT); }
__device__ __forceinline__ unsigned xb_add(unsigned* p, unsigned v) { return __hip_atomic_fetch_add(p, v, __ATOMIC_RELAXED, __HIP_MEMORY_SCOPE_AGENT); }
__device__ __forceinline__ unsigned xb_xcc_id() { return (unsigned)__builtin_amdgcn_s_getreg((3 << 11) | 20) & 0xFu; }
#define XB_SPIN(cond, bar) do { unsigned _sp = 0; while (cond) { __builtin_amdgcn_s_sleep(1); \
    if ((++_sp & 255u) == 0u) { if (xb_ld(&(bar)[XB_TMO])) break; if (_sp > XB_SPIN_CAP) { atomicAdd(&(bar)[XB_TMO], 1u); break; } } } } while (0)

struct XcdBarrier {
    unsigned* bar; unsigned x;
    volatile LAS unsigned* st;
};

__device__ __forceinline__ XcdBarrier xcd_barrier_post(unsigned* bar, volatile LAS unsigned* st) {
    XcdBarrier b; b.bar = bar; b.x = xb_xcc_id(); b.st = st;
    if (threadIdx.x == 0) (void)xb_add(&bar[XB_XCNT(b.x)], 1u);
    return b;
}
__device__ __forceinline__ void xcd_barrier_complete(unsigned* bar, unsigned x, unsigned& nloc, unsigned& nx) {
    const unsigned G = gridDim.x * gridDim.y * gridDim.z;
    unsigned sum, cnt, mine, sp = 0u;
    for (;;) {
        sum = 0u; cnt = 0u; mine = 0u;
#pragma unroll
        for (unsigned j = 0; j < 16; ++j) { const unsigned c = xb_ld(&bar[XB_XCNT(j)]); sum += c; cnt += (c > 0u) ? 1u : 0u; mine = (j == x) ? c : mine; }
        if (sum == G) break;
        __builtin_amdgcn_s_sleep(1);
        if ((++sp & 255u) == 0u) { if (xb_ld(&bar[XB_TMO])) break; if (sp > XB_SPIN_CAP) { atomicAdd(&bar[XB_TMO], 1u); break; } }
    }
    nloc = mine > 0u ? mine : 1u; nx = cnt > 0u ? cnt : 1u;
}

__device__ __forceinline__ void xcd_barrier(const XcdBarrier& b) {
    asm volatile("s_waitcnt vmcnt(0)" ::: "memory");
    __syncthreads();
    if (threadIdx.x == 0) {
        unsigned* bar = b.bar;
        __builtin_amdgcn_s_waitcnt(0);
        unsigned nloc = b.st[0], nx = b.st[1];
        if (nloc == 0u) { xcd_barrier_complete(bar, b.x, nloc, nx); b.st[0] = nloc; b.st[1] = nx; }
        const unsigned old = xb_add(&bar[XB_XSUB(b.x)], 1u);
        const unsigned gen = old / nloc;
        if (old + 1u == (gen + 1u) * nloc) {
            __builtin_amdgcn_fence(__ATOMIC_RELEASE, "agent");
            asm volatile("s_waitcnt vmcnt(0)" ::: "memory");
            const unsigned og = xb_add(&bar[XB_TOP], 1u);
            const unsigned tg = og / nx;
            if (og + 1u == (tg + 1u) * nx) xb_add(&bar[XB_TOPGEN], 1u);
            else XB_SPIN(xb_ld(&bar[XB_TOPGEN]) == tg, bar);
            __builtin_amdgcn_fence(__ATOMIC_ACQUIRE, "agent");
            xb_add(&bar[XB_XGEN(b.x)], 1u);
            asm volatile("s_waitcnt vmcnt(0)" ::: "memory");
        } else {
            XB_SPIN(xb_ld(&bar[XB_XGEN(b.x)]) == gen, bar);
            __builtin_amdgcn_fence(__ATOMIC_ACQUIRE, "agent");
            asm volatile("s_waitcnt vmcnt(0)" ::: "memory");
        }
    }
    __syncthreads();
}

template <int NP> __device__ __forceinline__ void fill_rstab(LAS unsigned char* lds, const float* ssp, int N, int G, int bx, int tid) {
    LAS float* rstab = (LAS float*)(lds + 131072); LAS int* pmtab = (LAS int*)(lds + 131072 + 12288);
    pg8::StaticOrder S0; S0.init(M, N, G, bx); pg8::Unit u0; int nu = 0;
    for (; nu < 12 && S0.next(nu, u0); ++nu) if (tid == 0) pmtab[nu] = u0.pm;
    __syncthreads();
    float sv[6];
#pragma unroll
    for (int k = 0; k < 6; ++k) { const int ri = tid + 512 * k; sv[k] = 0.f;
        if (ri < nu * 256) { const float* p = ssp + (size_t)(pmtab[ri >> 8] * 256 + (ri & 255)) * NP;
            if (NP == 16) { const f32x4 a = *(const f32x4*)p, b = *(const f32x4*)(p + 4), c = *(const f32x4*)(p + 8), d = *(const f32x4*)(p + 12);
                sv[k] = (((a.x + a.y) + (a.z + a.w)) + ((b.x + b.y) + (b.z + b.w))) + (((c.x + c.y) + (c.z + c.w)) + ((d.x + d.y) + (d.z + d.w))); }
            else sv[k] = p[0]; } }
#pragma unroll
    for (int k = 0; k < 6; ++k) { const int ri = tid + 512 * k; if (ri < nu * 256) rstab[ri] = __builtin_amdgcn_rsqf(sv[k] * (1.0f / 1024.0f) + EPS); }
    __syncthreads();
}

struct Args { const float* in[19]; float* out; unsigned char* ws; int ph_lo, ph_hi; };
#ifndef MK_MULTI
#define MK_MULTI 0
#endif
#if MK_MULTI
#define GRID_SYNC() do { } while (0)
#else
#ifndef MK_CG
#define MK_CG 0
#endif
#if MK_CG
#define GRID_SYNC() do { __threadfence(); cg::this_grid().sync(); } while (0)
#else
#define GRID_SYNC() xcd_barrier(xbar)
#endif
#endif

__global__ void __launch_bounds__(NTHREADS, 2) fwd_kernel(Args args) {
    extern __shared__ __attribute__((aligned(16))) unsigned char lds_raw[];
    LAS unsigned char* lds = (LAS unsigned char*)lds_raw;
    const int tid = threadIdx.x, lane = tid & 63, wave = __builtin_amdgcn_readfirstlane(tid >> 6);
    const int G = gridDim.x, bx = blockIdx.x; const int vcu = (G % 8 == 0) ? (bx % 8) * (G / 8) + bx / 8 : bx;
    const int gw = vcu * NWAVES + wave, NGW = G * NWAVES;
    unsigned char* ws = args.ws;
#if !MK_MULTI && !MK_CG
    volatile LAS unsigned* xst = (volatile LAS unsigned*)(lds + LDS_BYTES - 128);
    if (tid < 2) xst[tid] = 0u;
    __syncthreads();
    XcdBarrier xbar = xcd_barrier_post((unsigned*)(ws + WS_CTL), xst);
#endif
    const float* x = args.in[0];
    float* X = args.out; bf16* XB = (bf16*)args.out;
#define Wgu1 ((bf16*)(ws + WS_WGU1))
#define Wd1 ((bf16*)(ws + WS_WD1))
#define Wgu2 ((bf16*)(ws + WS_WGU2))
#define Wd2 ((bf16*)(ws + WS_WD2))
#define Win ((bf16*)(ws + WS_WIN))
#define Wc ((bf16*)(ws + WS_WC))
#define Wa ((bf16*)(ws + WS_WA))
#define Wo ((bf16*)(ws + WS_WO))
#define H ((bf16*)(ws + WS_H))
#define ZC ((bf16*)(ws + WS_ZC))
#define Qb ((bf16*)(ws + WS_Q))
#define Kb ((bf16*)(ws + WS_K))
#define Vb ((bf16*)(ws + WS_V))
#define LSE ((float*)(ws + WS_LSE))
#define ATT ((bf16*)(ws + WS_ATT))
#define ZG ((bf16*)(ws + WS_ZG))
#define GT ((bf16*)(ws + WS_G))
#define T1 ((bf16*)(ws + WS_T1))
#define MIX ((bf16*)(ws + WS_MIX))
#define A1 ((bf16*)(ws + WS_A1))
#define SS1 ((float*)(ws + WS_SS))
#define SS2 ((float*)(ws + WS_SSP))
#define SS3 ((float*)(ws + WS_SSP) + (size_t)M * 16)
    const int lo = args.ph_lo, hi = args.ph_hi;
#define IN(k) (lo <= (k) && (k) < hi)
#define SEAM(k) do { if (IN(k) && IN((k) + 1)) GRID_SYNC(); } while (0)
#define GEMM_PHASE(EPI, Aptr, Bptr, Nn, Kk, ...) do { pg8::Gemm g_{Aptr, Bptr, M, Nn, Kk}; pg8::StaticOrder S_; S_.init(M, Nn, G, bx); EPI E_{__VA_ARGS__}; \
        pg8::gemm_phase<EPI, pg8::StaticOrder, true, true>(lds, g_, S_, E_); } while (0)
#define GEMM_PHASE_RS(SSp, NP, EPI, Aptr, Bptr, Nn, Kk, ...) do { fill_rstab<NP>(lds, SSp, Nn, G, bx, tid); GEMM_PHASE(EPI, Aptr, Bptr, Nn, Kk, __VA_ARGS__); } while (0)

    if (IN(0)) {
        LAS float* scr = (LAS float*)(lds + wave * 16384);
        constexpr int I_GU = 16 * 88, I_DN = 44 * 32, I_IN = 16 * 272, I_C = 16 * 32, I_A = 8 * 32;
        constexpr int NITEMS = 6 * I_GU + I_IN + 2 * I_C + I_A;
        static_assert(I_DN == I_GU, "items");
        for (int it = gw; it < NITEMS; it += NGW) {
            int r = it;
            if (r < I_GU) { transpose_item(args.in[2], D, FF, Wgu1, 1, scr, r, lane, args.in[1]); continue; } r -= I_GU;
            if (r < I_GU) { transpose_item(args.in[3], D, FF, Wgu1, 2, scr, r, lane, args.in[1]); continue; } r -= I_GU;
            if (r < I_GU) { transpose_item(args.in[4], FF, D, Wd1, 0, scr, r, lane); continue; } r -= I_GU;
            if (r < I_GU) { transpose_item(args.in[15], D, FF, Wgu2, 1, scr, r, lane, args.in[14]); continue; } r -= I_GU;
            if (r < I_GU) { transpose_item(args.in[16], D, FF, Wgu2, 2, scr, r, lane, args.in[14]); continue; } r -= I_GU;
            if (r < I_GU) { transpose_item(args.in[17], FF, D, Wd2, 0, scr, r, lane); continue; } r -= I_GU;
            if (r < I_IN) { transpose_item(args.in[6], D, NIN, Win, 3, scr, r, lane, args.in[5]); continue; } r -= I_IN;
            if (r < I_C) { transpose_item(args.in[11], D, D, Wc, 0, scr, r, lane); continue; } r -= I_C;
            if (r < I_A) { transpose_item(args.in[12], 512, D, Wa, 0, scr, r, lane); continue; } r -= I_A;
            transpose_item(args.in[13], D, D, Wo, 0, scr, r, lane);
        }
        raw_rows(x, H, SS1, gw, NGW, lane);
        __syncthreads();
    }
    SEAM(0);
    if (IN(1)) GEMM_PHASE_RS(SS1, 1, pg8::EpiPair<0>, H, Wgu1, 2 * FF, D, A1, FF);
    SEAM(1);
    if (IN(2)) GEMM_PHASE(pg8::EpiResid<false>, A1, Wd1, D, FF, x, XB, SS2, 0.5f);
    SEAM(2);
    if (IN(3)) GEMM_PHASE_RS(SS2, 16, pg8::EpiPair<1>, XB, Win, 2048, D, ZG, D);
    SEAM(3);
    if (IN(4)) conv_phase(ZG, args.in[7], args.in[8], args.in[9], args.in[10], ZC, (LAS float*)lds, vcu, G);
    SEAM(4);
    if (IN(5)) GEMM_PHASE_RS(SS2, 16, pg8::EpiQKV, XB, Win + (size_t)2048 * D, 3 * AW, D, Qb, (size_t)(WS_K - WS_Q) / 2, 0.08838834764831845f * 1.4426950408889634f);
    SEAM(5);
    if (IN(6)) attn_phase(lds, Qb, Kb, Vb, Qb, LSE, vcu, G);
    SEAM(6);
    if (IN(7)) { merge_rows(Qb, LSE, ATT, gw, NGW, lane); __syncthreads(); }
    if (IN(7)) GEMM_PHASE_RS(SS2, 16, pg8::EpiSig, XB, Win + (size_t)6656 * D, 2048, D, GT, 2048);
    SEAM(7);
    if (IN(8)) GEMM_PHASE(pg8::EpiGate<false>, ZC, Wc, D, D, nullptr, GT, 2048, T1);
    if (IN(9)) GEMM_PHASE(pg8::EpiGate<true>, ATT, Wa, D, 512, T1, GT + 1024, 2048, MIX);
    SEAM(9);
    if (IN(10)) GEMM_PHASE(pg8::EpiResid<true>, MIX, Wo, D, D, XB, XB, SS3, 1.0f);
    SEAM(10);
    if (IN(11)) GEMM_PHASE_RS(SS3, 16, pg8::EpiPair<0>, XB, Wgu2, 2 * FF, D, A1, FF);
    SEAM(11);
    if (IN(12)) GEMM_PHASE(pg8::EpiResid<true>, A1, Wd2, D, FF, XB, H, nullptr, 0.5f);
    SEAM(12);
    if (IN(13)) rms_rows_b(H, args.in[18], X, gw, NGW, lane);
#undef IN
#undef Wgu1
#undef Wd1
#undef Wgu2
#undef Wd2
#undef Win
#undef Wc
#undef Wa
#undef Wo
#undef H
#undef ZC
#undef Qb
#undef Kb
#undef Vb
#undef LSE
#undef ATT
#undef ZG
#undef GT
#undef T1
#undef MIX
#undef A1
#undef SS1
#undef SS2
#undef SS3
#undef SEAM
}
constexpr int NPHASES = 14;

extern "C" void kernel_launch(void* const* d_in, const int* in_sizes, int n_in, void* d_out, int out_size, void* d_ws, size_t ws_size, hipStream_t stream) {
    static int grid = 0;
    if (grid == 0) {
        if (n_in != 19 || out_size != M * D || ws_size < WS_END) { fprintf(stderr, "kernel_launch: unexpected shapes (n_in %d out %d ws %zu)\n", n_in, out_size, ws_size); grid = -1; return; }
        int dev = 0, cus = 0, per_cu = 0;
        hipGetDevice(&dev); hipDeviceGetAttribute(&cus, hipDeviceAttributeMultiprocessorCount, dev);
        if (hipFuncSetAttribute((const void*)fwd_kernel, hipFuncAttributeMaxDynamicSharedMemorySize, LDS_BYTES) != hipSuccess) { fprintf(stderr, "kernel_launch: hipFuncSetAttribute failed\n"); grid = -1; return; }
        if (hipOccupancyMaxActiveBlocksPerMultiprocessor(&per_cu, (const void*)fwd_kernel, NTHREADS, LDS_BYTES) != hipSuccess || per_cu < 1) { fprintf(stderr, "kernel_launch: occupancy query says %d\n", per_cu); per_cu = 1; }
        (void)hipGetLastError();
        if (per_cu > 1) per_cu = 1;
        grid = cus * per_cu;
    }
    if (grid < 0) return;
    Args a{};
    for (int i = 0; i < 19; ++i) a.in[i] = (const float*)d_in[i];
    a.out = (float*)d_out; a.ws = (unsigned char*)d_ws;
#if MK_MULTI
    for (int p = 0; p < NPHASES; ++p) { a.ph_lo = p; a.ph_hi = p + 1; hipLaunchKernelGGL(fwd_kernel, dim3(grid), dim3(NTHREADS), LDS_BYTES, stream, a); }
#else
    a.ph_lo = 0; a.ph_hi = NPHASES;
#if MK_CG
    void* kargs[] = {&a};
    hipError_t e = hipLaunchCooperativeKernel((const void*)fwd_kernel, dim3(grid), dim3(NTHREADS), kargs, LDS_BYTES, stream);
    if (e != hipSuccess) fprintf(stderr, "cooperative launch failed: %s (grid %d)\n", hipGetErrorString(e), grid);
#else
    if (hipMemsetAsync((char*)d_ws + WS_CTL, 0, 65536, stream) != hipSuccess) { fprintf(stderr, "kernel_launch: memset failed\n"); return; }
    hipLaunchKernelGGL(fwd_kernel, dim3(grid), dim3(NTHREADS), LDS_BYTES, stream, a);
#endif
#endif
}
```

```cpp
#include <hip/hip_runtime.h>
#include <cstdio>
#include <cstdint>
namespace pg8 {
#define PG8_LAS __attribute__((address_space(3)))
typedef unsigned short bf16_t;
typedef short bf16x8 __attribute__((ext_vector_type(8)));
typedef float f32x4 __attribute__((ext_vector_type(4)));
typedef unsigned u32x4 __attribute__((ext_vector_type(4)));
constexpr int BM = 256, BK = 64, HALF = 128, HTB = HALF * BK * 2  , STAGE_BYTES = 8 * HTB, NXCD = 8, WGM = 8;

__host__ __device__ __forceinline__ int lds_byte(int r, int c) { const int st = (r >> 4) * 2 + (c >> 5), rr = r & 15, cc = c & 31, ob = rr * 64 + cc * 2; return st * 1024 + (ob ^ (((ob >> 9) & 1) << 5)); }
__host__ __device__ __forceinline__ void stage_rc(int b, int& R, int& C) { const int st = b / 1024, sb = b % 1024, swz = sb ^ (((sb >> 9) & 1) << 5); R = (st >> 1) * 16 + swz / 64; C = (st & 1) * 32 + (swz % 64) / 2; }
__host__ __device__ __forceinline__ int perm32(int rho) { const int n = rho >> 4, i = rho & 15; return 8 * (i >> 2) + 4 * n + (i & 3); }

struct Unit { int pm, pn; };
struct Gemm { const bf16_t* A; const bf16_t* Bt; int M, N, K; };

struct StaticOrder {
    int nM, nN, nwg, G, c;
    __host__ __device__ void init(int M, int N, int G_, int c_) { nM = M / BM; nN = N / BM; nwg = nM * nN; G = G_; c = c_; }
    __host__ __device__ bool next(int i, Unit& u) const {
        const long L = (long)i * G + c; if (L >= nwg) return false;
        int wgid = (int)L; { const int q = nwg / NXCD, r = nwg % NXCD, xcd = wgid % NXCD, off = wgid / NXCD; wgid = (xcd < r ? xcd * (q + 1) : r * (q + 1) + (xcd - r) * q) + off; }
        const int nig = WGM * nN, gid = wgid / nig, fm = gid * WGM, gsz = (nM - fm) < WGM ? (nM - fm) : WGM;
        u.pm = fm + ((wgid % nig) % gsz); u.pn = (wgid % nig) / gsz; return true;
    }
    __device__ __forceinline__ void a_ready(const Unit&) const {}
    __device__ __forceinline__ void done(const Unit&) const {}
};

typedef float f32x2_t __attribute__((ext_vector_type(2))); typedef __bf16 bf16x2_t __attribute__((ext_vector_type(2)));
__device__ __forceinline__ unsigned cvt_pk_bf16(float lo, float hi) { const f32x2_t v = {lo, hi}; const bf16x2_t b = __builtin_convertvector(v, bf16x2_t); return __builtin_bit_cast(unsigned, b); }
typedef float f32x2 __attribute__((ext_vector_type(2)));
__device__ __forceinline__ float sigmoid_f(float x) { return __builtin_amdgcn_rcpf(1.0f + __builtin_amdgcn_exp2f(-1.4426950408889634f * x)); }
__device__ __forceinline__ float bf_lo(unsigned u) { return __uint_as_float(u << 16); }
__device__ __forceinline__ float bf_hi(unsigned u) { return __uint_as_float(u & 0xffff0000u); }

template <int ACT> struct EpiPair {
    static constexpr bool PERM = true, AFTER_DRAIN = false;
    bf16_t* O; int ldo;
    __device__ __forceinline__ void operator()(const f32x4 (&acc)[2][2][4][2], const Unit& u, int wr, int wc, int fr, int fq, int ui, PG8_LAS unsigned char* lds) const {
        const PG8_LAS float* rs = (const PG8_LAS float*)(lds + 131072);
        const int row0 = u.pm * BM + wr * 64 + fr, col0 = u.pn * HALF + wc * 32 + 8 * fq;
#pragma unroll
        for (int ai = 0; ai < 2; ++ai)
#pragma unroll
            for (int m = 0; m < 4; ++m) { const float rsv = rs[ui * 256 + ai * HALF + wr * 64 + m * 16 + fr];
                float v[8];
#pragma unroll
                for (int n = 0; n < 2; ++n)
#pragma unroll
                    for (int i = 0; i < 4; ++i) { const float a = acc[ai][0][m][n][i] * rsv, b = acc[ai][1][m][n][i] * rsv;
                        v[n * 4 + i] = (ACT == 0) ? a * sigmoid_f(a) * b : a * sigmoid_f(b); }
                u32x4 w; w.x = cvt_pk_bf16(v[0], v[1]); w.y = cvt_pk_bf16(v[2], v[3]); w.z = cvt_pk_bf16(v[4], v[5]); w.w = cvt_pk_bf16(v[6], v[7]);
                *(u32x4*)(O + (size_t)(row0 + ai * HALF + m * 16) * ldo + col0) = w; }
    }
};
template <bool BASE_BF16> struct EpiResid {
    static constexpr bool PERM = true, AFTER_DRAIN = false;
    const void* base; bf16_t* outb; float* ss; float alpha;
    __device__ __forceinline__ void operator()(const f32x4 (&acc)[2][2][4][2], const Unit& u, int wr, int wc, int fr, int fq, int, PG8_LAS unsigned char*) const {
        const int row0 = u.pm * BM + wr * 64 + fr, col0 = u.pn * BM + wc * 32 + 8 * fq;
#pragma unroll
        for (int ai = 0; ai < 2; ++ai)
#pragma unroll
            for (int m = 0; m < 4; ++m) { const size_t off = (size_t)(row0 + ai * HALF + m * 16) * 1024 + col0; float sq = 0.f;
#pragma unroll
                for (int bj = 0; bj < 2; ++bj) { f32x4 b0, b1;
                    if (BASE_BF16) { const u32x4 r = *(const u32x4*)((const bf16_t*)base + off + bj * HALF);
                        b0 = (f32x4){bf_lo(r.x), bf_hi(r.x), bf_lo(r.y), bf_hi(r.y)}; b1 = (f32x4){bf_lo(r.z), bf_hi(r.z), bf_lo(r.w), bf_hi(r.w)}; }
                    else { b0 = *(const f32x4*)((const float*)base + off + bj * HALF); b1 = *(const f32x4*)((const float*)base + off + bj * HALF + 4); }
                    const f32x4 v0 = b0 + acc[ai][bj][m][0] * alpha, v1 = b1 + acc[ai][bj][m][1] * alpha;
                    u32x4 w; w.x = cvt_pk_bf16(v0[0], v0[1]); w.y = cvt_pk_bf16(v0[2], v0[3]); w.z = cvt_pk_bf16(v1[0], v1[1]); w.w = cvt_pk_bf16(v1[2], v1[3]);
                    *(u32x4*)(outb + off + bj * HALF) = w;
                    { const float r0 = bf_lo(w.x), r1 = bf_hi(w.x), r2 = bf_lo(w.y), r3 = bf_hi(w.y), r4 = bf_lo(w.z), r5 = bf_hi(w.z), r6 = bf_lo(w.w), r7 = bf_hi(w.w);
                      sq += ((r0 * r0 + r1 * r1) + (r2 * r2 + r3 * r3)) + ((r4 * r4 + r5 * r5) + (r6 * r6 + r7 * r7)); } }
                if (ss) { sq += __shfl_xor(sq, 16); sq += __shfl_xor(sq, 32); if (fq == 0) ss[(size_t)(row0 + ai * HALF + m * 16) * 16 + u.pn * 4 + wc] = sq; } }
    }
};
struct EpiQKV {
    static constexpr bool PERM = true, AFTER_DRAIN = false;
    bf16_t* O; size_t tstride; float qscale;
    __device__ __forceinline__ void operator()(const f32x4 (&acc)[2][2][4][2], const Unit& u, int wr, int wc, int fr, int fq, int ui, PG8_LAS unsigned char* lds) const {
        const PG8_LAS float* rs = (const PG8_LAS float*)(lds + 131072);
        const int row0 = u.pm * BM + wr * 64 + fr; const int t = u.pn / 6, ct = u.pn - 6 * t, dsh = 2 * (ct >> 1);
        bf16_t* base = O + (size_t)t * tstride + wc * 32 + 8 * fq; const float sc0 = (t == 0) ? qscale : 1.0f;
#pragma unroll
        for (int ai = 0; ai < 2; ++ai)
#pragma unroll
            for (int m = 0; m < 4; ++m) { const int row = row0 + ai * HALF + m * 16, b = row >> 12, s = row & 4095;
                const int pos = ((s & ((1 << dsh) - 1)) << (12 - dsh)) + (s >> dsh);
                const float sc = sc0 * rs[ui * 256 + ai * HALF + wr * 64 + m * 16 + fr];
#pragma unroll
                for (int bj = 0; bj < 2; ++bj) { const f32x4 v0 = acc[ai][bj][m][0] * sc, v1 = acc[ai][bj][m][1] * sc;
                    u32x4 w; w.x = cvt_pk_bf16(v0[0], v0[1]); w.y = cvt_pk_bf16(v0[2], v0[3]); w.z = cvt_pk_bf16(v1[0], v1[1]); w.w = cvt_pk_bf16(v1[2], v1[3]);
                    *(u32x4*)(base + ((size_t)((b * 12 + 2 * ct + bj) * 4096 + pos)) * 128) = w; } }
    }
};
struct EpiSig {
    static constexpr bool PERM = true, AFTER_DRAIN = false;
    bf16_t* O; int ldo;
    __device__ __forceinline__ void operator()(const f32x4 (&acc)[2][2][4][2], const Unit& u, int wr, int wc, int fr, int fq, int ui, PG8_LAS unsigned char* lds) const {
        const PG8_LAS float* rs = (const PG8_LAS float*)(lds + 131072);
        const int row0 = u.pm * BM + wr * 64 + fr, col0 = u.pn * BM + wc * 32 + 8 * fq;
#pragma unroll
        for (int ai = 0; ai < 2; ++ai)
#pragma unroll
            for (int m = 0; m < 4; ++m) { bf16_t* rowp = O + (size_t)(row0 + ai * HALF + m * 16) * ldo + col0; const float rsv = rs[ui * 256 + ai * HALF + wr * 64 + m * 16 + fr];
#pragma unroll
                for (int bj = 0; bj < 2; ++bj) { float v[8];
#pragma unroll
                    for (int n = 0; n < 2; ++n)
#pragma unroll
                        for (int i = 0; i < 4; ++i) v[n * 4 + i] = sigmoid_f(acc[ai][bj][m][n][i] * rsv);
                    u32x4 w; w.x = cvt_pk_bf16(v[0], v[1]); w.y = cvt_pk_bf16(v[2], v[3]); w.z = cvt_pk_bf16(v[4], v[5]); w.w = cvt_pk_bf16(v[6], v[7]);
                    *(u32x4*)(rowp + bj * HALF) = w; } }
    }
};
template <bool HAS_BASE> struct EpiGate {
    static constexpr bool PERM = true, AFTER_DRAIN = false;
    const bf16_t* base; const bf16_t* gate; int ldg; bf16_t* O;
    __device__ __forceinline__ void operator()(const f32x4 (&acc)[2][2][4][2], const Unit& u, int wr, int wc, int fr, int fq, int, PG8_LAS unsigned char*) const {
        const int row0 = u.pm * BM + wr * 64 + fr, col0 = u.pn * BM + wc * 32 + 8 * fq;
#pragma unroll
        for (int ai = 0; ai < 2; ++ai)
#pragma unroll
            for (int m = 0; m < 4; ++m) { const size_t r = (size_t)(row0 + ai * HALF + m * 16);
#pragma unroll
                for (int bj = 0; bj < 2; ++bj) {
                    const u32x4 gv = *(const u32x4*)(gate + r * ldg + col0 + bj * HALF);
                    u32x4 bv = (u32x4){0u, 0u, 0u, 0u}; if (HAS_BASE) bv = *(const u32x4*)(base + r * 1024 + col0 + bj * HALF);
                    const f32x4 a0 = acc[ai][bj][m][0], a1 = acc[ai][bj][m][1];
                    float v[8];
                    v[0] = bf_lo(bv.x) + bf_lo(gv.x) * a0[0]; v[1] = bf_hi(bv.x) + bf_hi(gv.x) * a0[1];
                    v[2] = bf_lo(bv.y) + bf_lo(gv.y) * a0[2]; v[3] = bf_hi(bv.y) + bf_hi(gv.y) * a0[3];
                    v[4] = bf_lo(bv.z) + bf_lo(gv.z) * a1[0]; v[5] = bf_hi(bv.z) + bf_hi(gv.z) * a1[1];
                    v[6] = bf_lo(bv.w) + bf_lo(gv.w) * a1[2]; v[7] = bf_hi(bv.w) + bf_hi(gv.w) * a1[3];
                    u32x4 w; w.x = cvt_pk_bf16(v[0], v[1]); w.y = cvt_pk_bf16(v[2], v[3]); w.z = cvt_pk_bf16(v[4], v[5]); w.w = cvt_pk_bf16(v[6], v[7]);
                    *(u32x4*)(O + r * 1024 + col0 + bj * HALF) = w; } }
    }
};

template <class Epi, class Sched, bool ALIGN_EPI = false, bool SP2 = false>
__device__ __forceinline__ void gemm_phase(PG8_LAS unsigned char* lds, const Gemm g, const Sched& S, const Epi& E) {
    const int tid = threadIdx.x, wid = __builtin_amdgcn_readfirstlane(tid >> 6), lane = tid & 63, wr = wid >> 2, wc = wid & 3, fr = lane & 15, fq = lane >> 4;
    const int K = g.K, nt = K / BK;
    unsigned voffA[2], voffB[2];
#pragma unroll
    for (int i = 0; i < 2; ++i) { int R, C; stage_rc(tid * 16 + i * 8192, R, C); const int Rb = Epi::PERM ? ((R & ~31) + perm32(R & 31)) : R;
        voffA[i] = (unsigned)(R * K + C) * 2u; voffB[i] = (unsigned)(Rb * K + C) * 2u; }
    const size_t kstep = (size_t)(BK * 2);
    const size_t hstep = (size_t)HALF * K * 2;
    const size_t tstep = 2 * hstep;
    const unsigned ldsw = (unsigned)wid * 1024u;
    const int aoff = lds_byte(wr * 64 + fr, fq * 8), boff = lds_byte(wc * 32 + fr, fq * 8);
#define PG8_SA(b, h) (((b) * 2 + (h)) * HTB)
#define PG8_SB(b, h) ((4 + (b) * 2 + (h)) * HTB)
#define PG8_STAGE(bufoff, gbase, voff) do { _Pragma("unroll") for (int _i = 0; _i < 2; ++_i) \
        __builtin_amdgcn_global_load_lds((const unsigned*)((const char*)(gbase) + (voff)[_i]), (PG8_LAS unsigned*)(lds + (bufoff) + ldsw + _i * 8192), 16, 0, 0); } while (0)
#define PG8_LDA(dst, b, h) do { _Pragma("unroll") for (int m = 0; m < 4; ++m) _Pragma("unroll") for (int k = 0; k < 2; ++k) dst[m][k] = *(const PG8_LAS bf16x8*)(lds + PG8_SA(b, h) + aoff + m * 2048 + k * 1024); } while (0)
#define PG8_LDB(dst, b, h) do { _Pragma("unroll") for (int n = 0; n < 2; ++n) _Pragma("unroll") for (int k = 0; k < 2; ++k) dst[n][k] = *(const PG8_LAS bf16x8*)(lds + PG8_SB(b, h) + boff + n * 2048 + k * 1024); } while (0)
#define PG8_MMA(ai, bj, At, Bt) do { __builtin_amdgcn_s_setprio(1); _Pragma("unroll") for (int m = 0; m < 4; ++m) _Pragma("unroll") for (int n = 0; n < 2; ++n) _Pragma("unroll") for (int k = 0; k < 2; ++k) \
        acc[ai][bj][m][n] = __builtin_amdgcn_mfma_f32_16x16x32_bf16(Bt[n][k], At[m][k], acc[ai][bj][m][n], 0, 0, 0); __builtin_amdgcn_s_setprio(0); } while (0)
#define PG8_WAIT_V(n) asm volatile("s_waitcnt vmcnt(" #n ")" ::: "memory")
#define PG8_WAIT_L(n) asm volatile("s_waitcnt lgkmcnt(" #n ")" ::: "memory")
#define PG8_BAR __builtin_amdgcn_s_barrier()
#define PG8_SCHED __builtin_amdgcn_sched_barrier(0)
    Unit cur, nxt; int ui = 0;
    if (!S.next(0, cur)) return;
    f32x4 acc[2][2][4][2];
#pragma unroll
    for (int a = 0; a < 2; ++a)
#pragma unroll
        for (int b = 0; b < 2; ++b)
#pragma unroll
            for (int m = 0; m < 4; ++m)
#pragma unroll
                for (int n = 0; n < 2; ++n) acc[a][b][m][n] = (f32x4){0.f, 0.f, 0.f, 0.f};
    bf16x8 At[4][2], B0[2][2], B1[2][2];
    const char* cA = (const char*)g.A + (size_t)cur.pm * tstep; const char* cB = (const char*)g.Bt + (size_t)cur.pn * tstep;
    S.a_ready(cur);
    if constexpr (SP2) {
        PG8_STAGE(PG8_SB(0, 0), cB, voffB); PG8_STAGE(PG8_SB(0, 1), cB + hstep, voffB); PG8_STAGE(PG8_SA(0, 0), cA, voffA); PG8_STAGE(PG8_SA(0, 1), cA + hstep, voffA);
        if (wr == 1) PG8_BAR;
        PG8_WAIT_V(2); PG8_BAR;
        PG8_STAGE(PG8_SB(1, 0), cB + kstep, voffB); PG8_STAGE(PG8_SA(1, 0), cA + kstep, voffA); PG8_STAGE(PG8_SB(1, 1), cB + hstep + kstep, voffB);
        PG8_WAIT_V(6); PG8_BAR;
    } else {
        PG8_STAGE(PG8_SB(0, 0), cB, voffB); PG8_STAGE(PG8_SA(0, 0), cA, voffA); PG8_STAGE(PG8_SB(0, 1), cB + hstep, voffB); PG8_STAGE(PG8_SA(0, 1), cA + hstep, voffA);
        if (wr == 1) PG8_BAR;
        PG8_WAIT_V(4); PG8_BAR;
        PG8_STAGE(PG8_SB(1, 0), cB + kstep, voffB); PG8_STAGE(PG8_SA(1, 0), cA + kstep, voffA); PG8_STAGE(PG8_SB(1, 1), cB + hstep + kstep, voffB);
        PG8_WAIT_V(6); PG8_BAR;
    }
    for (;;) {
        const bool has_next = S.next(ui + 1, nxt);
        const char* nA = has_next ? (const char*)g.A + (size_t)nxt.pm * tstep : cA; const char* nB = has_next ? (const char*)g.Bt + (size_t)nxt.pn * tstep : cB;
        for (int t = 0; t < nt; t += 2) {
            const bool last = (t == nt - 2);
            const char* a1 = cA + (size_t)(t + 1) * kstep;
            const char* a2 = last ? nA : cA + (size_t)(t + 2) * kstep; const char* b2 = last ? nB : cB + (size_t)(t + 2) * kstep;
            const char* a3 = a2 + kstep; const char* b3 = b2 + kstep;
            if (last && has_next) S.a_ready(nxt);
            if constexpr (SP2) {
            PG8_LDB(B0, 0, 0); PG8_LDB(B1, 0, 1); PG8_SCHED; PG8_LDA(At, 0, 0); PG8_STAGE(PG8_SA(1, 1), a1 + hstep, voffA);
            PG8_WAIT_V(8); PG8_WAIT_L(0); PG8_BAR; PG8_MMA(0, 0, At, B0); PG8_MMA(0, 1, At, B1); PG8_BAR; PG8_SCHED;
            PG8_LDA(At, 0, 1); PG8_STAGE(PG8_SB(0, 0), b2, voffB); PG8_STAGE(PG8_SB(0, 1), b2 + hstep, voffB); PG8_STAGE(PG8_SA(0, 0), a2, voffA);
            PG8_WAIT_V(8); PG8_WAIT_L(0); PG8_BAR; PG8_MMA(1, 0, At, B0); PG8_MMA(1, 1, At, B1); PG8_BAR; PG8_SCHED;
            PG8_LDB(B0, 1, 0); PG8_LDB(B1, 1, 1); PG8_SCHED; PG8_LDA(At, 1, 0); PG8_STAGE(PG8_SA(0, 1), a2 + hstep, voffA);
            PG8_WAIT_V(8); PG8_WAIT_L(0); PG8_BAR; PG8_MMA(0, 0, At, B0); PG8_MMA(0, 1, At, B1); PG8_BAR; PG8_SCHED;
            PG8_LDA(At, 1, 1); PG8_STAGE(PG8_SB(1, 0), b3, voffB); PG8_STAGE(PG8_SB(1, 1), b3 + hstep, voffB); PG8_STAGE(PG8_SA(1, 0), a3, voffA);
            PG8_WAIT_V(8); PG8_WAIT_L(0); PG8_BAR; PG8_MMA(1, 0, At, B0); PG8_MMA(1, 1, At, B1); PG8_BAR; PG8_SCHED;
            } else {
            PG8_LDB(B0, 0, 0); PG8_SCHED; PG8_LDA(At, 0, 0); PG8_STAGE(PG8_SA(1, 1), a1 + hstep, voffA);
            PG8_WAIT_L(8); PG8_BAR; PG8_WAIT_L(0); PG8_MMA(0, 0, At, B0); PG8_BAR; PG8_SCHED;
            PG8_LDB(B1, 0, 1); PG8_STAGE(PG8_SB(0, 0), b2, voffB);
            PG8_BAR; PG8_WAIT_L(0); PG8_MMA(0, 1, At, B1); PG8_BAR;
            PG8_LDA(At, 0, 1); PG8_STAGE(PG8_SA(0, 0), a2, voffA);
            PG8_BAR; PG8_WAIT_L(0); PG8_MMA(1, 0, At, B0); PG8_BAR; PG8_SCHED;
            PG8_STAGE(PG8_SB(0, 1), b2 + hstep, voffB);
            PG8_WAIT_V(6); PG8_BAR; PG8_MMA(1, 1, At, B1); PG8_BAR;
            PG8_LDB(B0, 1, 0); PG8_SCHED; PG8_LDA(At, 1, 0); PG8_STAGE(PG8_SA(0, 1), a2 + hstep, voffA);
            PG8_WAIT_L(8); PG8_BAR; PG8_WAIT_L(0); PG8_MMA(0, 0, At, B0); PG8_BAR; PG8_SCHED;
            PG8_LDB(B1, 1, 1); PG8_STAGE(PG8_SB(1, 0), b3, voffB);
            PG8_BAR; PG8_WAIT_L(0); PG8_MMA(0, 1, At, B1); PG8_BAR;
            PG8_LDA(At, 1, 1); PG8_STAGE(PG8_SA(1, 0), a3, voffA);
            PG8_BAR; PG8_WAIT_L(0); PG8_MMA(1, 0, At, B0); PG8_BAR; PG8_SCHED;
            PG8_STAGE(PG8_SB(1, 1), b3 + hstep, voffB);
            PG8_WAIT_V(6); PG8_BAR; PG8_MMA(1, 1, At, B1); PG8_BAR;
            }
        }
        if constexpr (ALIGN_EPI) { if (wr == 0) PG8_BAR; }
        if constexpr (!Epi::AFTER_DRAIN) { E(acc, cur, wr, wc, fr, fq, ui, lds); S.done(cur); }
        if (!has_next) break;
#pragma unroll
        for (int a = 0; a < 2; ++a)
#pragma unroll
            for (int b = 0; b < 2; ++b)
#pragma unroll
                for (int m = 0; m < 4; ++m)
#pragma unroll
                    for (int n = 0; n < 2; ++n) acc[a][b][m][n] = (f32x4){0.f, 0.f, 0.f, 0.f};
        cur = nxt; cA = nA; cB = nB; ++ui;
        if constexpr (ALIGN_EPI) { if (wr == 1) PG8_BAR; }
    }
    PG8_WAIT_V(0);
    if constexpr (!ALIGN_EPI) { if (wr == 0) PG8_BAR; }
    PG8_BAR;
    if constexpr (Epi::AFTER_DRAIN) { E.fused(acc, cur, wr, wc, fr, fq, lds, wid, lane); S.done(cur); }
#undef PG8_SA
#undef PG8_SB
#undef PG8_STAGE
#undef PG8_LDA
#undef PG8_LDB
#undef PG8_MMA
#undef PG8_WAIT_V
#undef PG8_WAIT_L
#undef PG8_BAR
#undef PG8_SCHED
}
}

#include <hip/hip_cooperative_groups.h>
namespace cg = cooperative_groups;
using pg8::sigmoid_f; using pg8::bf_lo; using pg8::bf_hi;
#define LAS __attribute__((address_space(3)))
typedef unsigned short bf16;
typedef unsigned v4u __attribute__((ext_vector_type(4)));
typedef unsigned v2u __attribute__((ext_vector_type(2)));
typedef float f32x4 __attribute__((ext_vector_type(4)));
typedef float f32x2 __attribute__((ext_vector_type(2)));
typedef short bf16x8 __attribute__((ext_vector_type(8)));
typedef short v4i16_t __attribute__((ext_vector_type(4)));

constexpr int NWAVES = 8, NTHREADS = 512;
constexpr int SEQ = 4096, BATCH = 8, M = BATCH * SEQ, D = 1024, FF = 2816, NIN = 8704, AW = 1536, CW = 31;
constexpr float EPS = 1e-6f;
constexpr size_t MiB = 1u << 20;
constexpr size_t WS_CTL = 0;
constexpr size_t WS_SS = 256 * 1024;
constexpr size_t WS_WGU1 = 1 * MiB, WS_WD1 = 12 * MiB, WS_WGU2 = 18 * MiB, WS_WD2 = 29 * MiB, WS_WIN = 35 * MiB, WS_WC = 52 * MiB, WS_WA = 54 * MiB, WS_WO = 55 * MiB;
constexpr size_t WS_H = 58 * MiB;
constexpr size_t WS_ZC = 122 * MiB;
constexpr size_t WS_Q = 186 * MiB;
constexpr size_t WS_K = 282 * MiB;
constexpr size_t WS_V = 378 * MiB;
constexpr size_t WS_LSE = 474 * MiB;
constexpr size_t WS_ATT = 476 * MiB;
constexpr size_t WS_ZG = WS_K;
constexpr size_t WS_G = WS_K;
constexpr size_t WS_T1 = WS_K + 128 * MiB;
constexpr size_t WS_MIX = WS_H;
constexpr size_t WS_A1 = WS_Q;
constexpr size_t WS_SSP = 508 * MiB;
constexpr size_t WS_END = 512 * MiB;
static_assert(WS_T1 + 64 * MiB <= WS_LSE && WS_A1 + (size_t)M * FF * 2 <= WS_LSE, "ws map");

constexpr int LDS_BYTES = 147456;

__device__ __forceinline__ float wave_sum(float v) {
#pragma unroll
    for (int o = 1; o < 64; o <<= 1) v += __shfl_xor(v, o);
    return v;
}
__device__ __forceinline__ unsigned pk2(float lo, float hi) { return pg8::cvt_pk_bf16(lo, hi); }

__device__ __forceinline__ int dst_row(int map, int n) {
    if (map == 3) { if (n < 1024) map = 1; else if (n < 2048) { map = 2; n -= 1024; } else map = 0; }
    if (map == 0) return n;
    return 256 * (n >> 7) + (n & 127) + (map == 2 ? 128 : 0);
}
__device__ __forceinline__ void transpose_item(const float* W, int K, int N, bf16* WT, int map, LAS float* scr, int item, int lane, const float* gain = nullptr) {
    const int nblk = N / 32, kb = item / nblk, nb = item % nblk, k0 = 64 * kb, n0 = 32 * nb;
    float wv[32];
#pragma unroll
    for (int i = 0; i < 32; ++i) wv[i] = W[(size_t)(k0 + 2 * i + (lane >> 5)) * N + n0 + (lane & 31)];
#pragma unroll
    for (int i = 0; i < 32; ++i) scr[(2 * i + (lane >> 5)) * 33 + (lane & 31)] = wv[i] * (gain ? gain[k0 + 2 * i + (lane >> 5)] : 1.0f);
    asm volatile("s_waitcnt lgkmcnt(0)" ::: "memory");
    const int c = lane & 7; const int r0 = dst_row(map, n0);
#pragma unroll
    for (int j = 0; j < 4; ++j) { const int n = (lane >> 3) + 8 * j; const LAS float* s = scr + (8 * c) * 33 + n;
        v4u o; o.x = pk2(s[0 * 33], s[1 * 33]); o.y = pk2(s[2 * 33], s[3 * 33]); o.z = pk2(s[4 * 33], s[5 * 33]); o.w = pk2(s[6 * 33], s[7 * 33]);
        *(v4u*)(WT + (size_t)(r0 + n) * K + k0 + 8 * c) = o; }
    asm volatile("s_waitcnt lgkmcnt(0)" ::: "memory");
}

template <bool OUT_BF16> __device__ __forceinline__ void rms_rows(const float* X, const float* gain, void* out, int gw, int NGW, int lane) {
    f32x4 gv[4];
#pragma unroll
    for (int j = 0; j < 4; ++j) gv[j] = ((const f32x4*)gain)[lane + 64 * j];
    for (int m0 = gw * 4; m0 < M; m0 += NGW * 4) {
        f32x4 v[4][4]; float s[4];
#pragma unroll
        for (int r = 0; r < 4; ++r) { const f32x4* xr = (const f32x4*)(X + (size_t)(m0 + r) * D) + lane;
#pragma unroll
            for (int j = 0; j < 4; ++j) v[r][j] = xr[64 * j]; }
#pragma unroll
        for (int r = 0; r < 4; ++r) { float a = 0.f;
#pragma unroll
            for (int j = 0; j < 4; ++j) a += (v[r][j].x * v[r][j].x + v[r][j].y * v[r][j].y) + (v[r][j].z * v[r][j].z + v[r][j].w * v[r][j].w);
            s[r] = a; }
#pragma unroll
        for (int o = 1; o < 64; o <<= 1) {
#pragma unroll
            for (int r = 0; r < 4; ++r) s[r] += __shfl_xor(s[r], o); }
#pragma unroll
        for (int r = 0; r < 4; ++r) { const float rstd = 1.0f / sqrtf(s[r] * (1.0f / D) + EPS);
            if (OUT_BF16) { v2u* o8 = (v2u*)((bf16*)out + (size_t)(m0 + r) * D) + lane;
#pragma unroll
                for (int j = 0; j < 4; ++j) { v2u w; w.x = pk2(v[r][j].x * rstd * gv[j].x, v[r][j].y * rstd * gv[j].y); w.y = pk2(v[r][j].z * rstd * gv[j].z, v[r][j].w * rstd * gv[j].w); o8[64 * j] = w; }
            } else { f32x4* o = (f32x4*)((float*)out + (size_t)(m0 + r) * D) + lane;
#pragma unroll
                for (int j = 0; j < 4; ++j) o[64 * j] = v[r][j] * rstd * gv[j]; } }
    }
}

__device__ __forceinline__ void rms_rows_bb(const bf16* Xb, const float* gain, bf16* out, int gw, int NGW, int lane) {
    f32x4 gv[4];
#pragma unroll
    for (int j = 0; j < 4; ++j) gv[j] = ((const f32x4*)gain)[lane + 64 * j];
    for (int m0 = gw * 4; m0 < M; m0 += NGW * 4) {
        v2u raw[4][4]; f32x4 v[4][4]; float s[4];
#pragma unroll
        for (int r = 0; r < 4; ++r) { const v2u* xr = (const v2u*)(Xb + (size_t)(m0 + r) * D) + lane;
#pragma unroll
            for (int j = 0; j < 4; ++j) raw[r][j] = xr[64 * j]; }
#pragma unroll
        for (int r = 0; r < 4; ++r) { float a = 0.f;
#pragma unroll
            for (int j = 0; j < 4; ++j) { v[r][j] = (f32x4){bf_lo(raw[r][j].x), bf_hi(raw[r][j].x), bf_lo(raw[r][j].y), bf_hi(raw[r][j].y)};
                a += (v[r][j].x * v[r][j].x + v[r][j].y * v[r][j].y) + (v[r][j].z * v[r][j].z + v[r][j].w * v[r][j].w); }
            s[r] = a; }
#pragma unroll
        for (int o = 1; o < 64; o <<= 1) {
#pragma unroll
            for (int r = 0; r < 4; ++r) s[r] += __shfl_xor(s[r], o); }
#pragma unroll
        for (int r = 0; r < 4; ++r) { const float rstd = 1.0f / sqrtf(s[r] * (1.0f / D) + EPS); v2u* o8 = (v2u*)(out + (size_t)(m0 + r) * D) + lane;
#pragma unroll
            for (int j = 0; j < 4; ++j) { v2u w; w.x = pk2(v[r][j].x * rstd * gv[j].x, v[r][j].y * rstd * gv[j].y); w.y = pk2(v[r][j].z * rstd * gv[j].z, v[r][j].w * rstd * gv[j].w); o8[64 * j] = w; } }
    }
}

__device__ __forceinline__ void rms_rows_b(const bf16* Xb, const float* gain, float* out, int gw, int NGW, int lane) {
    f32x4 gv[4];
#pragma unroll
    for (int j = 0; j < 4; ++j) gv[j] = ((const f32x4*)gain)[lane + 64 * j];
    for (int m0 = gw * 4; m0 < M; m0 += NGW * 4) {
        v2u raw[4][4]; f32x4 v[4][4]; float s[4];
#pragma unroll
        for (int r = 0; r < 4; ++r) { const v2u* xr = (const v2u*)(Xb + (size_t)(m0 + r) * D) + lane;
#pragma unroll
            for (int j = 0; j < 4; ++j) raw[r][j] = xr[64 * j]; }
#pragma unroll
        for (int r = 0; r < 4; ++r) { float a = 0.f;
#pragma unroll
            for (int j = 0; j < 4; ++j) { v[r][j] = (f32x4){bf_lo(raw[r][j].x), bf_hi(raw[r][j].x), bf_lo(raw[r][j].y), bf_hi(raw[r][j].y)};
                a += (v[r][j].x * v[r][j].x + v[r][j].y * v[r][j].y) + (v[r][j].z * v[r][j].z + v[r][j].w * v[r][j].w); }
            s[r] = a; }
#pragma unroll
        for (int o = 1; o < 64; o <<= 1) {
#pragma unroll
            for (int r = 0; r < 4; ++r) s[r] += __shfl_xor(s[r], o); }
#pragma unroll
        for (int r = 0; r < 4; ++r) { const float rstd = 1.0f / sqrtf(s[r] * (1.0f / D) + EPS); f32x4* o = (f32x4*)(out + (size_t)(m0 + r) * D) + lane;
#pragma unroll
            for (int j = 0; j < 4; ++j) o[64 * j] = v[r][j] * rstd * gv[j]; }
    }
}

__device__ __forceinline__ void raw_rows(const float* X, bf16* out, float* ss, int gw, int NGW, int lane) {
    for (int m0 = gw * 4; m0 < M; m0 += NGW * 4) {
        f32x4 v[4][4]; float s[4];
#pragma unroll
        for (int r = 0; r < 4; ++r) { const f32x4* xr = (const f32x4*)(X + (size_t)(m0 + r) * D) + lane;
#pragma unroll
            for (int j = 0; j < 4; ++j) v[r][j] = xr[64 * j]; }
#pragma unroll
        for (int r = 0; r < 4; ++r) { float a = 0.f;
#pragma unroll
            for (int j = 0; j < 4; ++j) a += (v[r][j].x * v[r][j].x + v[r][j].y * v[r][j].y) + (v[r][j].z * v[r][j].z + v[r][j].w * v[r][j].w);
            s[r] = a; }
#pragma unroll
        for (int o = 1; o < 64; o <<= 1) {
#pragma unroll
            for (int r = 0; r < 4; ++r) s[r] += __shfl_xor(s[r], o); }
#pragma unroll
        for (int r = 0; r < 4; ++r) { if (lane == 0) ss[m0 + r] = s[r];
            v2u* o8 = (v2u*)(out + (size_t)(m0 + r) * D) + lane;
#pragma unroll
            for (int j = 0; j < 4; ++j) { v2u w; w.x = pk2(v[r][j].x, v[r][j].y); w.y = pk2(v[r][j].z, v[r][j].w); o8[64 * j] = w; } }
    }
}

constexpr int CT = 16;
__device__ __forceinline__ void conv_phase(const bf16* Zg, const float* dwk, const float* dwb, const float* lng, const float* lnb, bf16* ZC, LAS float* red, int vcu, int G) {
    const int tid = threadIdx.x, lane = tid & 63, wave = tid >> 6, c = 2 * tid;
    float w0[CW], w1[CW];
#pragma unroll
    for (int j = 0; j < CW; ++j) { const f32x2 t = *(const f32x2*)(dwk + j * D + c); w0[j] = t.x; w1[j] = t.y; }
    const f32x2 bb = *(const f32x2*)(dwb + c), gg = *(const f32x2*)(lng + c), lb = *(const f32x2*)(lnb + c);
    constexpr int NT = M / CT; const int tpb = (NT + G - 1) / G; const int tb = vcu * tpb; int te = tb + tpb; if (te > NT) te = NT;
    if (tb >= te) return;
    float z0[CT + CW - 1], z1[CT + CW - 1]; unsigned nx[CT];
    { const int t0 = tb * CT, s0 = t0 & (SEQ - 1);
#pragma unroll
        for (int i = 0; i < CT + CW - 1; ++i) { const bool valid = (s0 + i - (CW - 1)) >= 0; unsigned pk = 0u;
            if (valid) pk = *(const unsigned*)(Zg + (size_t)(t0 + i - (CW - 1)) * D + c);
            z0[i] = bf_lo(pk); z1[i] = bf_hi(pk); } }
    for (int tile = tb; tile < te; ++tile) {
        const int t0 = tile * CT; const bool more = (tile + 1 < te);
        if (more) {
#pragma unroll
            for (int i = 0; i < CT; ++i) nx[i] = *(const unsigned*)(Zg + (size_t)(t0 + CT + i) * D + c); }
        float o0[CT], o1[CT];
#pragma unroll
        for (int t = 0; t < CT; ++t) { o0[t] = bb.x; o1[t] = bb.y; }
#pragma unroll
        for (int j = 0; j < CW; ++j) {
#pragma unroll
            for (int t = 0; t < CT; ++t) { o0[t] += w0[j] * z0[t + j]; o1[t] += w1[j] * z1[t + j]; } }
        { const bool fresh = (((t0 + CT) & (SEQ - 1)) == 0);
#pragma unroll
            for (int i = 0; i < CW - 1; ++i) { z0[i] = fresh ? 0.f : z0[i + CT]; z1[i] = fresh ? 0.f : z1[i + CT]; } }
        { float k32[2 * CT];
#pragma unroll
            for (int t = 0; t < CT; ++t) { k32[2 * t] = o0[t] + o1[t]; k32[2 * t + 1] = o0[t] * o0[t] + o1[t] * o1[t]; }
            float k16[16], k8[8], k4[4], k2[2];
            const bool b5 = (lane & 32) != 0, b4 = (lane & 16) != 0, b3 = (lane & 8) != 0, b2 = (lane & 4) != 0, b1 = (lane & 2) != 0;
#pragma unroll
            for (int k = 0; k < 16; ++k) { const float send = b5 ? k32[k] : k32[16 + k], mine = b5 ? k32[16 + k] : k32[k]; k16[k] = mine + __shfl_xor(send, 32); }
#pragma unroll
            for (int k = 0; k < 8; ++k) { const float send = b4 ? k16[k] : k16[8 + k], mine = b4 ? k16[8 + k] : k16[k]; k8[k] = mine + __shfl_xor(send, 16); }
#pragma unroll
            for (int k = 0; k < 4; ++k) { const float send = b3 ? k8[k] : k8[4 + k], mine = b3 ? k8[4 + k] : k8[k]; k4[k] = mine + __shfl_xor(send, 8); }
#pragma unroll
            for (int k = 0; k < 2; ++k) { const float send = b2 ? k4[k] : k4[2 + k], mine = b2 ? k4[2 + k] : k4[k]; k2[k] = mine + __shfl_xor(send, 4); }
            const float send1 = b1 ? k2[0] : k2[1], mine1 = b1 ? k2[1] : k2[0]; float tot = mine1 + __shfl_xor(send1, 2);
            tot += __shfl_xor(tot, 1);
            if ((lane & 1) == 0) red[(lane >> 1) * 8 + wave] = tot; }
        __syncthreads();
        if (tid < CT) {
            const f32x4 a = *(const LAS f32x4*)(red + (2 * tid) * 8), b = *(const LAS f32x4*)(red + (2 * tid) * 8 + 4);
            const f32x4 p = *(const LAS f32x4*)(red + (2 * tid + 1) * 8), q = *(const LAS f32x4*)(red + (2 * tid + 1) * 8 + 4);
            const float s1 = ((a.x + a.y) + (a.z + a.w)) + ((b.x + b.y) + (b.z + b.w)), s2 = ((p.x + p.y) + (p.z + p.w)) + ((q.x + q.y) + (q.z + q.w));
            const float mu = s1 * (1.0f / D); const float var = fmaxf(s2 * (1.0f / D) - mu * mu, 0.f);
            *(LAS f32x2*)(red + 256 + 2 * tid) = (f32x2){mu, 1.0f / sqrtf(var + EPS)}; }
        __syncthreads();
        unsigned* outp = (unsigned*)(ZC + (size_t)t0 * D + c);
#pragma unroll
        for (int t = 0; t < CT; ++t) { const f32x2 st = *(const LAS f32x2*)(red + 256 + 2 * t);
            float y0 = (o0[t] - st.x) * st.y * gg.x + lb.x, y1 = (o1[t] - st.x) * st.y * gg.y + lb.y;
            y0 = y0 * sigmoid_f(y0); y1 = y1 * sigmoid_f(y1);
            outp[(size_t)t * (D / 2)] = pk2(y0, y1); }
        if (more) {
#pragma unroll
            for (int i = 0; i < CT; ++i) { z0[CW - 1 + i] = bf_lo(nx[i]); z1[CW - 1 + i] = bf_hi(nx[i]); } }
        __syncthreads();
    }
}

constexpr int VROW = 272;
constexpr int ATT_UNITS = BATCH * 12 * 32;
__device__ __forceinline__ v4i16_t tr16(const LAS unsigned char* p) { return __builtin_amdgcn_ds_read_tr16_b64_v4i16((LAS v4i16_t*)p); }
struct AttnPre { v4u k[4], v[4]; bf16x8 q[4]; };
struct AttnIdx { size_t row0; int hg, dsh, n; };
__device__ __forceinline__ AttnIdx attn_decode(int unit) {
    AttnIdx x; const int bh = unit >> 5, j = unit & 31; x.hg = bh % 12; const int gi = x.hg >> 2;
    x.dsh = 2 * gi; const int nbsh = 5 - x.dsh;
    x.n = j & ((1 << nbsh) - 1);
    x.row0 = (size_t)bh * SEQ + (size_t)j * 128; return x;
}
constexpr int ATT_HB = 128 * VROW;
constexpr int ATT_KOFF = 0, ATT_VOFF = 2 * ATT_HB;
__device__ __forceinline__ void attn_load_kv(AttnPre& p, const bf16* K, const bf16* V, size_t r0, int tid) {
#pragma unroll
    for (int i = 0; i < 4; ++i) { const size_t off = r0 * 128 + (size_t)(tid + 512 * i) * 8; p.k[i] = *(const v4u*)(K + off); p.v[i] = *(const v4u*)(V + off); }
}
__device__ __forceinline__ void attn_load(AttnPre& p, const bf16* Q, const bf16* K, const bf16* V, int unit, int tid, int w, int lq, int g) {
    const AttnIdx x = attn_decode(unit);
    attn_load_kv(p, K, V, x.row0, tid);
#pragma unroll
    for (int s = 0; s < 4; ++s) p.q[s] = *(const bf16x8*)(Q + (x.row0 + 16 * w + lq) * 128 + 32 * s + 8 * g);
}
__device__ __forceinline__ void attn_stage(LAS unsigned char* lds, const AttnPre& p, int half, int tid) {
#pragma unroll
    for (int i = 0; i < 4; ++i) { const int cidx = tid + 512 * i, row = cidx >> 4, ch = cidx & 15;
        *(LAS v4u*)(lds + ATT_KOFF + half * ATT_HB + row * VROW + ch * 16) = p.k[i]; *(LAS v4u*)(lds + ATT_VOFF + half * ATT_HB + row * VROW + ch * 16) = p.v[i]; }
}
__device__ __forceinline__ void attn_compute(LAS unsigned char* lds, const bf16x8 (&qf)[4], bf16* O, float* LSE, int unit, int f, int lane, int w, int lq, int g) {
    const AttnIdx x = attn_decode(unit); const int hg = x.hg, n = x.n;
    int rowT[9];
#pragma unroll
    for (int T = 0; T < 9; ++T) { const int kk0 = 16 * w + 16 * T; rowT[T] = ((((kk0 >> 7) ^ f) & 1) << 7) + (kk0 & 127); }
    f32x4 st[9];
    const LAS unsigned char* kb = lds + ATT_KOFF + lq * VROW + 16 * g;
#pragma unroll
    for (int T = 0; T < 9; ++T) { f32x4 a = (f32x4){0.f, 0.f, 0.f, 0.f}; const LAS unsigned char* kp = kb + rowT[T] * VROW;
#pragma unroll
        for (int s = 0; s < 4; ++s) { const bf16x8 kf = *(const LAS bf16x8*)(kp + 64 * s); a = __builtin_amdgcn_mfma_f32_16x16x32_bf16(kf, qf[s], a, 0, 0, 0); }
        st[T] = a; }
    const float slope2 = __builtin_amdgcn_exp2f(-(float)(8 * (hg + 1)) * (1.0f / 12.0f)) * (float)(1 << x.dsh) * 1.4426950408889634f;
    float mx = -__builtin_inff();
#pragma unroll
    for (int T = 0; T < 9; ++T)
#pragma unroll
        for (int reg = 0; reg < 4; ++reg) { const int steps = 128 + lq - 16 * T - 4 * g - reg, ki = 16 * w + 16 * T + 4 * g + reg;
            const bool valid = (steps >= 0) && (steps <= 128) && (n > 0 || ki >= 128);
            const float v = valid ? st[T][reg] - slope2 * (float)steps : -__builtin_inff(); st[T][reg] = v; mx = fmaxf(mx, v); }
    mx = fmaxf(mx, __shfl_xor(mx, 16)); mx = fmaxf(mx, __shfl_xor(mx, 32));
    float sum = 0.f;
#pragma unroll
    for (int T = 0; T < 9; ++T)
#pragma unroll
        for (int reg = 0; reg < 4; ++reg) { const float p = __builtin_amdgcn_exp2f(st[T][reg] - mx); st[T][reg] = p; sum += p; }
    sum += __shfl_xor(sum, 16); sum += __shfl_xor(sum, 32);
    bf16x8 pf[5];
#pragma unroll
    for (int u = 0; u < 5; ++u) { v4u t; t.x = pk2(st[2 * u][0], st[2 * u][1]); t.y = pk2(st[2 * u][2], st[2 * u][3]);
        if (u < 4) { t.z = pk2(st[2 * u + 1][0], st[2 * u + 1][1]); t.w = pk2(st[2 * u + 1][2], st[2 * u + 1][3]); } else { t.z = 0u; t.w = 0u; }
        pf[u] = __builtin_bit_cast(bf16x8, t); }
    const LAS unsigned char* vb = lds + ATT_VOFF + (4 * g + ((lane & 15) >> 2)) * VROW + (lane & 3) * 16;
    f32x4 o[4][2];
#pragma unroll
    for (int cp = 0; cp < 4; ++cp) { o[cp][0] = (f32x4){0.f, 0.f, 0.f, 0.f}; o[cp][1] = (f32x4){0.f, 0.f, 0.f, 0.f}; }
#pragma unroll
    for (int u = 0; u < 5; ++u) { const LAS unsigned char* vlo = vb + rowT[2 * u] * VROW; const LAS unsigned char* vhi = vb + rowT[u < 4 ? 2 * u + 1 : 8] * VROW;
#pragma unroll
        for (int cp = 0; cp < 4; ++cp)
#pragma unroll
            for (int h2 = 0; h2 < 2; ++h2) {
                const v4i16_t lo = tr16(vlo + cp * 64 + h2 * 8), hi = tr16(vhi + cp * 64 + h2 * 8);
                const bf16x8 vf = (bf16x8){lo[0], lo[1], lo[2], lo[3], hi[0], hi[1], hi[2], hi[3]};
                o[cp][h2] = __builtin_amdgcn_mfma_f32_16x16x32_bf16(vf, pf[u], o[cp][h2], 0, 0, 0); } }
    const float inv = 1.0f / sum;
    const size_t rq = x.row0 + 16 * w + lq;
    bf16* op = O + rq * 128 + 8 * g;
#pragma unroll
    for (int cp = 0; cp < 4; ++cp) { const f32x4 a = o[cp][0] * inv, c = o[cp][1] * inv;
        v4u t; t.x = pk2(a[0], a[1]); t.y = pk2(a[2], a[3]); t.z = pk2(c[0], c[1]); t.w = pk2(c[2], c[3]);
        *(v4u*)(op + 32 * cp) = t; }
    if (g == 0) LSE[rq] = mx + __builtin_amdgcn_logf(sum);
}
__device__ __forceinline__ void attn_phase(LAS unsigned char* lds, const bf16* Q, const bf16* K, const bf16* V, bf16* O, float* LSE, int vcu, int G) {
    const int tid = threadIdx.x, lane = tid & 63, w = __builtin_amdgcn_readfirstlane(tid >> 6), lq = lane & 15, g = lane >> 4;
    const int upb = (ATT_UNITS + G - 1) / G; const int u0 = vcu * upb; int u1 = u0 + upb; if (u1 > ATT_UNITS) u1 = ATT_UNITS;
    if (u0 >= u1) return;
    for (int i = tid; i < 4 * ATT_HB / 16; i += NTHREADS) ((LAS v4u*)lds)[i] = (v4u){0u, 0u, 0u, 0u};
    __syncthreads();
    AttnPre pre; int f = 0;
    { const AttnIdx x0 = attn_decode(u0); if (x0.n > 0) { attn_load_kv(pre, K, V, x0.row0 - 128, tid); attn_stage(lds, pre, f, tid); } }
    attn_load(pre, Q, K, V, u0, tid, w, lq, g);
    for (int u = u0; u < u1; ++u) {
        bf16x8 qf[4];
#pragma unroll
        for (int s = 0; s < 4; ++s) qf[s] = pre.q[s];
        attn_stage(lds, pre, f ^ 1, tid);
        __syncthreads();
        if (u + 1 < u1) attn_load(pre, Q, K, V, u + 1, tid, w, lq, g);
        attn_compute(lds, qf, O, LSE, u, f, lane, w, lq, g);
        __syncthreads();
        f ^= 1;
    }
}

__device__ __forceinline__ void merge_rows(const bf16* OG, const float* LSE, bf16* ATT, int gw, int NGW, int lane) {
    const int hh = lane >> 4, c0 = (lane & 15) * 8;
    for (int m0 = gw * 4; m0 < M; m0 += NGW * 4) {
        float l[4][3]; v4u a[4][3];
#pragma unroll
        for (int r = 0; r < 4; ++r) { const int m = m0 + r, b = m >> 12, s = m & 4095;
#pragma unroll
            for (int gi = 0; gi < 3; ++gi) { const int dsh = 2 * gi; const int pos = ((s & ((1 << dsh) - 1)) << (12 - dsh)) + (s >> dsh);
                const size_t row = (size_t)(b * 12 + gi * 4 + hh) * 4096 + pos; l[r][gi] = LSE[row]; a[r][gi] = *(const v4u*)(OG + row * 128 + c0); } }
#pragma unroll
        for (int r = 0; r < 4; ++r) {
            const float mx = fmaxf(l[r][0], fmaxf(l[r][1], l[r][2]));
            float e0 = __builtin_amdgcn_exp2f(l[r][0] - mx), e1 = __builtin_amdgcn_exp2f(l[r][1] - mx), e2 = __builtin_amdgcn_exp2f(l[r][2] - mx);
            const float inv = 1.0f / (e0 + e1 + e2); e0 *= inv; e1 *= inv; e2 *= inv;
            const v4u A = a[r][0], B = a[r][1], C = a[r][2]; v4u o;
            o.x = pk2(e0 * bf_lo(A.x) + e1 * bf_lo(B.x) + e2 * bf_lo(C.x), e0 * bf_hi(A.x) + e1 * bf_hi(B.x) + e2 * bf_hi(C.x));
            o.y = pk2(e0 * bf_lo(A.y) + e1 * bf_lo(B.y) + e2 * bf_lo(C.y), e0 * bf_hi(A.y) + e1 * bf_hi(B.y) + e2 * bf_hi(C.y));
            o.z = pk2(e0 * bf_lo(A.z) + e1 * bf_lo(B.z) + e2 * bf_lo(C.z), e0 * bf_hi(A.z) + e1 * bf_hi(B.z) + e2 * bf_hi(C.z));
            o.w = pk2(e0 * bf_lo(A.w) + e1 * bf_lo(B.w) + e2 * bf_lo(C.w), e0 * bf_hi(A.w) + e1 * bf_hi(B.w) + e2 * bf_hi(C.w));
            *(v4u*)(ATT + (size_t)(m0 + r) * 512 + hh * 128 + c0) = o; }
    }
}

#define XB_TMO      128
#define XB_XCNT(j)  (256  + 64 * (j))
#define XB_XSUB(j)  (1280 + 64 * (j))
#define XB_XGEN(j)  (2304 + 64 * (j))
#define XB_TOP      3328
#define XB_TOPGEN   3392
#define XCD_BAR_WORDS 3456
#define XB_SPIN_CAP (1u << 18)

__device__ __forceinline__ unsigned xb_ld(unsigned* p)              { return __hip_atomic_load(p, __ATOMIC_RELAXED, __HIP_MEMORY_SCOPE_AGENT); }
__device__ __forceinline__ unsigned xb_add(unsigned* p, unsigned v) { return __hip_atomic_fetch_add(p, v, __ATOMIC_RELAXED, __HIP_MEMORY_SCOPE_AGENT); }
__device__ __forceinline__ unsigned xb_xcc_id() { return (unsigned)__builtin_amdgcn_s_getreg((3 << 11) | 20) & 0xFu; }
#define XB_SPIN(cond, bar) do { unsigned _sp = 0; while (cond) { __builtin_amdgcn_s_sleep(1); \
    if ((++_sp & 255u) == 0u) { if (xb_ld(&(bar)[XB_TMO])) break; if (_sp > XB_SPIN_CAP) { atomicAdd(&(bar)[XB_TMO], 1u); break; } } } } while (0)

struct XcdBarrier {
    unsigned* bar; unsigned x;
    volatile LAS unsigned* st;
};

__device__ __forceinline__ XcdBarrier xcd_barrier_post(unsigned* bar, volatile LAS unsigned* st) {
    XcdBarrier b; b.bar = bar; b.x = xb_xcc_id(); b.st = st;
    if (threadIdx.x == 0) (void)xb_add(&bar[XB_XCNT(b.x)], 1u);
    return b;
}
__device__ __forceinline__ void xcd_barrier_complete(unsigned* bar, unsigned x, unsigned& nloc, unsigned& nx) {
    const unsigned G = gridDim.x * gridDim.y * gridDim.z;
    unsigned sum, cnt, mine, sp = 0u;
    for (;;) {
        sum = 0u; cnt = 0u; mine = 0u;
#pragma unroll
        for (unsigned j = 0; j < 16; ++j) { const unsigned c = xb_ld(&bar[XB_XCNT(j)]); sum += c; cnt += (c > 0u) ? 1u : 0u; mine = (j == x) ? c : mine; }
        if (sum == G) break;
        __builtin_amdgcn_s_sleep(1);
        if ((++sp & 255u) == 0u) { if (xb_ld(&bar[XB_TMO])) break; if (sp > XB_SPIN_CAP) { atomicAdd(&bar[XB_TMO], 1u); break; } }
    }
    nloc = mine > 0u ? mine : 1u; nx = cnt > 0u ? cnt : 1u;
}

__device__ __forceinline__ void xcd_barrier(const XcdBarrier& b) {
    asm volatile("s_waitcnt vmcnt(0)" ::: "memory");
    __syncthreads();
    if (threadIdx.x == 0) {
        unsigned* bar = b.bar;
        __builtin_amdgcn_s_waitcnt(0);
        unsigned nloc = b.st[0], nx = b.st[1];
        if (nloc == 0u) { xcd_barrier_complete(bar, b.x, nloc, nx); b.st[0] = nloc; b.st[1] = nx; }
        const unsigned old = xb_add(&bar[XB_XSUB(b.x)], 1u);
        const unsigned gen = old / nloc;
        if (old + 1u == (gen + 1u) * nloc) {
            __builtin_amdgcn_fence(__ATOMIC_RELEASE, "agent");
            asm volatile("s_waitcnt vmcnt(0)" ::: "memory");
            const unsigned og = xb_add(&bar[XB_TOP], 1u);
            const unsigned tg = og / nx;
            if (og + 1u == (tg + 1u) * nx) xb_add(&bar[XB_TOPGEN], 1u);
            else XB_SPIN(xb_ld(&bar[XB_TOPGEN]) == tg, bar);
            __builtin_amdgcn_fence(__ATOMIC_ACQUIRE, "agent");
            xb_add(&bar[XB_XGEN(b.x)], 1u);
            asm volatile("s_waitcnt vmcnt(0)" ::: "memory");
        } else {
            XB_SPIN(xb_ld(&bar[XB_XGEN(b.x)]) == gen, bar);
            __builtin_amdgcn_fence(__ATOMIC_ACQUIRE, "agent");
            asm volatile("s_waitcnt vmcnt(0)" ::: "memory");
        }
    }
    __syncthreads();
}

template <int NP> __device__ __forceinline__ void fill_rstab(LAS unsigned char* lds, const float* ssp, int N, int G, int bx, int tid) {
    LAS float* rstab = (LAS float*)(lds + 131072); LAS int* pmtab = (LAS int*)(lds + 131072 + 12288);
    pg8::StaticOrder S0; S0.init(M, N, G, bx); pg8::Unit u0; int nu = 0;
    for (; nu < 12 && S0.next(nu, u0); ++nu) if (tid == 0) pmtab[nu] = u0.pm;
    __syncthreads();
    float sv[6];
#pragma unroll
    for (int k = 0; k < 6; ++k) { const int ri = tid + 512 * k; sv[k] = 0.f;
        if (ri < nu * 256) { const float* p = ssp + (size_t)(pmtab[ri >> 8] * 256 + (ri & 255)) * NP;
            if (NP == 16) { const f32x4 a = *(const f32x4*)p, b = *(const f32x4*)(p + 4), c = *(const f32x4*)(p + 8), d = *(const f32x4*)(p + 12);
                sv[k] = (((a.x + a.y) + (a.z + a.w)) + ((b.x + b.y) + (b.z + b.w))) + (((c.x + c.y) + (c.z + c.w)) + ((d.x + d.y) + (d.z + d.w))); }
            else sv[k] = p[0]; } }
#pragma unroll
    for (int k = 0; k < 6; ++k) { const int ri = tid + 512 * k; if (ri < nu * 256) rstab[ri] = __builtin_amdgcn_rsqf(sv[k] * (1.0f / 1024.0f) + EPS); }
    __syncthreads();
}

struct Args { const float* in[19]; float* out; unsigned char* ws; int ph_lo, ph_hi; };
#ifndef MK_MULTI
#define MK_MULTI 0
#endif
#if MK_MULTI
#define GRID_SYNC() do { } while (0)
#else
#ifndef MK_CG
#define MK_CG 0
#endif
#if MK_CG
#define GRID_SYNC() do { __threadfence(); cg::this_grid().sync(); } while (0)
#else
#define GRID_SYNC() xcd_barrier(xbar)
#endif
#endif

__global__ void __launch_bounds__(NTHREADS, 2) fwd_kernel(Args args) {
    extern __shared__ __attribute__((aligned(16))) unsigned char lds_raw[];
    LAS unsigned char* lds = (LAS unsigned char*)lds_raw;
    const int tid = threadIdx.x, lane = tid & 63, wave = __builtin_amdgcn_readfirstlane(tid >> 6);
    const int G = gridDim.x, bx = blockIdx.x; const int vcu = (G % 8 == 0) ? (bx % 8) * (G / 8) + bx / 8 : bx;
    const int gw = vcu * NWAVES + wave, NGW = G * NWAVES;
    unsigned char* ws = args.ws;
#if !MK_MULTI && !MK_CG
    volatile LAS unsigned* xst = (volatile LAS unsigned*)(lds + LDS_BYTES - 128);
    if (tid < 2) xst[tid] = 0u;
    __syncthreads();
    XcdBarrier xbar = xcd_barrier_post((unsigned*)(ws + WS_CTL), xst);
#endif
    const float* x = args.in[0];
    float* X = args.out; bf16* XB = (bf16*)args.out;
#define Wgu1 ((bf16*)(ws + WS_WGU1))
#define Wd1 ((bf16*)(ws + WS_WD1))
#define Wgu2 ((bf16*)(ws + WS_WGU2))
#define Wd2 ((bf16*)(ws + WS_WD2))
#define Win ((bf16*)(ws + WS_WIN))
#define Wc ((bf16*)(ws + WS_WC))
#define Wa ((bf16*)(ws + WS_WA))
#define Wo ((bf16*)(ws + WS_WO))
#define H ((bf16*)(ws + WS_H))
#define ZC ((bf16*)(ws + WS_ZC))
#define Qb ((bf16*)(ws + WS_Q))
#define Kb ((bf16*)(ws + WS_K))
#define Vb ((bf16*)(ws + WS_V))
#define LSE ((float*)(ws + WS_LSE))
#define ATT ((bf16*)(ws + WS_ATT))
#define ZG ((bf16*)(ws + WS_ZG))
#define GT ((bf16*)(ws + WS_G))
#define T1 ((bf16*)(ws + WS_T1))
#define MIX ((bf16*)(ws + WS_MIX))
#define A1 ((bf16*)(ws + WS_A1))
#define SS1 ((float*)(ws + WS_SS))
#define SS2 ((float*)(ws + WS_SSP))
#define SS3 ((float*)(ws + WS_SSP) + (size_t)M * 16)
    const int lo = args.ph_lo, hi = args.ph_hi;
#define IN(k) (lo <= (k) && (k) < hi)
#define SEAM(k) do { if (IN(k) && IN((k) + 1)) GRID_SYNC(); } while (0)
#define GEMM_PHASE(EPI, Aptr, Bptr, Nn, Kk, ...) do { pg8::Gemm g_{Aptr, Bptr, M, Nn, Kk}; pg8::StaticOrder S_; S_.init(M, Nn, G, bx); EPI E_{__VA_ARGS__}; \
        pg8::gemm_phase<EPI, pg8::StaticOrder, true, true>(lds, g_, S_, E_); } while (0)
#define GEMM_PHASE_RS(SSp, NP, EPI, Aptr, Bptr, Nn, Kk, ...) do { fill_rstab<NP>(lds, SSp, Nn, G, bx, tid); GEMM_PHASE(EPI, Aptr, Bptr, Nn, Kk, __VA_ARGS__); } while (0)

    if (IN(0)) {
        LAS float* scr = (LAS float*)(lds + wave * 16384);
        constexpr int I_GU = 16 * 88, I_DN = 44 * 32, I_IN = 16 * 272, I_C = 16 * 32, I_A = 8 * 32;
        constexpr int NITEMS = 6 * I_GU + I_IN + 2 * I_C + I_A;
        static_assert(I_DN == I_GU, "items");
        for (int it = gw; it < NITEMS; it += NGW) {
            int r = it;
            if (r < I_GU) { transpose_item(args.in[2], D, FF, Wgu1, 1, scr, r, lane, args.in[1]); continue; } r -= I_GU;
            if (r < I_GU) { transpose_item(args.in[3], D, FF, Wgu1, 2, scr, r, lane, args.in[1]); continue; } r -= I_GU;
            if (r < I_GU) { transpose_item(args.in[4], FF, D, Wd1, 0, scr, r, lane); continue; } r -= I_GU;
            if (r < I_GU) { transpose_item(args.in[15], D, FF, Wgu2, 1, scr, r, lane, args.in[14]); continue; } r -= I_GU;
            if (r < I_GU) { transpose_item(args.in[16], D, FF, Wgu2, 2, scr, r, lane, args.in[14]); continue; } r -= I_GU;
            if (r < I_GU) { transpose_item(args.in[17], FF, D, Wd2, 0, scr, r, lane); continue; } r -= I_GU;
            if (r < I_IN) { transpose_item(args.in[6], D, NIN, Win, 3, scr, r, lane, args.in[5]); continue; } r -= I_IN;
            if (r < I_C) { transpose_item(args.in[11], D, D, Wc, 0, scr, r, lane); continue; } r -= I_C;
            if (r < I_A) { transpose_item(args.in[12], 512, D, Wa, 0, scr, r, lane); continue; } r -= I_A;
            transpose_item(args.in[13], D, D, Wo, 0, scr, r, lane);
        }
        raw_rows(x, H, SS1, gw, NGW, lane);
        __syncthreads();
    }
    SEAM(0);
    if (IN(1)) GEMM_PHASE_RS(SS1, 1, pg8::EpiPair<0>, H, Wgu1, 2 * FF, D, A1, FF);
    SEAM(1);
    if (IN(2)) GEMM_PHASE(pg8::EpiResid<true>, A1, Wd1, D, FF, H, XB, SS2, 0.5f);
    SEAM(2);
    if (IN(3)) GEMM_PHASE_RS(SS2, 16, pg8::EpiPair<1>, XB, Win, 2048, D, ZG, D);
    SEAM(3);
    if (IN(4)) conv_phase(ZG, args.in[7], args.in[8], args.in[9], args.in[10], ZC, (LAS float*)lds, vcu, G);
    SEAM(4);
    if (IN(5)) GEMM_PHASE_RS(SS2, 16, pg8::EpiQKV, XB, Win + (size_t)2048 * D, 3 * AW, D, Qb, (size_t)(WS_K - WS_Q) / 2, 0.08838834764831845f * 1.4426950408889634f);
    SEAM(5);
    if (IN(6)) attn_phase(lds, Qb, Kb, Vb, Qb, LSE, vcu, G);
    SEAM(6);
    if (IN(7)) { merge_rows(Qb, LSE, ATT, gw, NGW, lane); __syncthreads(); }
    if (IN(7)) GEMM_PHASE_RS(SS2, 16, pg8::EpiSig, XB, Win + (size_t)6656 * D, 2048, D, GT, 2048);
    SEAM(7);
    if (IN(8)) GEMM_PHASE(pg8::EpiGate<false>, ZC, Wc, D, D, nullptr, GT, 2048, T1);
    if (IN(9)) GEMM_PHASE(pg8::EpiGate<true>, ATT, Wa, D, 512, T1, GT + 1024, 2048, MIX);
    SEAM(9);
    if (IN(10)) GEMM_PHASE(pg8::EpiResid<true>, MIX, Wo, D, D, XB, XB, SS3, 1.0f);
    SEAM(10);
    if (IN(11)) GEMM_PHASE_RS(SS3, 16, pg8::EpiPair<0>, XB, Wgu2, 2 * FF, D, A1, FF);
    SEAM(11);
    if (IN(12)) GEMM_PHASE(pg8::EpiResid<true>, A1, Wd2, D, FF, XB, H, nullptr, 0.5f);
    SEAM(12);
    if (IN(13)) rms_rows_b(H, args.in[18], X, gw, NGW, lane);
#undef IN
#undef Wgu1
#undef Wd1
#undef Wgu2
#undef Wd2
#undef Win
#undef Wc
#undef Wa
#undef Wo
#undef H
#undef ZC
#undef Qb
#undef Kb
#undef Vb
#undef LSE
#undef ATT
#undef ZG
#undef GT
#undef T1
#undef MIX
#undef A1
#undef SS1
#undef SS2
#undef SS3
#undef SEAM
}
constexpr int NPHASES = 14;

extern "C" void kernel_launch(void* const* d_in, const int* in_sizes, int n_in, void* d_out, int out_size, void* d_ws, size_t ws_size, hipStream_t stream) {
    static int grid = 0;
    if (grid == 0) {
        if (n_in != 19 || out_size != M * D || ws_size < WS_END) { fprintf(stderr, "kernel_launch: unexpected shapes (n_in %d out %d ws %zu)\n", n_in, out_size, ws_size); grid = -1; return; }
        int dev = 0, cus = 0, per_cu = 0;
        hipGetDevice(&dev); hipDeviceGetAttribute(&cus, hipDeviceAttributeMultiprocessorCount, dev);
        if (hipFuncSetAttribute((const void*)fwd_kernel, hipFuncAttributeMaxDynamicSharedMemorySize, LDS_BYTES) != hipSuccess) { fprintf(stderr, "kernel_launch: hipFuncSetAttribute failed\n"); grid = -1; return; }
        if (hipOccupancyMaxActiveBlocksPerMultiprocessor(&per_cu, (const void*)fwd_kernel, NTHREADS, LDS_BYTES) != hipSuccess || per_cu < 1) { fprintf(stderr, "kernel_launch: occupancy query says %d\n", per_cu); per_cu = 1; }
        (void)hipGetLastError();
        if (per_cu > 1) per_cu = 1;
        grid = cus * per_cu;
    }
    if (grid < 0) return;
    Args a{};
    for (int i = 0; i < 19; ++i) a.in[i] = (const float*)d_in[i];
    a.out = (float*)d_out; a.ws = (unsigned char*)d_ws;
#if MK_MULTI
    for (int p = 0; p < NPHASES; ++p) { a.ph_lo = p; a.ph_hi = p + 1; hipLaunchKernelGGL(fwd_kernel, dim3(grid), dim3(NTHREADS), LDS_BYTES, stream, a); }
#else
    a.ph_lo = 0; a.ph_hi = NPHASES;
#if MK_CG
    void* kargs[] = {&a};
    hipError_t e = hipLaunchCooperativeKernel((const void*)fwd_kernel, dim3(grid), dim3(NTHREADS), kargs, LDS_BYTES, stream);
    if (e != hipSuccess) fprintf(stderr, "cooperative launch failed: %s (grid %d)\n", hipGetErrorString(e), grid);
#else
    if (hipMemsetAsync((char*)d_ws + WS_CTL, 0, 65536, stream) != hipSuccess) { fprintf(stderr, "kernel_launch: memset failed\n"); return; }
    hipLaunchKernelGGL(fwd_kernel, dim3(grid), dim3(NTHREADS), LDS_BYTES, stream, a);
#endif
#endif
}
```

```cpp
#include <hip/hip_runtime.h>
#include <cstdio>
#include <cstdint>
namespace pg8 {
#define PG8_LAS __attribute__((address_space(3)))
typedef unsigned short bf16_t;
typedef short bf16x8 __attribute__((ext_vector_type(8)));
typedef float f32x4 __attribute__((ext_vector_type(4)));
typedef unsigned u32x4 __attribute__((ext_vector_type(4)));
constexpr int BM = 256, BK = 64, HALF = 128, HTB = HALF * BK * 2  , STAGE_BYTES = 8 * HTB, NXCD = 8, WGM = 8;

__host__ __device__ __forceinline__ int lds_byte(int r, int c) { const int st = (r >> 4) * 2 + (c >> 5), rr = r & 15, cc = c & 31, ob = rr * 64 + cc * 2; return st * 1024 + (ob ^ (((ob >> 9) & 1) << 5)); }
__host__ __device__ __forceinline__ void stage_rc(int b, int& R, int& C) { const int st = b / 1024, sb = b % 1024, swz = sb ^ (((sb >> 9) & 1) << 5); R = (st >> 1) * 16 + swz / 64; C = (st & 1) * 32 + (swz % 64) / 2; }
__host__ __device__ __forceinline__ int perm32(int rho) { const int n = rho >> 4, i = rho & 15; return 8 * (i >> 2) + 4 * n + (i & 3); }

struct Unit { int pm, pn; };
struct Gemm { const bf16_t* A; const bf16_t* Bt; int M, N, K; };

struct StaticOrder {
    int nM, nN, nwg, G, c;
    __host__ __device__ void init(int M, int N, int G_, int c_) { nM = M / BM; nN = N / BM; nwg = nM * nN; G = G_; c = c_; }
    __host__ __device__ bool next(int i, Unit& u) const {
        const long L = (long)i * G + c; if (L >= nwg) return false;
        int wgid = (int)L; { const int q = nwg / NXCD, r = nwg % NXCD, xcd = wgid % NXCD, off = wgid / NXCD; wgid = (xcd < r ? xcd * (q + 1) : r * (q + 1) + (xcd - r) * q) + off; }
        const int nig = WGM * nN, gid = wgid / nig, fm = gid * WGM, gsz = (nM - fm) < WGM ? (nM - fm) : WGM;
        u.pm = fm + ((wgid % nig) % gsz); u.pn = (wgid % nig) / gsz; return true;
    }
    __device__ __forceinline__ void a_ready(const Unit&) const {}
    __device__ __forceinline__ void done(const Unit&) const {}
};

typedef float f32x2_t __attribute__((ext_vector_type(2))); typedef __bf16 bf16x2_t __attribute__((ext_vector_type(2)));
__device__ __forceinline__ unsigned cvt_pk_bf16(float lo, float hi) { const f32x2_t v = {lo, hi}; const bf16x2_t b = __builtin_convertvector(v, bf16x2_t); return __builtin_bit_cast(unsigned, b); }
typedef float f32x2 __attribute__((ext_vector_type(2)));
__device__ __forceinline__ float sigmoid_f(float x) { return __builtin_amdgcn_rcpf(1.0f + __builtin_amdgcn_exp2f(-1.4426950408889634f * x)); }
__device__ __forceinline__ float bf_lo(unsigned u) { return __uint_as_float(u << 16); }
__device__ __forceinline__ float bf_hi(unsigned u) { return __uint_as_float(u & 0xffff0000u); }

template <int ACT> struct EpiPair {
    static constexpr bool PERM = true, AFTER_DRAIN = false;
    bf16_t* O; int ldo;
    __device__ __forceinline__ void operator()(const f32x4 (&acc)[2][2][4][2], const Unit& u, int wr, int wc, int fr, int fq, int ui, PG8_LAS unsigned char* lds) const {
        const PG8_LAS float* rs = (const PG8_LAS float*)(lds + 131072);
        const int row0 = u.pm * BM + wr * 64 + fr, col0 = u.pn * HALF + wc * 32 + 8 * fq;
#pragma unroll
        for (int ai = 0; ai < 2; ++ai)
#pragma unroll
            for (int m = 0; m < 4; ++m) { const float rsv = rs[ui * 256 + ai * HALF + wr * 64 + m * 16 + fr];
                float v[8];
#pragma unroll
                for (int n = 0; n < 2; ++n)
#pragma unroll
                    for (int i = 0; i < 4; ++i) { const float a = acc[ai][0][m][n][i] * rsv, b = acc[ai][1][m][n][i] * rsv;
                        v[n * 4 + i] = (ACT == 0) ? a * sigmoid_f(a) * b : a * sigmoid_f(b); }
                u32x4 w; w.x = cvt_pk_bf16(v[0], v[1]); w.y = cvt_pk_bf16(v[2], v[3]); w.z = cvt_pk_bf16(v[4], v[5]); w.w = cvt_pk_bf16(v[6], v[7]);
                *(u32x4*)(O + (size_t)(row0 + ai * HALF + m * 16) * ldo + col0) = w; }
    }
};
template <bool BASE_BF16> struct EpiResid {
    static constexpr bool PERM = true, AFTER_DRAIN = false;
    const void* base; bf16_t* outb; float* ss; float alpha;
    __device__ __forceinline__ void operator()(const f32x4 (&acc)[2][2][4][2], const Unit& u, int wr, int wc, int fr, int fq, int, PG8_LAS unsigned char*) const {
        const int row0 = u.pm * BM + wr * 64 + fr, col0 = u.pn * BM + wc * 32 + 8 * fq;
#pragma unroll
        for (int ai = 0; ai < 2; ++ai)
#pragma unroll
            for (int m = 0; m < 4; ++m) { const size_t off = (size_t)(row0 + ai * HALF + m * 16) * 1024 + col0; float sq = 0.f;
#pragma unroll
                for (int bj = 0; bj < 2; ++bj) { f32x4 b0, b1;
                    if (BASE_BF16) { const u32x4 r = *(const u32x4*)((const bf16_t*)base + off + bj * HALF);
                        b0 = (f32x4){bf_lo(r.x), bf_hi(r.x), bf_lo(r.y), bf_hi(r.y)}; b1 = (f32x4){bf_lo(r.z), bf_hi(r.z), bf_lo(r.w), bf_hi(r.w)}; }
                    else { b0 = *(const f32x4*)((const float*)base + off + bj * HALF); b1 = *(const f32x4*)((const float*)base + off + bj * HALF + 4); }
                    const f32x4 v0 = b0 + acc[ai][bj][m][0] * alpha, v1 = b1 + acc[ai][bj][m][1] * alpha;
                    u32x4 w; w.x = cvt_pk_bf16(v0[0], v0[1]); w.y = cvt_pk_bf16(v0[2], v0[3]); w.z = cvt_pk_bf16(v1[0], v1[1]); w.w = cvt_pk_bf16(v1[2], v1[3]);
                    *(u32x4*)(outb + off + bj * HALF) = w;
                    { const float r0 = bf_lo(w.x), r1 = bf_hi(w.x), r2 = bf_lo(w.y), r3 = bf_hi(w.y), r4 = bf_lo(w.z), r5 = bf_hi(w.z), r6 = bf_lo(w.w), r7 = bf_hi(w.w);
                      sq += ((r0 * r0 + r1 * r1) + (r2 * r2 + r3 * r3)) + ((r4 * r4 + r5 * r5) + (r6 * r6 + r7 * r7)); } }
                if (ss) { sq += __shfl_xor(sq, 16); sq += __shfl_xor(sq, 32); if (fq == 0) ss[(size_t)(row0 + ai * HALF + m * 16) * 16 + u.pn * 4 + wc] = sq; } }
    }
};
struct EpiQKV {
    static constexpr bool PERM = true, AFTER_DRAIN = false;
    bf16_t* O; size_t tstride; float qscale;
    __device__ __forceinline__ void operator()(const f32x4 (&acc)[2][2][4][2], const Unit& u, int wr, int wc, int fr, int fq, int ui, PG8_LAS unsigned char* lds) const {
        const PG8_LAS float* rs = (const PG8_LAS float*)(lds + 131072);
        const int row0 = u.pm * BM + wr * 64 + fr; const int t = u.pn / 6, ct = u.pn - 6 * t, dsh = 2 * (ct >> 1);
        bf16_t* base = O + (size_t)t * tstride + wc * 32 + 8 * fq; const float sc0 = (t == 0) ? qscale : 1.0f;
#pragma unroll
        for (int ai = 0; ai < 2; ++ai)
#pragma unroll
            for (int m = 0; m < 4; ++m) { const int row = row0 + ai * HALF + m * 16, b = row >> 12, s = row & 4095;
                const int pos = ((s & ((1 << dsh) - 1)) << (12 - dsh)) + (s >> dsh);
                const float sc = sc0 * rs[ui * 256 + ai * HALF + wr * 64 + m * 16 + fr];
#pragma unroll
                for (int bj = 0; bj < 2; ++bj) { const f32x4 v0 = acc[ai][bj][m][0] * sc, v1 = acc[ai][bj][m][1] * sc;
                    u32x4 w; w.x = cvt_pk_bf16(v0[0], v0[1]); w.y = cvt_pk_bf16(v0[2], v0[3]); w.z = cvt_pk_bf16(v1[0], v1[1]); w.w = cvt_pk_bf16(v1[2], v1[3]);
                    *(u32x4*)(base + ((size_t)((b * 12 + 2 * ct + bj) * 4096 + pos)) * 128) = w; } }
    }
};
struct EpiSig {
    static constexpr bool PERM = true, AFTER_DRAIN = false;
    bf16_t* O; int ldo;
    __device__ __forceinline__ void operator()(const f32x4 (&acc)[2][2][4][2], const Unit& u, int wr, int wc, int fr, int fq, int ui, PG8_LAS unsigned char* lds) const {
        const PG8_LAS float* rs = (const PG8_LAS float*)(lds + 131072);
        const int row0 = u.pm * BM + wr * 64 + fr, col0 = u.pn * BM + wc * 32 + 8 * fq;
#pragma unroll
        for (int ai = 0; ai < 2; ++ai)
#pragma unroll
            for (int m = 0; m < 4; ++m) { bf16_t* rowp = O + (size_t)(row0 + ai * HALF + m * 16) * ldo + col0; const float rsv = rs[ui * 256 + ai * HALF + wr * 64 + m * 16 + fr];
#pragma unroll
                for (int bj = 0; bj < 2; ++bj) { float v[8];
#pragma unroll
                    for (int n = 0; n < 2; ++n)
#pragma unroll
                        for (int i = 0; i < 4; ++i) v[n * 4 + i] = sigmoid_f(acc[ai][bj][m][n][i] * rsv);
                    u32x4 w; w.x = cvt_pk_bf16(v[0], v[1]); w.y = cvt_pk_bf16(v[2], v[3]); w.z = cvt_pk_bf16(v[4], v[5]); w.w = cvt_pk_bf16(v[6], v[7]);
                    *(u32x4*)(rowp + bj * HALF) = w; } }
    }
};
template <bool HAS_BASE> struct EpiGate {
    static constexpr bool PERM = true, AFTER_DRAIN = false;
    const bf16_t* base; const bf16_t* gate; int ldg; bf16_t* O;
    __device__ __forceinline__ void operator()(const f32x4 (&acc)[2][2][4][2], const Unit& u, int wr, int wc, int fr, int fq, int, PG8_LAS unsigned char*) const {
        const int row0 = u.pm * BM + wr * 64 + fr, col0 = u.pn * BM + wc * 32 + 8 * fq;
#pragma unroll
        for (int ai = 0; ai < 2; ++ai)
#pragma unroll
            for (int m = 0; m < 4; ++m) { const size_t r = (size_t)(row0 + ai * HALF + m * 16);
#pragma unroll
                for (int bj = 0; bj < 2; ++bj) {
                    const u32x4 gv = *(const u32x4*)(gate + r * ldg + col0 + bj * HALF);
                    u32x4 bv = (u32x4){0u, 0u, 0u, 0u}; if (HAS_BASE) bv = *(const u32x4*)(base + r * 1024 + col0 + bj * HALF);
                    const f32x4 a0 = acc[ai][bj][m][0], a1 = acc[ai][bj][m][1];
                    float v[8];
                    v[0] = bf_lo(bv.x) + bf_lo(gv.x) * a0[0]; v[1] = bf_hi(bv.x) + bf_hi(gv.x) * a0[1];
                    v[2] = bf_lo(bv.y) + bf_lo(gv.y) * a0[2]; v[3] = bf_hi(bv.y) + bf_hi(gv.y) * a0[3];
                    v[4] = bf_lo(bv.z) + bf_lo(gv.z) * a1[0]; v[5] = bf_hi(bv.z) + bf_hi(gv.z) * a1[1];
                    v[6] = bf_lo(bv.w) + bf_lo(gv.w) * a1[2]; v[7] = bf_hi(bv.w) + bf_hi(gv.w) * a1[3];
                    u32x4 w; w.x = cvt_pk_bf16(v[0], v[1]); w.y = cvt_pk_bf16(v[2], v[3]); w.z = cvt_pk_bf16(v[4], v[5]); w.w = cvt_pk_bf16(v[6], v[7]);
                    *(u32x4*)(O + r * 1024 + col0 + bj * HALF) = w; } }
    }
};

template <class Epi, class Sched, bool ALIGN_EPI = false, bool SP2 = false>
__device__ __forceinline__ void gemm_phase(PG8_LAS unsigned char* lds, const Gemm g, const Sched& S, const Epi& E) {
    const int tid = threadIdx.x, wid = __builtin_amdgcn_readfirstlane(tid >> 6), lane = tid & 63, wr = wid >> 2, wc = wid & 3, fr = lane & 15, fq = lane >> 4;
    const int K = g.K, nt = K / BK;
    unsigned voffA[2], voffB[2];
#pragma unroll
    for (int i = 0; i < 2; ++i) { int R, C; stage_rc(tid * 16 + i * 8192, R, C); const int Rb = Epi::PERM ? ((R & ~31) + perm32(R & 31)) : R;
        voffA[i] = (unsigned)(R * K + C) * 2u; voffB[i] = (unsigned)(Rb * K + C) * 2u; }
    const size_t kstep = (size_t)(BK * 2);
    const size_t hstep = (size_t)HALF * K * 2;
    const size_t tstep = 2 * hstep;
    const unsigned ldsw = (unsigned)wid * 1024u;
    const int aoff = lds_byte(wr * 64 + fr, fq * 8), boff = lds_byte(wc * 32 + fr, fq * 8);
#define PG8_SA(b, h) (((b) * 2 + (h)) * HTB)
#define PG8_SB(b, h) ((4 + (b) * 2 + (h)) * HTB)
#define PG8_STAGE(bufoff, gbase, voff) do { _Pragma("unroll") for (int _i = 0; _i < 2; ++_i) \
        __builtin_amdgcn_global_load_lds((const unsigned*)((const char*)(gbase) + (voff)[_i]), (PG8_LAS unsigned*)(lds + (bufoff) + ldsw + _i * 8192), 16, 0, 0); } while (0)
#define PG8_LDA(dst, b, h) do { _Pragma("unroll") for (int m = 0; m < 4; ++m) _Pragma("unroll") for (int k = 0; k < 2; ++k) dst[m][k] = *(const PG8_LAS bf16x8*)(lds + PG8_SA(b, h) + aoff + m * 2048 + k * 1024); } while (0)
#define PG8_LDB(dst, b, h) do { _Pragma("unroll") for (int n = 0; n < 2; ++n) _Pragma("unroll") for (int k = 0; k < 2; ++k) dst[n][k] = *(const PG8_LAS bf16x8*)(lds + PG8_SB(b, h) + boff + n * 2048 + k * 1024); } while (0)
#define PG8_MMA(ai, bj, At, Bt) do { __builtin_amdgcn_s_setprio(1); _Pragma("unroll") for (int m = 0; m < 4; ++m) _Pragma("unroll") for (int n = 0; n < 2; ++n) _Pragma("unroll") for (int k = 0; k < 2; ++k) \
        acc[ai][bj][m][n] = __builtin_amdgcn_mfma_f32_16x16x32_bf16(Bt[n][k], At[m][k], acc[ai][bj][m][n], 0, 0, 0); __builtin_amdgcn_s_setprio(0); } while (0)
#define PG8_WAIT_V(n) asm volatile("s_waitcnt vmcnt(" #n ")" ::: "memory")
#define PG8_WAIT_L(n) asm volatile("s_waitcnt lgkmcnt(" #n ")" ::: "memory")
#define PG8_BAR __builtin_amdgcn_s_barrier()
#define PG8_SCHED __builtin_amdgcn_sched_barrier(0)
    Unit cur, nxt; int ui = 0;
    if (!S.next(0, cur)) return;
    f32x4 acc[2][2][4][2];
#pragma unroll
    for (int a = 0; a < 2; ++a)
#pragma unroll
        for (int b = 0; b < 2; ++b)
#pragma unroll
            for (int m = 0; m < 4; ++m)
#pragma unroll
                for (int n = 0; n < 2; ++n) acc[a][b][m][n] = (f32x4){0.f, 0.f, 0.f, 0.f};
    bf16x8 At[4][2], B0[2][2], B1[2][2];
    const char* cA = (const char*)g.A + (size_t)cur.pm * tstep; const char* cB = (const char*)g.Bt + (size_t)cur.pn * tstep;
    S.a_ready(cur);
    if constexpr (SP2) {
        PG8_STAGE(PG8_SB(0, 0), cB, voffB); PG8_STAGE(PG8_SB(0, 1), cB + hstep, voffB); PG8_STAGE(PG8_SA(0, 0), cA, voffA); PG8_STAGE(PG8_SA(0, 1), cA + hstep, voffA);
        if (wr == 1) PG8_BAR;
        PG8_WAIT_V(2); PG8_BAR;
        PG8_STAGE(PG8_SB(1, 0), cB + kstep, voffB); PG8_STAGE(PG8_SA(1, 0), cA + kstep, voffA); PG8_STAGE(PG8_SB(1, 1), cB + hstep + kstep, voffB);
        PG8_WAIT_V(6); PG8_BAR;
    } else {
        PG8_STAGE(PG8_SB(0, 0), cB, voffB); PG8_STAGE(PG8_SA(0, 0), cA, voffA); PG8_STAGE(PG8_SB(0, 1), cB + hstep, voffB); PG8_STAGE(PG8_SA(0, 1), cA + hstep, voffA);
        if (wr == 1) PG8_BAR;
        PG8_WAIT_V(4); PG8_BAR;
        PG8_STAGE(PG8_SB(1, 0), cB + kstep, voffB); PG8_STAGE(PG8_SA(1, 0), cA + kstep, voffA); PG8_STAGE(PG8_SB(1, 1), cB + hstep + kstep, voffB);
        PG8_WAIT_V(6); PG8_BAR;
    }
    for (;;) {
        const bool has_next = S.next(ui + 1, nxt);
        const char* nA = has_next ? (const char*)g.A + (size_t)nxt.pm * tstep : cA; const char* nB = has_next ? (const char*)g.Bt + (size_t)nxt.pn * tstep : cB;
        for (int t = 0; t < nt; t += 2) {
            const bool last = (t == nt - 2);
            const char* a1 = cA + (size_t)(t + 1) * kstep;
            const char* a2 = last ? nA : cA + (size_t)(t + 2) * kstep; const char* b2 = last ? nB : cB + (size_t)(t + 2) * kstep;
            const char* a3 = a2 + kstep; const char* b3 = b2 + kstep;
            if (last && has_next) S.a_ready(nxt);
            if constexpr (SP2) {
            PG8_LDB(B0, 0, 0); PG8_LDB(B1, 0, 1); PG8_SCHED; PG8_LDA(At, 0, 0); PG8_STAGE(PG8_SA(1, 1), a1 + hstep, voffA);
            PG8_WAIT_V(8); PG8_WAIT_L(0); PG8_BAR; PG8_MMA(0, 0, At, B0); PG8_MMA(0, 1, At, B1); PG8_BAR; PG8_SCHED;
            PG8_LDA(At, 0, 1); PG8_STAGE(PG8_SB(0, 0), b2, voffB); PG8_STAGE(PG8_SB(0, 1), b2 + hstep, voffB); PG8_STAGE(PG8_SA(0, 0), a2, voffA);
            PG8_WAIT_V(8); PG8_WAIT_L(0); PG8_BAR; PG8_MMA(1, 0, At, B0); PG8_MMA(1, 1, At, B1); PG8_BAR; PG8_SCHED;
            PG8_LDB(B0, 1, 0); PG8_LDB(B1, 1, 1); PG8_SCHED; PG8_LDA(At, 1, 0); PG8_STAGE(PG8_SA(0, 1), a2 + hstep, voffA);
            PG8_WAIT_V(8); PG8_WAIT_L(0); PG8_BAR; PG8_MMA(0, 0, At, B0); PG8_MMA(0, 1, At, B1); PG8_BAR; PG8_SCHED;
            PG8_LDA(At, 1, 1); PG8_STAGE(PG8_SB(1, 0), b3, voffB); PG8_STAGE(PG8_SB(1, 1), b3 + hstep, voffB); PG8_STAGE(PG8_SA(1, 0), a3, voffA);
            PG8_WAIT_V(8); PG8_WAIT_L(0); PG8_BAR; PG8_MMA(1, 0, At, B0); PG8_MMA(1, 1, At, B1); PG8_BAR; PG8_SCHED;
            } else {
            PG8_LDB(B0, 0, 0); PG8_SCHED; PG8_LDA(At, 0, 0); PG8_STAGE(PG8_SA(1, 1), a1 + hstep, voffA);
            PG8_WAIT_L(8); PG8_BAR; PG8_WAIT_L(0); PG8_MMA(0, 0, At, B0); PG8_BAR; PG8_SCHED;
            PG8_LDB(B1, 0, 1); PG8_STAGE(PG8_SB(0, 0), b2, voffB);
            PG8_BAR; PG8_WAIT_L(0); PG8_MMA(0, 1, At, B1); PG8_BAR;
            PG8_LDA(At, 0, 1); PG8_STAGE(PG8_SA(0, 0), a2, voffA);
            PG8_BAR; PG8_WAIT_L(0); PG8_MMA(1, 0, At, B0); PG8_BAR; PG8_SCHED;
            PG8_STAGE(PG8_SB(0, 1), b2 + hstep, voffB);
            PG8_WAIT_V(6); PG8_BAR; PG8_MMA(1, 1, At, B1); PG8_BAR;
            PG8_LDB(B0, 1, 0); PG8_SCHED; PG8_LDA(At, 1, 0); PG8_STAGE(PG8_SA(0, 1), a2 + hstep, voffA);
            PG8_WAIT_L(8); PG8_BAR; PG8_WAIT_L(0); PG8_MMA(0, 0, At, B0); PG8_BAR; PG8_SCHED;
            PG8_LDB(B1, 1, 1); PG8_STAGE(PG8_SB(1, 0), b3, voffB);
            PG8_BAR; PG8_WAIT_L(0); PG8_MMA(0, 1, At, B1); PG8_BAR;
            PG8_LDA(At, 1, 1); PG8_STAGE(PG8_SA(1, 0), a3, voffA);
            PG8_BAR; PG8_WAIT_L(0); PG8_MMA(1, 0, At, B0); PG8_BAR; PG8_SCHED;
            PG8_STAGE(PG8_SB(1, 1), b3 + hstep, voffB);
            PG8_WAIT_V(6); PG8_BAR; PG8_MMA(1, 1, At, B1); PG8_BAR;
            }
        }
        if constexpr (ALIGN_EPI) { if (wr == 0) PG8_BAR; }
        if constexpr (!Epi::AFTER_DRAIN) { E(acc, cur, wr, wc, fr, fq, ui, lds); S.done(cur); }
        if (!has_next) break;
#pragma unroll
        for (int a = 0; a < 2; ++a)
#pragma unroll
            for (int b = 0; b < 2; ++b)
#pragma unroll
                for (int m = 0; m < 4; ++m)
#pragma unroll
                    for (int n = 0; n < 2; ++n) acc[a][b][m][n] = (f32x4){0.f, 0.f, 0.f, 0.f};
        cur = nxt; cA = nA; cB = nB; ++ui;
        if constexpr (ALIGN_EPI) { if (wr == 1) PG8_BAR; }
    }
    PG8_WAIT_V(0);
    if constexpr (!ALIGN_EPI) { if (wr == 0) PG8_BAR; }
    PG8_BAR;
    if constexpr (Epi::AFTER_DRAIN) { E.fused(acc, cur, wr, wc, fr, fq, lds, wid, lane); S.done(cur); }
#undef PG8_SA
#undef PG8_SB
#undef PG8_STAGE
#undef PG8_LDA
#undef PG8_LDB
#undef PG8_MMA
#undef PG8_WAIT_V
#undef PG8_WAIT_L
#undef PG8_BAR
#undef PG8_SCHED
}
}

#include <hip/hip_cooperative_groups.h>
namespace cg = cooperative_groups;
using pg8::sigmoid_f; using pg8::bf_lo; using pg8::bf_hi;
#define LAS __attribute__((address_space(3)))
typedef unsigned short bf16;
typedef unsigned v4u __attribute__((ext_vector_type(4)));
typedef unsigned v2u __attribute__((ext_vector_type(2)));
typedef float f32x4 __attribute__((ext_vector_type(4)));
typedef float f32x2 __attribute__((ext_vector_type(2)));
typedef short bf16x8 __attribute__((ext_vector_type(8)));
typedef short v4i16_t __attribute__((ext_vector_type(4)));

constexpr int NWAVES = 8, NTHREADS = 512;
constexpr int SEQ = 4096, BATCH = 8, M = BATCH * SEQ, D = 1024, FF = 2816, NIN = 8704, AW = 1536, CW = 31;
constexpr float EPS = 1e-6f;
constexpr size_t MiB = 1u << 20;
constexpr size_t WS_CTL = 0;
constexpr size_t WS_SS = 256 * 1024;
constexpr size_t WS_WGU1 = 1 * MiB, WS_WD1 = 12 * MiB, WS_WGU2 = 18 * MiB, WS_WD2 = 29 * MiB, WS_WIN = 35 * MiB, WS_WC = 52 * MiB, WS_WA = 54 * MiB, WS_WO = 55 * MiB;
constexpr size_t WS_H = 58 * MiB;
constexpr size_t WS_ZC = 122 * MiB;
constexpr size_t WS_Q = 186 * MiB;
constexpr size_t WS_K = 282 * MiB;
constexpr size_t WS_V = 378 * MiB;
constexpr size_t WS_LSE = 474 * MiB;
constexpr size_t WS_ATT = 476 * MiB;
constexpr size_t WS_ZG = WS_K;
constexpr size_t WS_G = WS_K;
constexpr size_t WS_T1 = WS_K + 128 * MiB;
constexpr size_t WS_MIX = WS_H;
constexpr size_t WS_A1 = WS_Q;
constexpr size_t WS_SSP = 508 * MiB;
constexpr size_t WS_END = 512 * MiB;
static_assert(WS_T1 + 64 * MiB <= WS_LSE && WS_A1 + (size_t)M * FF * 2 <= WS_LSE, "ws map");

constexpr int LDS_BYTES = 147456;

__device__ __forceinline__ float wave_sum(float v) {
#pragma unroll
    for (int o = 1; o < 64; o <<= 1) v += __shfl_xor(v, o);
    return v;
}
__device__ __forceinline__ unsigned pk2(float lo, float hi) { return pg8::cvt_pk_bf16(lo, hi); }

__device__ __forceinline__ int dst_row(int map, int n) {
    if (map == 3) { if (n < 1024) map = 1; else if (n < 2048) { map = 2; n -= 1024; } else map = 0; }
    if (map == 0) return n;
    return 256 * (n >> 7) + (n & 127) + (map == 2 ? 128 : 0);
}
__device__ __forceinline__ void transpose_item(const float* W, int K, int N, bf16* WT, int map, LAS float* scr, int item, int lane, const float* gain = nullptr) {
    const int nblk = N / 32, kb = item / nblk, nb = item % nblk, k0 = 64 * kb, n0 = 32 * nb;
    float wv[32];
#pragma unroll
    for (int i = 0; i < 32; ++i) wv[i] = W[(size_t)(k0 + 2 * i + (lane >> 5)) * N + n0 + (lane & 31)];
#pragma unroll
    for (int i = 0; i < 32; ++i) scr[(2 * i + (lane >> 5)) * 33 + (lane & 31)] = wv[i] * (gain ? gain[k0 + 2 * i + (lane >> 5)] : 1.0f);
    asm volatile("s_waitcnt lgkmcnt(0)" ::: "memory");
    const int c = lane & 7; const int r0 = dst_row(map, n0);
#pragma unroll
    for (int j = 0; j < 4; ++j) { const int n = (lane >> 3) + 8 * j; const LAS float* s = scr + (8 * c) * 33 + n;
        v4u o; o.x = pk2(s[0 * 33], s[1 * 33]); o.y = pk2(s[2 * 33], s[3 * 33]); o.z = pk2(s[4 * 33], s[5 * 33]); o.w = pk2(s[6 * 33], s[7 * 33]);
        *(v4u*)(WT + (size_t)(r0 + n) * K + k0 + 8 * c) = o; }
    asm volatile("s_waitcnt lgkmcnt(0)" ::: "memory");
}

template <bool OUT_BF16> __device__ __forceinline__ void rms_rows(const float* X, const float* gain, void* out, int gw, int NGW, int lane) {
    f32x4 gv[4];
#pragma unroll
    for (int j = 0; j < 4; ++j) gv[j] = ((const f32x4*)gain)[lane + 64 * j];
    for (int m0 = gw * 4; m0 < M; m0 += NGW * 4) {
        f32x4 v[4][4]; float s[4];
#pragma unroll
        for (int r = 0; r < 4; ++r) { const f32x4* xr = (const f32x4*)(X + (size_t)(m0 + r) * D) + lane;
#pragma unroll
            for (int j = 0; j < 4; ++j) v[r][j] = xr[64 * j]; }
#pragma unroll
        for (int r = 0; r < 4; ++r) { float a = 0.f;
#pragma unroll
            for (int j = 0; j < 4; ++j) a += (v[r][j].x * v[r][j].x + v[r][j].y * v[r][j].y) + (v[r][j].z * v[r][j].z + v[r][j].w * v[r][j].w);
            s[r] = a; }
#pragma unroll
        for (int o = 1; o < 64; o <<= 1) {
#pragma unroll
            for (int r = 0; r < 4; ++r) s[r] += __shfl_xor(s[r], o); }
#pragma unroll
        for (int r = 0; r < 4; ++r) { const float rstd = 1.0f / sqrtf(s[r] * (1.0f / D) + EPS);
            if (OUT_BF16) { v2u* o8 = (v2u*)((bf16*)out + (size_t)(m0 + r) * D) + lane;
#pragma unroll
                for (int j = 0; j < 4; ++j) { v2u w; w.x = pk2(v[r][j].x * rstd * gv[j].x, v[r][j].y * rstd * gv[j].y); w.y = pk2(v[r][j].z * rstd * gv[j].z, v[r][j].w * rstd * gv[j].w); o8[64 * j] = w; }
            } else { f32x4* o = (f32x4*)((float*)out + (size_t)(m0 + r) * D) + lane;
#pragma unroll
                for (int j = 0; j < 4; ++j) o[64 * j] = v[r][j] * rstd * gv[j]; } }
    }
}

__device__ __forceinline__ void rms_rows_bb(const bf16* Xb, const float* gain, bf16* out, int gw, int NGW, int lane) {
    f32x4 gv[4];
#pragma unroll
    for (int j = 0; j < 4; ++j) gv[j] = ((const f32x4*)gain)[lane + 64 * j];
    for (int m0 = gw * 4; m0 < M; m0 += NGW * 4) {
        v2u raw[4][4]; f32x4 v[4][4]; float s[4];
#pragma unroll
        for (int r = 0; r < 4; ++r) { const v2u* xr = (const v2u*)(Xb + (size_t)(m0 + r) * D) + lane;
#pragma unroll
            for (int j = 0; j < 4; ++j) raw[r][j] = xr[64 * j]; }
#pragma unroll
        for (int r = 0; r < 4; ++r) { float a = 0.f;
#pragma unroll
            for (int j = 0; j < 4; ++j) { v[r][j] = (f32x4){bf_lo(raw[r][j].x), bf_hi(raw[r][j].x), bf_lo(raw[r][j].y), bf_hi(raw[r][j].y)};
                a += (v[r][j].x * v[r][j].x + v[r][j].y * v[r][j].y) + (v[r][j].z * v[r][j].z + v[r][j].w * v[r][j].w); }
            s[r] = a; }
#pragma unroll
        for (int o = 1; o < 64; o <<= 1) {
#pragma unroll
            for (int r = 0; r < 4; ++r) s[r] += __shfl_xor(s[r], o); }
#pragma unroll
        for (int r = 0; r < 4; ++r) { const float rstd = 1.0f / sqrtf(s[r] * (1.0f / D) + EPS); v2u* o8 = (v2u*)(out + (size_t)(m0 + r) * D) + lane;
#pragma unroll
            for (int j = 0; j < 4; ++j) { v2u w; w.x = pk2(v[r][j].x * rstd * gv[j].x, v[r][j].y * rstd * gv[j].y); w.y = pk2(v[r][j].z * rstd * gv[j].z, v[r][j].w * rstd * gv[j].w); o8[64 * j] = w; } }
    }
}

__device__ __forceinline__ void rms_rows_b(const bf16* Xb, const float* gain, float* out, int gw, int NGW, int lane) {
    f32x4 gv[4];
#pragma unroll
    for (int j = 0; j < 4; ++j) gv[j] = ((const f32x4*)gain)[lane + 64 * j];
    for (int m0 = gw * 4; m0 < M; m0 += NGW * 4) {
        v2u raw[4][4]; f32x4 v[4][4]; float s[4];
#pragma unroll
        for (int r = 0; r < 4; ++r) { const v2u* xr = (const v2u*)(Xb + (size_t)(m0 + r) * D) + lane;
#pragma unroll
            for (int j = 0; j < 4; ++j) raw[r][j] = xr[64 * j]; }
#pragma unroll
        for (int r = 0; r < 4; ++r) { float a = 0.f;
#pragma unroll
            for (int j = 0; j < 4; ++j) { v[r][j] = (f32x4){bf_lo(raw[r][j].x), bf_hi(raw[r][j].x), bf_lo(raw[r][j].y), bf_hi(raw[r][j].y)};
                a += (v[r][j].x * v[r][j].x + v[r][j].y * v[r][j].y) + (v[r][j].z * v[r][j].z + v[r][j].w * v[r][j].w); }
            s[r] = a; }
#pragma unroll
        for (int o = 1; o < 64; o <<= 1) {
#pragma unroll
            for (int r = 0; r < 4; ++r) s[r] += __shfl_xor(s[r], o); }
#pragma unroll
        for (int r = 0; r < 4; ++r) { const float rstd = 1.0f / sqrtf(s[r] * (1.0f / D) + EPS); f32x4* o = (f32x4*)(out + (size_t)(m0 + r) * D) + lane;
#pragma unroll
            for (int j = 0; j < 4; ++j) o[64 * j] = v[r][j] * rstd * gv[j]; }
    }
}

__device__ __forceinline__ void raw_rows(const float* X, bf16* out, float* ss, int gw, int NGW, int lane) {
    for (int m0 = gw * 4; m0 < M; m0 += NGW * 4) {
        f32x4 v[4][4]; float s[4];
#pragma unroll
        for (int r = 0; r < 4; ++r) { const f32x4* xr = (const f32x4*)(X + (size_t)(m0 + r) * D) + lane;
#pragma unroll
            for (int j = 0; j < 4; ++j) v[r][j] = xr[64 * j]; }
#pragma unroll
        for (int r = 0; r < 4; ++r) { float a = 0.f;
#pragma unroll
            for (int j = 0; j < 4; ++j) a += (v[r][j].x * v[r][j].x + v[r][j].y * v[r][j].y) + (v[r][j].z * v[r][j].z + v[r][j].w * v[r][j].w);
            s[r] = a; }
#pragma unroll
        for (int o = 1; o < 64; o <<= 1) {
#pragma unroll
            for (int r = 0; r < 4; ++r) s[r] += __shfl_xor(s[r], o); }
#pragma unroll
        for (int r = 0; r < 4; ++r) { if (lane == 0) ss[m0 + r] = s[r];
            v2u* o8 = (v2u*)(out + (size_t)(m0 + r) * D) + lane;
#pragma unroll
            for (int j = 0; j < 4; ++j) { v2u w; w.x = pk2(v[r][j].x, v[r][j].y); w.y = pk2(v[r][j].z, v[r][j].w); o8[64 * j] = w; } }
    }
}

constexpr int CT = 16;
__device__ __forceinline__ void conv_phase(const bf16* Zg, const float* dwk, const float* dwb, const float* lng, const float* lnb, bf16* ZC, LAS float* red, int vcu, int G) {
    const int tid = threadIdx.x, lane = tid & 63, wave = tid >> 6, c = 2 * tid;
    float w0[CW], w1[CW];
#pragma unroll
    for (int j = 0; j < CW; ++j) { const f32x2 t = *(const f32x2*)(dwk + j * D + c); w0[j] = t.x; w1[j] = t.y; }
    const f32x2 bb = *(const f32x2*)(dwb + c), gg = *(const f32x2*)(lng + c), lb = *(const f32x2*)(lnb + c);
    constexpr int NT = M / CT; const int tpb = (NT + G - 1) / G; const int tb = vcu * tpb; int te = tb + tpb; if (te > NT) te = NT;
    if (tb >= te) return;
    float z0[CT + CW - 1], z1[CT + CW - 1]; unsigned nx[CT];
    { const int t0 = tb * CT, s0 = t0 & (SEQ - 1);
#pragma unroll
        for (int i = 0; i < CT + CW - 1; ++i) { const bool valid = (s0 + i - (CW - 1)) >= 0; unsigned pk = 0u;
            if (valid) pk = *(const unsigned*)(Zg + (size_t)(t0 + i - (CW - 1)) * D + c);
            z0[i] = bf_lo(pk); z1[i] = bf_hi(pk); } }
    for (int tile = tb; tile < te; ++tile) {
        const int t0 = tile * CT; const bool more = (tile + 1 < te); LAS float* redp = red + ((tile & 1) << 8);
        if (more) {
#pragma unroll
            for (int i = 0; i < CT; ++i) nx[i] = *(const unsigned*)(Zg + (size_t)(t0 + CT + i) * D + c); }
        float o0[CT], o1[CT];
#pragma unroll
        for (int t = 0; t < CT; ++t) { o0[t] = bb.x; o1[t] = bb.y; }
#pragma unroll
        for (int j = 0; j < CW; ++j) {
#pragma unroll
            for (int t = 0; t < CT; ++t) { o0[t] += w0[j] * z0[t + j]; o1[t] += w1[j] * z1[t + j]; } }
        { const bool fresh = (((t0 + CT) & (SEQ - 1)) == 0);
#pragma unroll
            for (int i = 0; i < CW - 1; ++i) { z0[i] = fresh ? 0.f : z0[i + CT]; z1[i] = fresh ? 0.f : z1[i + CT]; } }
        { float k32[2 * CT];
#pragma unroll
            for (int t = 0; t < CT; ++t) { k32[2 * t] = o0[t] + o1[t]; k32[2 * t + 1] = o0[t] * o0[t] + o1[t] * o1[t]; }
            float k16[16], k8[8], k4[4], k2[2];
            const bool b5 = (lane & 32) != 0, b4 = (lane & 16) != 0, b3 = (lane & 8) != 0, b2 = (lane & 4) != 0, b1 = (lane & 2) != 0;
#pragma unroll
            for (int k = 0; k < 16; ++k) { const float send = b5 ? k32[k] : k32[16 + k], mine = b5 ? k32[16 + k] : k32[k]; k16[k] = mine + __shfl_xor(send, 32); }
#pragma unroll
            for (int k = 0; k < 8; ++k) { const float send = b4 ? k16[k] : k16[8 + k], mine = b4 ? k16[8 + k] : k16[k]; k8[k] = mine + __shfl_xor(send, 16); }
#pragma unroll
            for (int k = 0; k < 4; ++k) { const float send = b3 ? k8[k] : k8[4 + k], mine = b3 ? k8[4 + k] : k8[k]; k4[k] = mine + __shfl_xor(send, 8); }
#pragma unroll
            for (int k = 0; k < 2; ++k) { const float send = b2 ? k4[k] : k4[2 + k], mine = b2 ? k4[2 + k] : k4[k]; k2[k] = mine + __shfl_xor(send, 4); }
            const float send1 = b1 ? k2[0] : k2[1], mine1 = b1 ? k2[1] : k2[0]; float tot = mine1 + __shfl_xor(send1, 2);
            tot += __shfl_xor(tot, 1);
            if ((lane & 1) == 0) redp[(lane >> 1) * 8 + wave] = tot; }
        __syncthreads();
        float mu_l, rs_l;
        { const int tl = lane & 15;
            const f32x4 a = *(const LAS f32x4*)(redp + (2 * tl) * 8), b = *(const LAS f32x4*)(redp + (2 * tl) * 8 + 4);
            const f32x4 p = *(const LAS f32x4*)(redp + (2 * tl + 1) * 8), q = *(const LAS f32x4*)(redp + (2 * tl + 1) * 8 + 4);
            const float s1 = ((a.x + a.y) + (a.z + a.w)) + ((b.x + b.y) + (b.z + b.w)), s2 = ((p.x + p.y) + (p.z + p.w)) + ((q.x + q.y) + (q.z + q.w));
            mu_l = s1 * (1.0f / D); const float var = fmaxf(s2 * (1.0f / D) - mu_l * mu_l, 0.f); rs_l = 1.0f / sqrtf(var + EPS); }
        unsigned* outp = (unsigned*)(ZC + (size_t)t0 * D + c);
#pragma unroll
        for (int t = 0; t < CT; ++t) { const float mu = __int_as_float(__builtin_amdgcn_readlane(__float_as_int(mu_l), t)), rstd = __int_as_float(__builtin_amdgcn_readlane(__float_as_int(rs_l), t));
            float y0 = (o0[t] - mu) * rstd * gg.x + lb.x, y1 = (o1[t] - mu) * rstd * gg.y + lb.y;
            y0 = y0 * sigmoid_f(y0); y1 = y1 * sigmoid_f(y1);
            outp[(size_t)t * (D / 2)] = pk2(y0, y1); }
        if (more) {
#pragma unroll
            for (int i = 0; i < CT; ++i) { z0[CW - 1 + i] = bf_lo(nx[i]); z1[CW - 1 + i] = bf_hi(nx[i]); } }
    }
    __syncthreads();
}

constexpr int VROW = 272;
constexpr int ATT_UNITS = BATCH * 12 * 32;
__device__ __forceinline__ v4i16_t tr16(const LAS unsigned char* p) { return __builtin_amdgcn_ds_read_tr16_b64_v4i16((LAS v4i16_t*)p); }
struct AttnPre { v4u k[4], v[4]; bf16x8 q[4]; };
struct AttnIdx { size_t row0; int hg, dsh, n; };
__device__ __forceinline__ AttnIdx attn_decode(int unit) {
    AttnIdx x; const int bh = unit >> 5, j = unit & 31; x.hg = bh % 12; const int gi = x.hg >> 2;
    x.dsh = 2 * gi; const int nbsh = 5 - x.dsh;
    x.n = j & ((1 << nbsh) - 1);
    x.row0 = (size_t)bh * SEQ + (size_t)j * 128; return x;
}
constexpr int ATT_HB = 128 * VROW;
constexpr int ATT_KOFF = 0, ATT_VOFF = 2 * ATT_HB;
__device__ __forceinline__ void attn_load_kv(AttnPre& p, const bf16* K, const bf16* V, size_t r0, int tid) {
#pragma unroll
    for (int i = 0; i < 4; ++i) { const size_t off = r0 * 128 + (size_t)(tid + 512 * i) * 8; p.k[i] = *(const v4u*)(K + off); p.v[i] = *(const v4u*)(V + off); }
}
__device__ __forceinline__ void attn_load(AttnPre& p, const bf16* Q, const bf16* K, const bf16* V, int unit, int tid, int w, int lq, int g) {
    const AttnIdx x = attn_decode(unit);
    attn_load_kv(p, K, V, x.row0, tid);
#pragma unroll
    for (int s = 0; s < 4; ++s) p.q[s] = *(const bf16x8*)(Q + (x.row0 + 16 * w + lq) * 128 + 32 * s + 8 * g);
}
__device__ __forceinline__ void attn_stage(LAS unsigned char* lds, const AttnPre& p, int half, int tid) {
#pragma unroll
    for (int i = 0; i < 4; ++i) { const int cidx = tid + 512 * i, row = cidx >> 4, ch = cidx & 15;
        *(LAS v4u*)(lds + ATT_KOFF + half * ATT_HB + row * VROW + ch * 16) = p.k[i]; *(LAS v4u*)(lds + ATT_VOFF + half * ATT_HB + row * VROW + ch * 16) = p.v[i]; }
}
__device__ __forceinline__ void attn_compute(LAS unsigned char* lds, const bf16x8 (&qf)[4], bf16* O, float* LSE, int unit, int f, int lane, int w, int lq, int g) {
    const AttnIdx x = attn_decode(unit); const int hg = x.hg, n = x.n;
    int rowT[9];
#pragma unroll
    for (int T = 0; T < 9; ++T) { const int kk0 = 16 * w + 16 * T; rowT[T] = ((((kk0 >> 7) ^ f) & 1) << 7) + (kk0 & 127); }
    f32x4 st[9];
    const LAS unsigned char* kb = lds + ATT_KOFF + lq * VROW + 16 * g;
#pragma unroll
    for (int T = 0; T < 9; ++T) { f32x4 a = (f32x4){0.f, 0.f, 0.f, 0.f}; const LAS unsigned char* kp = kb + rowT[T] * VROW;
#pragma unroll
        for (int s = 0; s < 4; ++s) { const bf16x8 kf = *(const LAS bf16x8*)(kp + 64 * s); a = __builtin_amdgcn_mfma_f32_16x16x32_bf16(kf, qf[s], a, 0, 0, 0); }
        st[T] = a; }
    const float slope2 = __builtin_amdgcn_exp2f(-(float)(8 * (hg + 1)) * (1.0f / 12.0f)) * (float)(1 << x.dsh) * 1.4426950408889634f;
    float mx = -__builtin_inff();
#pragma unroll
    for (int T = 0; T < 9; ++T)
#pragma unroll
        for (int reg = 0; reg < 4; ++reg) { const int steps = 128 + lq - 16 * T - 4 * g - reg, ki = 16 * w + 16 * T + 4 * g + reg;
            const bool valid = (steps >= 0) && (steps <= 128) && (n > 0 || ki >= 128);
            const float v = valid ? st[T][reg] - slope2 * (float)steps : -__builtin_inff(); st[T][reg] = v; mx = fmaxf(mx, v); }
    mx = fmaxf(mx, __shfl_xor(mx, 16)); mx = fmaxf(mx, __shfl_xor(mx, 32));
    float sum = 0.f;
#pragma unroll
    for (int T = 0; T < 9; ++T)
#pragma unroll
        for (int reg = 0; reg < 4; ++reg) { const float p = __builtin_amdgcn_exp2f(st[T][reg] - mx); st[T][reg] = p; sum += p; }
    sum += __shfl_xor(sum, 16); sum += __shfl_xor(sum, 32);
    bf16x8 pf[5];
#pragma unroll
    for (int u = 0; u < 5; ++u) { v4u t; t.x = pk2(st[2 * u][0], st[2 * u][1]); t.y = pk2(st[2 * u][2], st[2 * u][3]);
        if (u < 4) { t.z = pk2(st[2 * u + 1][0], st[2 * u + 1][1]); t.w = pk2(st[2 * u + 1][2], st[2 * u + 1][3]); } else { t.z = 0u; t.w = 0u; }
        pf[u] = __builtin_bit_cast(bf16x8, t); }
    const LAS unsigned char* vb = lds + ATT_VOFF + (4 * g + ((lane & 15) >> 2)) * VROW + (lane & 3) * 16;
    f32x4 o[4][2];
#pragma unroll
    for (int cp = 0; cp < 4; ++cp) { o[cp][0] = (f32x4){0.f, 0.f, 0.f, 0.f}; o[cp][1] = (f32x4){0.f, 0.f, 0.f, 0.f}; }
#pragma unroll
    for (int u = 0; u < 5; ++u) { const LAS unsigned char* vlo = vb + rowT[2 * u] * VROW; const LAS unsigned char* vhi = vb + rowT[u < 4 ? 2 * u + 1 : 8] * VROW;
#pragma unroll
        for (int cp = 0; cp < 4; ++cp)
#pragma unroll
            for (int h2 = 0; h2 < 2; ++h2) {
                const v4i16_t lo = tr16(vlo + cp * 64 + h2 * 8), hi = tr16(vhi + cp * 64 + h2 * 8);
                const bf16x8 vf = (bf16x8){lo[0], lo[1], lo[2], lo[3], hi[0], hi[1], hi[2], hi[3]};
                o[cp][h2] = __builtin_amdgcn_mfma_f32_16x16x32_bf16(vf, pf[u], o[cp][h2], 0, 0, 0); } }
    const float inv = 1.0f / sum;
    const size_t rq = x.row0 + 16 * w + lq;
    bf16* op = O + rq * 128 + 8 * g;
#pragma unroll
    for (int cp = 0; cp < 4; ++cp) { const f32x4 a = o[cp][0] * inv, c = o[cp][1] * inv;
        v4u t; t.x = pk2(a[0], a[1]); t.y = pk2(a[2], a[3]); t.z = pk2(c[0], c[1]); t.w = pk2(c[2], c[3]);
        *(v4u*)(op + 32 * cp) = t; }
    if (g == 0) LSE[rq] = mx + __builtin_amdgcn_logf(sum);
}
__device__ __forceinline__ void attn_phase(LAS unsigned char* lds, const bf16* Q, const bf16* K, const bf16* V, bf16* O, float* LSE, int vcu, int G) {
    const int tid = threadIdx.x, lane = tid & 63, w = __builtin_amdgcn_readfirstlane(tid >> 6), lq = lane & 15, g = lane >> 4;
    const int upb = (ATT_UNITS + G - 1) / G; const int u0 = vcu * upb; int u1 = u0 + upb; if (u1 > ATT_UNITS) u1 = ATT_UNITS;
    if (u0 >= u1) return;
    for (int i = tid; i < 4 * ATT_HB / 16; i += NTHREADS) ((LAS v4u*)lds)[i] = (v4u){0u, 0u, 0u, 0u};
    __syncthreads();
    AttnPre pre; int f = 0;
    { const AttnIdx x0 = attn_decode(u0); if (x0.n > 0) { attn_load_kv(pre, K, V, x0.row0 - 128, tid); attn_stage(lds, pre, f, tid); } }
    attn_load(pre, Q, K, V, u0, tid, w, lq, g);
    for (int u = u0; u < u1; ++u) {
        bf16x8 qf[4];
#pragma unroll
        for (int s = 0; s < 4; ++s) qf[s] = pre.q[s];
        attn_stage(lds, pre, f ^ 1, tid);
        __syncthreads();
        if (u + 1 < u1) attn_load(pre, Q, K, V, u + 1, tid, w, lq, g);
        attn_compute(lds, qf, O, LSE, u, f, lane, w, lq, g);
        __syncthreads();
        f ^= 1;
    }
}

__device__ __forceinline__ void merge_rows(const bf16* OG, const float* LSE, bf16* ATT, int gw, int NGW, int lane) {
    const int hh = lane >> 4, c0 = (lane & 15) * 8;
    for (int m0 = gw * 4; m0 < M; m0 += NGW * 4) {
        float l[4][3]; v4u a[4][3];
#pragma unroll
        for (int r = 0; r < 4; ++r) { const int m = m0 + r, b = m >> 12, s = m & 4095;
#pragma unroll
            for (int gi = 0; gi < 3; ++gi) { const int dsh = 2 * gi; const int pos = ((s & ((1 << dsh) - 1)) << (12 - dsh)) + (s >> dsh);
                const size_t row = (size_t)(b * 12 + gi * 4 + hh) * 4096 + pos; l[r][gi] = LSE[row]; a[r][gi] = *(const v4u*)(OG + row * 128 + c0); } }
#pragma unroll
        for (int r = 0; r < 4; ++r) {
            const float mx = fmaxf(l[r][0], fmaxf(l[r][1], l[r][2]));
            float e0 = __builtin_amdgcn_exp2f(l[r][0] - mx), e1 = __builtin_amdgcn_exp2f(l[r][1] - mx), e2 = __builtin_amdgcn_exp2f(l[r][2] - mx);
            const float inv = 1.0f / (e0 + e1 + e2); e0 *= inv; e1 *= inv; e2 *= inv;
            const v4u A = a[r][0], B = a[r][1], C = a[r][2]; v4u o;
            o.x = pk2(e0 * bf_lo(A.x) + e1 * bf_lo(B.x) + e2 * bf_lo(C.x), e0 * bf_hi(A.x) + e1 * bf_hi(B.x) + e2 * bf_hi(C.x));
            o.y = pk2(e0 * bf_lo(A.y) + e1 * bf_lo(B.y) + e2 * bf_lo(C.y), e0 * bf_hi(A.y) + e1 * bf_hi(B.y) + e2 * bf_hi(C.y));
            o.z = pk2(e0 * bf_lo(A.z) + e1 * bf_lo(B.z) + e2 * bf_lo(C.z), e0 * bf_hi(A.z) + e1 * bf_hi(B.z) + e2 * bf_hi(C.z));
            o.w = pk2(e0 * bf_lo(A.w) + e1 * bf_lo(B.w) + e2 * bf_lo(C.w), e0 * bf_hi(A.w) + e1 * bf_hi(B.w) + e2 * bf_hi(C.w));
            *(v4u*)(ATT + (size_t)(m0 + r) * 512 + hh * 128 + c0) = o; }
    }
}

#define XB_TMO      128
#define XB_XCNT(j)  (256  + 64 * (j))
#define XB_XSUB(j)  (1280 + 64 * (j))
#define XB_XGEN(j)  (2304 + 64 * (j))
#define XB_TOP      3328
#define XB_TOPGEN   3392
#define XCD_BAR_WORDS 3456
#define XB_SPIN_CAP (1u << 18)

__device__ __forceinline__ unsigned xb_ld(unsigned* p)              { return __hip_atomic_load(p, __ATOMIC_RELAXED, __HIP_MEMORY_SCOPE_AGENT); }
__device__ __forceinline__ unsigned xb_add(unsigned* p, unsigned v) { return __hip_atomic_fetch_add(p, v, __ATOMIC_RELAXED, __HIP_MEMORY_SCOPE_AGENT); }
__device__ __forceinline__ unsigned xb_xcc_id() { return (unsigned)__builtin_amdgcn_s_getreg((3 << 11) | 20) & 0xFu; }
#define XB_SPIN(cond, bar) do { unsigned _sp = 0; while (cond) { __builtin_amdgcn_s_sleep(1); \
    if ((++_sp & 255u) == 0u) { if (xb_ld(&(bar)[XB_TMO])) break; if (_sp > XB_SPIN_CAP) { atomicAdd(&(bar)[XB_TMO], 1u); break; } } } } while (0)

struct XcdBarrier {
    unsigned* bar; unsigned x;
    volatile LAS unsigned* st;
};

__device__ __forceinline__ XcdBarrier xcd_barrier_post(unsigned* bar, volatile LAS unsigned* st) {
    XcdBarrier b; b.bar = bar; b.x = xb_xcc_id(); b.st = st;
    if (threadIdx.x == 0) (void)xb_add(&bar[XB_XCNT(b.x)], 1u);
    return b;
}
__device__ __forceinline__ void xcd_barrier_complete(unsigned* bar, unsigned x, unsigned& nloc, unsigned& nx) {
    const unsigned G = gridDim.x * gridDim.y * gridDim.z;
    unsigned sum, cnt, mine, sp = 0u;
    for (;;) {
        sum = 0u; cnt = 0u; mine = 0u;
#pragma unroll
        for (unsigned j = 0; j < 16; ++j) { const unsigned c = xb_ld(&bar[XB_XCNT(j)]); sum += c; cnt += (c > 0u) ? 1u : 0u; mine = (j == x) ? c : mine; }
        if (sum == G) break;
        __builtin_amdgcn_s_sleep(1);
        if ((++sp & 255u) == 0u) { if (xb_ld(&bar[XB_TMO])) break; if (sp > XB_SPIN_CAP) { atomicAdd(&bar[XB_TMO], 1u); break; } }
    }
    nloc = mine > 0u ? mine : 1u; nx = cnt > 0u ? cnt : 1u;
}

__device__ __forceinline__ void xcd_barrier(const XcdBarrier& b) {
    asm volatile("s_waitcnt vmcnt(0)" ::: "memory");
    __syncthreads();
    if (threadIdx.x == 0) {
        unsigned* bar = b.bar;
        __builtin_amdgcn_s_waitcnt(0);
        unsigned nloc = b.st[0], nx = b.st[1];
        if (nloc == 0u) { xcd_barrier_complete(bar, b.x, nloc, nx); b.st[0] = nloc; b.st[1] = nx; }
        const unsigned old = xb_add(&bar[XB_XSUB(b.x)], 1u);
        const unsigned gen = old / nloc;
        if (old + 1u == (gen + 1u) * nloc) {
            __builtin_amdgcn_fence(__ATOMIC_RELEASE, "agent");
            asm volatile("s_waitcnt vmcnt(0)" ::: "memory");
            const unsigned og = xb_add(&bar[XB_TOP], 1u);
            const unsigned tg = og / nx;
            if (og + 1u == (tg + 1u) * nx) xb_add(&bar[XB_TOPGEN], 1u);
            else XB_SPIN(xb_ld(&bar[XB_TOPGEN]) == tg, bar);
            __builtin_amdgcn_fence(__ATOMIC_ACQUIRE, "agent");
            xb_add(&bar[XB_XGEN(b.x)], 1u);
            asm volatile("s_waitcnt vmcnt(0)" ::: "memory");
        } else {
            XB_SPIN(xb_ld(&bar[XB_XGEN(b.x)]) == gen, bar);
            __builtin_amdgcn_fence(__ATOMIC_ACQUIRE, "agent");
            asm volatile("s_waitcnt vmcnt(0)" ::: "memory");
        }
    }
    __syncthreads();
}

template <int NP> __device__ __forceinline__ void fill_rstab(LAS unsigned char* lds, const float* ssp, int N, int G, int bx, int tid) {
    LAS float* rstab = (LAS float*)(lds + 131072); LAS int* pmtab = (LAS int*)(lds + 131072 + 12288);
    pg8::StaticOrder S0; S0.init(M, N, G, bx); pg8::Unit u0; int nu = 0;
    for (; nu < 12 && S0.next(nu, u0); ++nu) if (tid == 0) pmtab[nu] = u0.pm;
    __syncthreads();
    float sv[6];
#pragma unroll
    for (int k = 0; k < 6; ++k) { const int ri = tid + 512 * k; sv[k] = 0.f;
        if (ri < nu * 256) { const float* p = ssp + (size_t)(pmtab[ri >> 8] * 256 + (ri & 255)) * NP;
            if (NP == 16) { const f32x4 a = *(const f32x4*)p, b = *(const f32x4*)(p + 4), c = *(const f32x4*)(p + 8), d = *(const f32x4*)(p + 12);
                sv[k] = (((a.x + a.y) + (a.z + a.w)) + ((b.x + b.y) + (b.z + b.w))) + (((c.x + c.y) + (c.z + c.w)) + ((d.x + d.y) + (d.z + d.w))); }
            else sv[k] = p[0]; } }
#pragma unroll
    for (int k = 0; k < 6; ++k) { const int ri = tid + 512 * k; if (ri < nu * 256) rstab[ri] = __builtin_amdgcn_rsqf(sv[k] * (1.0f / 1024.0f) + EPS); }
    __syncthreads();
}

struct Args { const float* in[19]; float* out; unsigned char* ws; int ph_lo, ph_hi; };
#ifndef MK_MULTI
#define MK_MULTI 0
#endif
#if MK_MULTI
#define GRID_SYNC() do { } while (0)
#else
#ifndef MK_CG
#define MK_CG 0
#endif
#if MK_CG
#define GRID_SYNC() do { __threadfence(); cg::this_grid().sync(); } while (0)
#else
#define GRID_SYNC() xcd_barrier(xbar)
#endif
#endif

__global__ void __launch_bounds__(NTHREADS, 2) fwd_kernel(Args args) {
    extern __shared__ __attribute__((aligned(16))) unsigned char lds_raw[];
    LAS unsigned char* lds = (LAS unsigned char*)lds_raw;
    const int tid = threadIdx.x, lane = tid & 63, wave = __builtin_amdgcn_readfirstlane(tid >> 6);
    const int G = gridDim.x, bx = blockIdx.x; const int vcu = (G % 8 == 0) ? (bx % 8) * (G / 8) + bx / 8 : bx;
    const int gw = vcu * NWAVES + wave, NGW = G * NWAVES;
    unsigned char* ws = args.ws;
#if !MK_MULTI && !MK_CG
    volatile LAS unsigned* xst = (volatile LAS unsigned*)(lds + LDS_BYTES - 128);
    if (tid < 2) xst[tid] = 0u;
    __syncthreads();
    XcdBarrier xbar = xcd_barrier_post((unsigned*)(ws + WS_CTL), xst);
#endif
    const float* x = args.in[0];
    float* X = args.out; bf16* XB = (bf16*)args.out;
#define Wgu1 ((bf16*)(ws + WS_WGU1))
#define Wd1 ((bf16*)(ws + WS_WD1))
#define Wgu2 ((bf16*)(ws + WS_WGU2))
#define Wd2 ((bf16*)(ws + WS_WD2))
#define Win ((bf16*)(ws + WS_WIN))
#define Wc ((bf16*)(ws + WS_WC))
#define Wa ((bf16*)(ws + WS_WA))
#define Wo ((bf16*)(ws + WS_WO))
#define H ((bf16*)(ws + WS_H))
#define ZC ((bf16*)(ws + WS_ZC))
#define Qb ((bf16*)(ws + WS_Q))
#define Kb ((bf16*)(ws + WS_K))
#define Vb ((bf16*)(ws + WS_V))
#define LSE ((float*)(ws + WS_LSE))
#define ATT ((bf16*)(ws + WS_ATT))
#define ZG ((bf16*)(ws + WS_ZG))
#define GT ((bf16*)(ws + WS_G))
#define T1 ((bf16*)(ws + WS_T1))
#define MIX ((bf16*)(ws + WS_MIX))
#define A1 ((bf16*)(ws + WS_A1))
#define SS1 ((float*)(ws + WS_SS))
#define SS2 ((float*)(ws + WS_SSP))
#define SS3 ((float*)(ws + WS_SSP) + (size_t)M * 16)
    const int lo = args.ph_lo, hi = args.ph_hi;
#define IN(k) (lo <= (k) && (k) < hi)
#define SEAM(k) do { if (IN(k) && IN((k) + 1)) GRID_SYNC(); } while (0)
#define GEMM_PHASE(EPI, Aptr, Bptr, Nn, Kk, ...) do { pg8::Gemm g_{Aptr, Bptr, M, Nn, Kk}; pg8::StaticOrder S_; S_.init(M, Nn, G, bx); EPI E_{__VA_ARGS__}; \
        pg8::gemm_phase<EPI, pg8::StaticOrder, true, true>(lds, g_, S_, E_); } while (0)
#define GEMM_PHASE_RS(SSp, NP, EPI, Aptr, Bptr, Nn, Kk, ...) do { fill_rstab<NP>(lds, SSp, Nn, G, bx, tid); GEMM_PHASE(EPI, Aptr, Bptr, Nn, Kk, __VA_ARGS__); } while (0)

    if (IN(0)) {
        LAS float* scr = (LAS float*)(lds + wave * 16384);
        constexpr int I_GU = 16 * 88, I_DN = 44 * 32, I_IN = 16 * 272, I_C = 16 * 32, I_A = 8 * 32;
        constexpr int NITEMS = 6 * I_GU + I_IN + 2 * I_C + I_A;
        static_assert(I_DN == I_GU, "items");
        for (int it = gw; it < NITEMS; it += NGW) {
            int r = it;
            if (r < I_GU) { transpose_item(args.in[2], D, FF, Wgu1, 1, scr, r, lane, args.in[1]); continue; } r -= I_GU;
            if (r < I_GU) { transpose_item(args.in[3], D, FF, Wgu1, 2, scr, r, lane, args.in[1]); continue; } r -= I_GU;
            if (r < I_GU) { transpose_item(args.in[4], FF, D, Wd1, 0, scr, r, lane); continue; } r -= I_GU;
            if (r < I_GU) { transpose_item(args.in[15], D, FF, Wgu2, 1, scr, r, lane, args.in[14]); continue; } r -= I_GU;
            if (r < I_GU) { transpose_item(args.in[16], D, FF, Wgu2, 2, scr, r, lane, args.in[14]); continue; } r -= I_GU;
            if (r < I_GU) { transpose_item(args.in[17], FF, D, Wd2, 0, scr, r, lane); continue; } r -= I_GU;
            if (r < I_IN) { transpose_item(args.in[6], D, NIN, Win, 3, scr, r, lane, args.in[5]); continue; } r -= I_IN;
            if (r < I_C) { transpose_item(args.in[11], D, D, Wc, 0, scr, r, lane); continue; } r -= I_C;
            if (r < I_A) { transpose_item(args.in[12], 512, D, Wa, 0, scr, r, lane); continue; } r -= I_A;
            transpose_item(args.in[13], D, D, Wo, 0, scr, r, lane);
        }
        raw_rows(x, H, SS1, gw, NGW, lane);
        __syncthreads();
    }
    SEAM(0);
    if (IN(1)) GEMM_PHASE_RS(SS1, 1, pg8::EpiPair<0>, H, Wgu1, 2 * FF, D, A1, FF);
    SEAM(1);
    if (IN(2)) GEMM_PHASE(pg8::EpiResid<true>, A1, Wd1, D, FF, H, XB, SS2, 0.5f);
    SEAM(2);
    if (IN(3)) GEMM_PHASE_RS(SS2, 16, pg8::EpiPair<1>, XB, Win, 2048, D, ZG, D);
    SEAM(3);
    if (IN(4)) conv_phase(ZG, args.in[7], args.in[8], args.in[9], args.in[10], ZC, (LAS float*)lds, vcu, G);
    SEAM(4);
    if (IN(5)) GEMM_PHASE_RS(SS2, 16, pg8::EpiQKV, XB, Win + (size_t)2048 * D, 3 * AW, D, Qb, (size_t)(WS_K - WS_Q) / 2, 0.08838834764831845f * 1.4426950408889634f);
    SEAM(5);
    if (IN(6)) attn_phase(lds, Qb, Kb, Vb, Qb, LSE, vcu, G);
    SEAM(6);
    if (IN(7)) { merge_rows(Qb, LSE, ATT, gw, NGW, lane); __syncthreads(); }
    if (IN(7)) GEMM_PHASE_RS(SS2, 16, pg8::EpiSig, XB, Win + (size_t)6656 * D, 2048, D, GT, 2048);
    SEAM(7);
    if (IN(8)) GEMM_PHASE(pg8::EpiGate<false>, ZC, Wc, D, D, nullptr, GT, 2048, T1);
    if (IN(9)) GEMM_PHASE(pg8::EpiGate<true>, ATT, Wa, D, 512, T1, GT + 1024, 2048, MIX);
    SEAM(9);
    if (IN(10)) GEMM_PHASE(pg8::EpiResid<true>, MIX, Wo, D, D, XB, XB, SS3, 1.0f);
    SEAM(10);
    if (IN(11)) GEMM_PHASE_RS(SS3, 16, pg8::EpiPair<0>, XB, Wgu2, 2 * FF, D, A1, FF);
    SEAM(11);
    if (IN(12)) GEMM_PHASE(pg8::EpiResid<true>, A1, Wd2, D, FF, XB, H, nullptr, 0.5f);
    SEAM(12);
    if (IN(13)) rms_rows_b(H, args.in[18], X, gw, NGW, lane);
#undef IN
#undef Wgu1
#undef Wd1
#undef Wgu2
#undef Wd2
#undef Win
#undef Wc
#undef Wa
#undef Wo
#undef H
#undef ZC
#undef Qb
#undef Kb
#undef Vb
#undef LSE
#undef ATT
#undef ZG
#undef GT
#undef T1
#undef MIX
#undef A1
#undef SS1
#undef SS2
#undef SS3
#undef SEAM
}
constexpr int NPHASES = 14;

extern "C" void kernel_launch(void* const* d_in, const int* in_sizes, int n_in, void* d_out, int out_size, void* d_ws, size_t ws_size, hipStream_t stream) {
    static int grid = 0;
    if (grid == 0) {
        if (n_in != 19 || out_size != M * D || ws_size < WS_END) { fprintf(stderr, "kernel_launch: unexpected shapes (n_in %d out %d ws %zu)\n", n_in, out_size, ws_size); grid = -1; return; }
        int dev = 0, cus = 0, per_cu = 0;
        hipGetDevice(&dev); hipDeviceGetAttribute(&cus, hipDeviceAttributeMultiprocessorCount, dev);
        if (hipFuncSetAttribute((const void*)fwd_kernel, hipFuncAttributeMaxDynamicSharedMemorySize, LDS_BYTES) != hipSuccess) { fprintf(stderr, "kernel_launch: hipFuncSetAttribute failed\n"); grid = -1; return; }
        if (hipOccupancyMaxActiveBlocksPerMultiprocessor(&per_cu, (const void*)fwd_kernel, NTHREADS, LDS_BYTES) != hipSuccess || per_cu < 1) { fprintf(stderr, "kernel_launch: occupancy query says %d\n", per_cu); per_cu = 1; }
        (void)hipGetLastError();
        if (per_cu > 1) per_cu = 1;
        grid = cus * per_cu;
    }
    if (grid < 0) return;
    Args a{};
    for (int i = 0; i < 19; ++i) a.in[i] = (const float*)d_in[i];
    a.out = (float*)d_out; a.ws = (unsigned char*)d_ws;
#if MK_MULTI
    for (int p = 0; p < NPHASES; ++p) { a.ph_lo = p; a.ph_hi = p + 1; hipLaunchKernelGGL(fwd_kernel, dim3(grid), dim3(NTHREADS), LDS_BYTES, stream, a); }
#else
    a.ph_lo = 0; a.ph_hi = NPHASES;
#if MK_CG
    void* kargs[] = {&a};
    hipError_t e = hipLaunchCooperativeKernel((const void*)fwd_kernel, dim3(grid), dim3(NTHREADS), kargs, LDS_BYTES, stream);
    if (e != hipSuccess) fprintf(stderr, "cooperative launch failed: %s (grid %d)\n", hipGetErrorString(e), grid);
#else
    if (hipMemsetAsync((char*)d_ws + WS_CTL, 0, 65536, stream) != hipSuccess) { fprintf(stderr, "kernel_launch: memset failed\n"); return; }
    hipLaunchKernelGGL(fwd_kernel, dim3(grid), dim3(NTHREADS), LDS_BYTES, stream, a);
#endif
#endif
}
```

```cpp
#include <hip/hip_runtime.h>
#include <cstdio>
#include <cstdint>
namespace pg8 {
#define PG8_LAS __attribute__((address_space(3)))
typedef unsigned short bf16_t;
typedef short bf16x8 __attribute__((ext_vector_type(8)));
typedef float f32x4 __attribute__((ext_vector_type(4)));
typedef unsigned u32x4 __attribute__((ext_vector_type(4)));
constexpr int BM = 256, BK = 64, HALF = 128, HTB = HALF * BK * 2  , STAGE_BYTES = 8 * HTB, NXCD = 8, WGM = 8;

__host__ __device__ __forceinline__ int lds_byte(int r, int c) { const int st = (r >> 4) * 2 + (c >> 5), rr = r & 15, cc = c & 31, ob = rr * 64 + cc * 2; return st * 1024 + (ob ^ (((ob >> 9) & 1) << 5)); }
__host__ __device__ __forceinline__ void stage_rc(int b, int& R, int& C) { const int st = b / 1024, sb = b % 1024, swz = sb ^ (((sb >> 9) & 1) << 5); R = (st >> 1) * 16 + swz / 64; C = (st & 1) * 32 + (swz % 64) / 2; }
__host__ __device__ __forceinline__ int perm32(int rho) { const int n = rho >> 4, i = rho & 15; return 8 * (i >> 2) + 4 * n + (i & 3); }

struct Unit { int pm, pn; };
struct Gemm { const bf16_t* A; const bf16_t* Bt; int M, N, K; };

struct StaticOrder {
    int nM, nN, nwg, G, c;
    __host__ __device__ void init(int M, int N, int G_, int c_) { nM = M / BM; nN = N / BM; nwg = nM * nN; G = G_; c = c_; }
    __host__ __device__ bool next(int i, Unit& u) const {
        const long L = (long)i * G + c; if (L >= nwg) return false;
        int wgid = (int)L; { const int q = nwg / NXCD, r = nwg % NXCD, xcd = wgid % NXCD, off = wgid / NXCD; wgid = (xcd < r ? xcd * (q + 1) : r * (q + 1) + (xcd - r) * q) + off; }
        const int nig = WGM * nN, gid = wgid / nig, fm = gid * WGM, gsz = (nM - fm) < WGM ? (nM - fm) : WGM;
        u.pm = fm + ((wgid % nig) % gsz); u.pn = (wgid % nig) / gsz; return true;
    }
    __device__ __forceinline__ void a_ready(const Unit&) const {}
    __device__ __forceinline__ void done(const Unit&) const {}
};

typedef float f32x2_t __attribute__((ext_vector_type(2))); typedef __bf16 bf16x2_t __attribute__((ext_vector_type(2)));
__device__ __forceinline__ unsigned cvt_pk_bf16(float lo, float hi) { const f32x2_t v = {lo, hi}; const bf16x2_t b = __builtin_convertvector(v, bf16x2_t); return __builtin_bit_cast(unsigned, b); }
typedef float f32x2 __attribute__((ext_vector_type(2)));
__device__ __forceinline__ float sigmoid_f(float x) { return __builtin_amdgcn_rcpf(1.0f + __builtin_amdgcn_exp2f(-1.4426950408889634f * x)); }
__device__ __forceinline__ float bf_lo(unsigned u) { return __uint_as_float(u << 16); }
__device__ __forceinline__ float bf_hi(unsigned u) { return __uint_as_float(u & 0xffff0000u); }

template <int ACT> struct EpiPair {
    static constexpr bool PERM = true, AFTER_DRAIN = false;
    bf16_t* O; int ldo;
    __device__ __forceinline__ void operator()(const f32x4 (&acc)[2][2][4][2], const Unit& u, int wr, int wc, int fr, int fq, int ui, PG8_LAS unsigned char* lds) const {
        const PG8_LAS float* rs = (const PG8_LAS float*)(lds + 131072);
        const int row0 = u.pm * BM + wr * 64 + fr, col0 = u.pn * HALF + wc * 32 + 8 * fq;
#pragma unroll
        for (int ai = 0; ai < 2; ++ai)
#pragma unroll
            for (int m = 0; m < 4; ++m) { const float rsv = rs[ui * 256 + ai * HALF + wr * 64 + m * 16 + fr];
                float v[8];
#pragma unroll
                for (int n = 0; n < 2; ++n)
#pragma unroll
                    for (int i = 0; i < 4; ++i) { const float a = acc[ai][0][m][n][i] * rsv, b = acc[ai][1][m][n][i] * rsv;
                        v[n * 4 + i] = (ACT == 0) ? a * sigmoid_f(a) * b : a * sigmoid_f(b); }
                u32x4 w; w.x = cvt_pk_bf16(v[0], v[1]); w.y = cvt_pk_bf16(v[2], v[3]); w.z = cvt_pk_bf16(v[4], v[5]); w.w = cvt_pk_bf16(v[6], v[7]);
                *(u32x4*)(O + (size_t)(row0 + ai * HALF + m * 16) * ldo + col0) = w; }
    }
};
template <bool BASE_BF16> struct EpiResid {
    static constexpr bool PERM = true, AFTER_DRAIN = false;
    const void* base; bf16_t* outb; float* ss; float alpha;
    __device__ __forceinline__ void operator()(const f32x4 (&acc)[2][2][4][2], const Unit& u, int wr, int wc, int fr, int fq, int, PG8_LAS unsigned char*) const {
        const int row0 = u.pm * BM + wr * 64 + fr, col0 = u.pn * BM + wc * 32 + 8 * fq;
#pragma unroll
        for (int ai = 0; ai < 2; ++ai)
#pragma unroll
            for (int m = 0; m < 4; ++m) { const size_t off = (size_t)(row0 + ai * HALF + m * 16) * 1024 + col0; float sq = 0.f;
#pragma unroll
                for (int bj = 0; bj < 2; ++bj) { f32x4 b0, b1;
                    if (BASE_BF16) { const u32x4 r = *(const u32x4*)((const bf16_t*)base + off + bj * HALF);
                        b0 = (f32x4){bf_lo(r.x), bf_hi(r.x), bf_lo(r.y), bf_hi(r.y)}; b1 = (f32x4){bf_lo(r.z), bf_hi(r.z), bf_lo(r.w), bf_hi(r.w)}; }
                    else { b0 = *(const f32x4*)((const float*)base + off + bj * HALF); b1 = *(const f32x4*)((const float*)base + off + bj * HALF + 4); }
                    const f32x4 v0 = b0 + acc[ai][bj][m][0] * alpha, v1 = b1 + acc[ai][bj][m][1] * alpha;
                    u32x4 w; w.x = cvt_pk_bf16(v0[0], v0[1]); w.y = cvt_pk_bf16(v0[2], v0[3]); w.z = cvt_pk_bf16(v1[0], v1[1]); w.w = cvt_pk_bf16(v1[2], v1[3]);
                    *(u32x4*)(outb + off + bj * HALF) = w;
                    { const float r0 = bf_lo(w.x), r1 = bf_hi(w.x), r2 = bf_lo(w.y), r3 = bf_hi(w.y), r4 = bf_lo(w.z), r5 = bf_hi(w.z), r6 = bf_lo(w.w), r7 = bf_hi(w.w);
                      sq += ((r0 * r0 + r1 * r1) + (r2 * r2 + r3 * r3)) + ((r4 * r4 + r5 * r5) + (r6 * r6 + r7 * r7)); } }
                if (ss) { sq += __shfl_xor(sq, 16); sq += __shfl_xor(sq, 32); if (fq == 0) ss[(size_t)(row0 + ai * HALF + m * 16) * 16 + u.pn * 4 + wc] = sq; } }
    }
};
struct EpiQKV {
    static constexpr bool PERM = true, AFTER_DRAIN = false;
    bf16_t* O; size_t tstride; float qscale;
    __device__ __forceinline__ void operator()(const f32x4 (&acc)[2][2][4][2], const Unit& u, int wr, int wc, int fr, int fq, int ui, PG8_LAS unsigned char* lds) const {
        const PG8_LAS float* rs = (const PG8_LAS float*)(lds + 131072);
        const int row0 = u.pm * BM + wr * 64 + fr; const int t = u.pn / 6, ct = u.pn - 6 * t, dsh = 2 * (ct >> 1);
        bf16_t* base = O + (size_t)t * tstride + wc * 32 + 8 * fq; const float sc0 = (t == 0) ? qscale : 1.0f;
#pragma unroll
        for (int ai = 0; ai < 2; ++ai)
#pragma unroll
            for (int m = 0; m < 4; ++m) { const int row = row0 + ai * HALF + m * 16, b = row >> 12, s = row & 4095;
                const int pos = ((s & ((1 << dsh) - 1)) << (12 - dsh)) + (s >> dsh);
                const float sc = sc0 * rs[ui * 256 + ai * HALF + wr * 64 + m * 16 + fr];
#pragma unroll
                for (int bj = 0; bj < 2; ++bj) { const f32x4 v0 = acc[ai][bj][m][0] * sc, v1 = acc[ai][bj][m][1] * sc;
                    u32x4 w; w.x = cvt_pk_bf16(v0[0], v0[1]); w.y = cvt_pk_bf16(v0[2], v0[3]); w.z = cvt_pk_bf16(v1[0], v1[1]); w.w = cvt_pk_bf16(v1[2], v1[3]);
                    *(u32x4*)(base + ((size_t)((b * 12 + 2 * ct + bj) * 4096 + pos)) * 128) = w; } }
    }
};
struct EpiGluQkv {
    static constexpr bool PERM = true, AFTER_DRAIN = false;
    EpiPair<1> glu; EpiQKV qkv;
    __device__ __forceinline__ void operator()(const f32x4 (&acc)[2][2][4][2], const Unit& u, int wr, int wc, int fr, int fq, int ui, PG8_LAS unsigned char* lds) const {
        if (u.pn < 8) glu(acc, u, wr, wc, fr, fq, ui, lds);
        else { Unit v = u; v.pn = u.pn - 8; qkv(acc, v, wr, wc, fr, fq, ui, lds); }
    }
};
struct EpiSig {
    static constexpr bool PERM = true, AFTER_DRAIN = false;
    bf16_t* O; int ldo;
    __device__ __forceinline__ void operator()(const f32x4 (&acc)[2][2][4][2], const Unit& u, int wr, int wc, int fr, int fq, int ui, PG8_LAS unsigned char* lds) const {
        const PG8_LAS float* rs = (const PG8_LAS float*)(lds + 131072);
        const int row0 = u.pm * BM + wr * 64 + fr, col0 = u.pn * BM + wc * 32 + 8 * fq;
#pragma unroll
        for (int ai = 0; ai < 2; ++ai)
#pragma unroll
            for (int m = 0; m < 4; ++m) { bf16_t* rowp = O + (size_t)(row0 + ai * HALF + m * 16) * ldo + col0; const float rsv = rs[ui * 256 + ai * HALF + wr * 64 + m * 16 + fr];
#pragma unroll
                for (int bj = 0; bj < 2; ++bj) { float v[8];
#pragma unroll
                    for (int n = 0; n < 2; ++n)
#pragma unroll
                        for (int i = 0; i < 4; ++i) v[n * 4 + i] = sigmoid_f(acc[ai][bj][m][n][i] * rsv);
                    u32x4 w; w.x = cvt_pk_bf16(v[0], v[1]); w.y = cvt_pk_bf16(v[2], v[3]); w.z = cvt_pk_bf16(v[4], v[5]); w.w = cvt_pk_bf16(v[6], v[7]);
                    *(u32x4*)(rowp + bj * HALF) = w; } }
    }
};
template <bool HAS_BASE> struct EpiGate {
    static constexpr bool PERM = true, AFTER_DRAIN = false;
    const bf16_t* base; const bf16_t* gate; int ldg; bf16_t* O;
    __device__ __forceinline__ void operator()(const f32x4 (&acc)[2][2][4][2], const Unit& u, int wr, int wc, int fr, int fq, int, PG8_LAS unsigned char*) const {
        const int row0 = u.pm * BM + wr * 64 + fr, col0 = u.pn * BM + wc * 32 + 8 * fq;
#pragma unroll
        for (int ai = 0; ai < 2; ++ai)
#pragma unroll
            for (int m = 0; m < 4; ++m) { const size_t r = (size_t)(row0 + ai * HALF + m * 16);
#pragma unroll
                for (int bj = 0; bj < 2; ++bj) {
                    const u32x4 gv = *(const u32x4*)(gate + r * ldg + col0 + bj * HALF);
                    u32x4 bv = (u32x4){0u, 0u, 0u, 0u}; if (HAS_BASE) bv = *(const u32x4*)(base + r * 1024 + col0 + bj * HALF);
                    const f32x4 a0 = acc[ai][bj][m][0], a1 = acc[ai][bj][m][1];
                    float v[8];
                    v[0] = bf_lo(bv.x) + bf_lo(gv.x) * a0[0]; v[1] = bf_hi(bv.x) + bf_hi(gv.x) * a0[1];
                    v[2] = bf_lo(bv.y) + bf_lo(gv.y) * a0[2]; v[3] = bf_hi(bv.y) + bf_hi(gv.y) * a0[3];
                    v[4] = bf_lo(bv.z) + bf_lo(gv.z) * a1[0]; v[5] = bf_hi(bv.z) + bf_hi(gv.z) * a1[1];
                    v[6] = bf_lo(bv.w) + bf_lo(gv.w) * a1[2]; v[7] = bf_hi(bv.w) + bf_hi(gv.w) * a1[3];
                    u32x4 w; w.x = cvt_pk_bf16(v[0], v[1]); w.y = cvt_pk_bf16(v[2], v[3]); w.z = cvt_pk_bf16(v[4], v[5]); w.w = cvt_pk_bf16(v[6], v[7]);
                    *(u32x4*)(O + r * 1024 + col0 + bj * HALF) = w; } }
    }
};

template <class Epi, class Sched, bool ALIGN_EPI = false, bool SP2 = false>
__device__ __forceinline__ void gemm_phase(PG8_LAS unsigned char* lds, const Gemm g, const Sched& S, const Epi& E) {
    const int tid = threadIdx.x, wid = __builtin_amdgcn_readfirstlane(tid >> 6), lane = tid & 63, wr = wid >> 2, wc = wid & 3, fr = lane & 15, fq = lane >> 4;
    const int K = g.K, nt = K / BK;
    unsigned voffA[2], voffB[2];
#pragma unroll
    for (int i = 0; i < 2; ++i) { int R, C; stage_rc(tid * 16 + i * 8192, R, C); const int Rb = Epi::PERM ? ((R & ~31) + perm32(R & 31)) : R;
        voffA[i] = (unsigned)(R * K + C) * 2u; voffB[i] = (unsigned)(Rb * K + C) * 2u; }
    const size_t kstep = (size_t)(BK * 2);
    const size_t hstep = (size_t)HALF * K * 2;
    const size_t tstep = 2 * hstep;
    const unsigned ldsw = (unsigned)wid * 1024u;
    const int aoff = lds_byte(wr * 64 + fr, fq * 8), boff = lds_byte(wc * 32 + fr, fq * 8);
#define PG8_SA(b, h) (((b) * 2 + (h)) * HTB)
#define PG8_SB(b, h) ((4 + (b) * 2 + (h)) * HTB)
#define PG8_STAGE(bufoff, gbase, voff) do { _Pragma("unroll") for (int _i = 0; _i < 2; ++_i) \
        __builtin_amdgcn_global_load_lds((const unsigned*)((const char*)(gbase) + (voff)[_i]), (PG8_LAS unsigned*)(lds + (bufoff) + ldsw + _i * 8192), 16, 0, 0); } while (0)
#define PG8_LDA(dst, b, h) do { _Pragma("unroll") for (int m = 0; m < 4; ++m) _Pragma("unroll") for (int k = 0; k < 2; ++k) dst[m][k] = *(const PG8_LAS bf16x8*)(lds + PG8_SA(b, h) + aoff + m * 2048 + k * 1024); } while (0)
#define PG8_LDB(dst, b, h) do { _Pragma("unroll") for (int n = 0; n < 2; ++n) _Pragma("unroll") for (int k = 0; k < 2; ++k) dst[n][k] = *(const PG8_LAS bf16x8*)(lds + PG8_SB(b, h) + boff + n * 2048 + k * 1024); } while (0)
#define PG8_MMA(ai, bj, At, Bt) do { __builtin_amdgcn_s_setprio(1); _Pragma("unroll") for (int m = 0; m < 4; ++m) _Pragma("unroll") for (int n = 0; n < 2; ++n) _Pragma("unroll") for (int k = 0; k < 2; ++k) \
        acc[ai][bj][m][n] = __builtin_amdgcn_mfma_f32_16x16x32_bf16(Bt[n][k], At[m][k], acc[ai][bj][m][n], 0, 0, 0); __builtin_amdgcn_s_setprio(0); } while (0)
#define PG8_WAIT_V(n) asm volatile("s_waitcnt vmcnt(" #n ")" ::: "memory")
#define PG8_WAIT_L(n) asm volatile("s_waitcnt lgkmcnt(" #n ")" ::: "memory")
#define PG8_BAR __builtin_amdgcn_s_barrier()
#define PG8_SCHED __builtin_amdgcn_sched_barrier(0)
    Unit cur, nxt; int ui = 0;
    if (!S.next(0, cur)) return;
    f32x4 acc[2][2][4][2];
#pragma unroll
    for (int a = 0; a < 2; ++a)
#pragma unroll
        for (int b = 0; b < 2; ++b)
#pragma unroll
            for (int m = 0; m < 4; ++m)
#pragma unroll
                for (int n = 0; n < 2; ++n) acc[a][b][m][n] = (f32x4){0.f, 0.f, 0.f, 0.f};
    bf16x8 At[4][2], B0[2][2], B1[2][2];
    const char* cA = (const char*)g.A + (size_t)cur.pm * tstep; const char* cB = (const char*)g.Bt + (size_t)cur.pn * tstep;
    S.a_ready(cur);
    if constexpr (SP2) {
        PG8_STAGE(PG8_SB(0, 0), cB, voffB); PG8_STAGE(PG8_SB(0, 1), cB + hstep, voffB); PG8_STAGE(PG8_SA(0, 0), cA, voffA); PG8_STAGE(PG8_SA(0, 1), cA + hstep, voffA);
        if (wr == 1) PG8_BAR;
        PG8_WAIT_V(2); PG8_BAR;
        PG8_STAGE(PG8_SB(1, 0), cB + kstep, voffB); PG8_STAGE(PG8_SA(1, 0), cA + kstep, voffA); PG8_STAGE(PG8_SB(1, 1), cB + hstep + kstep, voffB);
        PG8_WAIT_V(6); PG8_BAR;
    } else {
        PG8_STAGE(PG8_SB(0, 0), cB, voffB); PG8_STAGE(PG8_SA(0, 0), cA, voffA); PG8_STAGE(PG8_SB(0, 1), cB + hstep, voffB); PG8_STAGE(PG8_SA(0, 1), cA + hstep, voffA);
        if (wr == 1) PG8_BAR;
        PG8_WAIT_V(4); PG8_BAR;
        PG8_STAGE(PG8_SB(1, 0), cB + kstep, voffB); PG8_STAGE(PG8_SA(1, 0), cA + kstep, voffA); PG8_STAGE(PG8_SB(1, 1), cB + hstep + kstep, voffB);
        PG8_WAIT_V(6); PG8_BAR;
    }
    for (;;) {
        const bool has_next = S.next(ui + 1, nxt);
        const char* nA = has_next ? (const char*)g.A + (size_t)nxt.pm * tstep : cA; const char* nB = has_next ? (const char*)g.Bt + (size_t)nxt.pn * tstep : cB;
        for (int t = 0; t < nt; t += 2) {
            const bool last = (t == nt - 2);
            const char* a1 = cA + (size_t)(t + 1) * kstep;
            const char* a2 = last ? nA : cA + (size_t)(t + 2) * kstep; const char* b2 = last ? nB : cB + (size_t)(t + 2) * kstep;
            const char* a3 = a2 + kstep; const char* b3 = b2 + kstep;
            if (last && has_next) S.a_ready(nxt);
            if constexpr (SP2) {
            PG8_LDB(B0, 0, 0); PG8_LDB(B1, 0, 1); PG8_SCHED; PG8_LDA(At, 0, 0); PG8_STAGE(PG8_SA(1, 1), a1 + hstep, voffA);
            PG8_WAIT_V(8); PG8_WAIT_L(0); PG8_BAR; PG8_MMA(0, 0, At, B0); PG8_MMA(0, 1, At, B1); PG8_BAR; PG8_SCHED;
            PG8_LDA(At, 0, 1); PG8_STAGE(PG8_SB(0, 0), b2, voffB); PG8_STAGE(PG8_SB(0, 1), b2 + hstep, voffB); PG8_STAGE(PG8_SA(0, 0), a2, voffA);
            PG8_WAIT_V(8); PG8_WAIT_L(0); PG8_BAR; PG8_MMA(1, 0, At, B0); PG8_MMA(1, 1, At, B1); PG8_BAR; PG8_SCHED;
            PG8_LDB(B0, 1, 0); PG8_LDB(B1, 1, 1); PG8_SCHED; PG8_LDA(At, 1, 0); PG8_STAGE(PG8_SA(0, 1), a2 + hstep, voffA);
            PG8_WAIT_V(8); PG8_WAIT_L(0); PG8_BAR; PG8_MMA(0, 0, At, B0); PG8_MMA(0, 1, At, B1); PG8_BAR; PG8_SCHED;
            PG8_LDA(At, 1, 1); PG8_STAGE(PG8_SB(1, 0), b3, voffB); PG8_STAGE(PG8_SB(1, 1), b3 + hstep, voffB); PG8_STAGE(PG8_SA(1, 0), a3, voffA);
            PG8_WAIT_V(8); PG8_WAIT_L(0); PG8_BAR; PG8_MMA(1, 0, At, B0); PG8_MMA(1, 1, At, B1); PG8_BAR; PG8_SCHED;
            } else {
            PG8_LDB(B0, 0, 0); PG8_SCHED; PG8_LDA(At, 0, 0); PG8_STAGE(PG8_SA(1, 1), a1 + hstep, voffA);
            PG8_WAIT_L(8); PG8_BAR; PG8_WAIT_L(0); PG8_MMA(0, 0, At, B0); PG8_BAR; PG8_SCHED;
            PG8_LDB(B1, 0, 1); PG8_STAGE(PG8_SB(0, 0), b2, voffB);
            PG8_BAR; PG8_WAIT_L(0); PG8_MMA(0, 1, At, B1); PG8_BAR;
            PG8_LDA(At, 0, 1); PG8_STAGE(PG8_SA(0, 0), a2, voffA);
            PG8_BAR; PG8_WAIT_L(0); PG8_MMA(1, 0, At, B0); PG8_BAR; PG8_SCHED;
            PG8_STAGE(PG8_SB(0, 1), b2 + hstep, voffB);
            PG8_WAIT_V(6); PG8_BAR; PG8_MMA(1, 1, At, B1); PG8_BAR;
            PG8_LDB(B0, 1, 0); PG8_SCHED; PG8_LDA(At, 1, 0); PG8_STAGE(PG8_SA(0, 1), a2 + hstep, voffA);
            PG8_WAIT_L(8); PG8_BAR; PG8_WAIT_L(0); PG8_MMA(0, 0, At, B0); PG8_BAR; PG8_SCHED;
            PG8_LDB(B1, 1, 1); PG8_STAGE(PG8_SB(1, 0), b3, voffB);
            PG8_BAR; PG8_WAIT_L(0); PG8_MMA(0, 1, At, B1); PG8_BAR;
            PG8_LDA(At, 1, 1); PG8_STAGE(PG8_SA(1, 0), a3, voffA);
            PG8_BAR; PG8_WAIT_L(0); PG8_MMA(1, 0, At, B0); PG8_BAR; PG8_SCHED;
            PG8_STAGE(PG8_SB(1, 1), b3 + hstep, voffB);
            PG8_WAIT_V(6); PG8_BAR; PG8_MMA(1, 1, At, B1); PG8_BAR;
            }
        }
        if constexpr (ALIGN_EPI) { if (wr == 0) PG8_BAR; }
        if constexpr (!Epi::AFTER_DRAIN) { E(acc, cur, wr, wc, fr, fq, ui, lds); S.done(cur); }
        if (!has_next) break;
#pragma unroll
        for (int a = 0; a < 2; ++a)
#pragma unroll
            for (int b = 0; b < 2; ++b)
#pragma unroll
                for (int m = 0; m < 4; ++m)
#pragma unroll
                    for (int n = 0; n < 2; ++n) acc[a][b][m][n] = (f32x4){0.f, 0.f, 0.f, 0.f};
        cur = nxt; cA = nA; cB = nB; ++ui;
        if constexpr (ALIGN_EPI) { if (wr == 1) PG8_BAR; }
    }
    PG8_WAIT_V(0);
    if constexpr (!ALIGN_EPI) { if (wr == 0) PG8_BAR; }
    PG8_BAR;
    if constexpr (Epi::AFTER_DRAIN) { E.fused(acc, cur, wr, wc, fr, fq, lds, wid, lane); S.done(cur); }
#undef PG8_SA
#undef PG8_SB
#undef PG8_STAGE
#undef PG8_LDA
#undef PG8_LDB
#undef PG8_MMA
#undef PG8_WAIT_V
#undef PG8_WAIT_L
#undef PG8_BAR
#undef PG8_SCHED
}
}

#include <hip/hip_cooperative_groups.h>
namespace cg = cooperative_groups;
using pg8::sigmoid_f; using pg8::bf_lo; using pg8::bf_hi;
#define LAS __attribute__((address_space(3)))
typedef unsigned short bf16;
typedef unsigned v4u __attribute__((ext_vector_type(4)));
typedef unsigned v2u __attribute__((ext_vector_type(2)));
typedef float f32x4 __attribute__((ext_vector_type(4)));
typedef float f32x2 __attribute__((ext_vector_type(2)));
typedef short bf16x8 __attribute__((ext_vector_type(8)));
typedef short v4i16_t __attribute__((ext_vector_type(4)));

constexpr int NWAVES = 8, NTHREADS = 512;
constexpr int SEQ = 4096, BATCH = 8, M = BATCH * SEQ, D = 1024, FF = 2816, NIN = 8704, AW = 1536, CW = 31;
constexpr float EPS = 1e-6f;
constexpr size_t MiB = 1u << 20;
constexpr size_t WS_CTL = 0;
constexpr size_t WS_SS = 256 * 1024;
constexpr size_t WS_WGU1 = 1 * MiB, WS_WD1 = 12 * MiB, WS_WGU2 = 18 * MiB, WS_WD2 = 29 * MiB, WS_WIN = 35 * MiB, WS_WC = 52 * MiB, WS_WA = 54 * MiB, WS_WO = 55 * MiB;
constexpr size_t WS_H = 58 * MiB;
constexpr size_t WS_ZC = 122 * MiB;
constexpr size_t WS_Q = 186 * MiB;
constexpr size_t WS_K = 282 * MiB;
constexpr size_t WS_V = 378 * MiB;
constexpr size_t WS_LSE = 474 * MiB;
constexpr size_t WS_ATT = 476 * MiB;
constexpr size_t WS_ZG = WS_H;
constexpr size_t WS_G = WS_K;
constexpr size_t WS_T1 = WS_K + 128 * MiB;
constexpr size_t WS_MIX = WS_H;
constexpr size_t WS_A1 = WS_Q;
constexpr size_t WS_SSP = 508 * MiB;
constexpr size_t WS_END = 512 * MiB;
static_assert(WS_T1 + 64 * MiB <= WS_LSE && WS_A1 + (size_t)M * FF * 2 <= WS_LSE, "ws map");

constexpr int LDS_BYTES = 147456;

__device__ __forceinline__ float wave_sum(float v) {
#pragma unroll
    for (int o = 1; o < 64; o <<= 1) v += __shfl_xor(v, o);
    return v;
}
__device__ __forceinline__ unsigned pk2(float lo, float hi) { return pg8::cvt_pk_bf16(lo, hi); }

__device__ __forceinline__ int dst_row(int map, int n) {
    if (map == 3) { if (n < 1024) map = 1; else if (n < 2048) { map = 2; n -= 1024; } else map = 0; }
    if (map == 0) return n;
    return 256 * (n >> 7) + (n & 127) + (map == 2 ? 128 : 0);
}
__device__ __forceinline__ void transpose_item(const float* W, int K, int N, bf16* WT, int map, LAS float* scr, int item, int lane, const float* gain = nullptr) {
    const int nblk = N / 32, kb = item / nblk, nb = item % nblk, k0 = 64 * kb, n0 = 32 * nb;
    float wv[32];
#pragma unroll
    for (int i = 0; i < 32; ++i) wv[i] = W[(size_t)(k0 + 2 * i + (lane >> 5)) * N + n0 + (lane & 31)];
#pragma unroll
    for (int i = 0; i < 32; ++i) scr[(2 * i + (lane >> 5)) * 33 + (lane & 31)] = wv[i] * (gain ? gain[k0 + 2 * i + (lane >> 5)] : 1.0f);
    asm volatile("s_waitcnt lgkmcnt(0)" ::: "memory");
    const int c = lane & 7; const int r0 = dst_row(map, n0);
#pragma unroll
    for (int j = 0; j < 4; ++j) { const int n = (lane >> 3) + 8 * j; const LAS float* s = scr + (8 * c) * 33 + n;
        v4u o; o.x = pk2(s[0 * 33], s[1 * 33]); o.y = pk2(s[2 * 33], s[3 * 33]); o.z = pk2(s[4 * 33], s[5 * 33]); o.w = pk2(s[6 * 33], s[7 * 33]);
        *(v4u*)(WT + (size_t)(r0 + n) * K + k0 + 8 * c) = o; }
    asm volatile("s_waitcnt lgkmcnt(0)" ::: "memory");
}

template <bool OUT_BF16> __device__ __forceinline__ void rms_rows(const float* X, const float* gain, void* out, int gw, int NGW, int lane) {
    f32x4 gv[4];
#pragma unroll
    for (int j = 0; j < 4; ++j) gv[j] = ((const f32x4*)gain)[lane + 64 * j];
    for (int m0 = gw * 4; m0 < M; m0 += NGW * 4) {
        f32x4 v[4][4]; float s[4];
#pragma unroll
        for (int r = 0; r < 4; ++r) { const f32x4* xr = (const f32x4*)(X + (size_t)(m0 + r) * D) + lane;
#pragma unroll
            for (int j = 0; j < 4; ++j) v[r][j] = xr[64 * j]; }
#pragma unroll
        for (int r = 0; r < 4; ++r) { float a = 0.f;
#pragma unroll
            for (int j = 0; j < 4; ++j) a += (v[r][j].x * v[r][j].x + v[r][j].y * v[r][j].y) + (v[r][j].z * v[r][j].z + v[r][j].w * v[r][j].w);
            s[r] = a; }
#pragma unroll
        for (int o = 1; o < 64; o <<= 1) {
#pragma unroll
            for (int r = 0; r < 4; ++r) s[r] += __shfl_xor(s[r], o); }
#pragma unroll
        for (int r = 0; r < 4; ++r) { const float rstd = 1.0f / sqrtf(s[r] * (1.0f / D) + EPS);
            if (OUT_BF16) { v2u* o8 = (v2u*)((bf16*)out + (size_t)(m0 + r) * D) + lane;
#pragma unroll
                for (int j = 0; j < 4; ++j) { v2u w; w.x = pk2(v[r][j].x * rstd * gv[j].x, v[r][j].y * rstd * gv[j].y); w.y = pk2(v[r][j].z * rstd * gv[j].z, v[r][j].w * rstd * gv[j].w); o8[64 * j] = w; }
            } else { f32x4* o = (f32x4*)((float*)out + (size_t)(m0 + r) * D) + lane;
#pragma unroll
                for (int j = 0; j < 4; ++j) o[64 * j] = v[r][j] * rstd * gv[j]; } }
    }
}

__device__ __forceinline__ void rms_rows_bb(const bf16* Xb, const float* gain, bf16* out, int gw, int NGW, int lane) {
    f32x4 gv[4];
#pragma unroll
    for (int j = 0; j < 4; ++j) gv[j] = ((const f32x4*)gain)[lane + 64 * j];
    for (int m0 = gw * 4; m0 < M; m0 += NGW * 4) {
        v2u raw[4][4]; f32x4 v[4][4]; float s[4];
#pragma unroll
        for (int r = 0; r < 4; ++r) { const v2u* xr = (const v2u*)(Xb + (size_t)(m0 + r) * D) + lane;
#pragma unroll
            for (int j = 0; j < 4; ++j) raw[r][j] = xr[64 * j]; }
#pragma unroll
        for (int r = 0; r < 4; ++r) { float a = 0.f;
#pragma unroll
            for (int j = 0; j < 4; ++j) { v[r][j] = (f32x4){bf_lo(raw[r][j].x), bf_hi(raw[r][j].x), bf_lo(raw[r][j].y), bf_hi(raw[r][j].y)};
                a += (v[r][j].x * v[r][j].x + v[r][j].y * v[r][j].y) + (v[r][j].z * v[r][j].z + v[r][j].w * v[r][j].w); }
            s[r] = a; }
#pragma unroll
        for (int o = 1; o < 64; o <<= 1) {
#pragma unroll
            for (int r = 0; r < 4; ++r) s[r] += __shfl_xor(s[r], o); }
#pragma unroll
        for (int r = 0; r < 4; ++r) { const float rstd = 1.0f / sqrtf(s[r] * (1.0f / D) + EPS); v2u* o8 = (v2u*)(out + (size_t)(m0 + r) * D) + lane;
#pragma unroll
            for (int j = 0; j < 4; ++j) { v2u w; w.x = pk2(v[r][j].x * rstd * gv[j].x, v[r][j].y * rstd * gv[j].y); w.y = pk2(v[r][j].z * rstd * gv[j].z, v[r][j].w * rstd * gv[j].w); o8[64 * j] = w; } }
    }
}

__device__ __forceinline__ void rms_rows_b(const bf16* Xb, const float* gain, float* out, int gw, int NGW, int lane) {
    f32x4 gv[4];
#pragma unroll
    for (int j = 0; j < 4; ++j) gv[j] = ((const f32x4*)gain)[lane + 64 * j];
    for (int m0 = gw * 4; m0 < M; m0 += NGW * 4) {
        v2u raw[4][4]; f32x4 v[4][4]; float s[4];
#pragma unroll
        for (int r = 0; r < 4; ++r) { const v2u* xr = (const v2u*)(Xb + (size_t)(m0 + r) * D) + lane;
#pragma unroll
            for (int j = 0; j < 4; ++j) raw[r][j] = xr[64 * j]; }
#pragma unroll
        for (int r = 0; r < 4; ++r) { float a = 0.f;
#pragma unroll
            for (int j = 0; j < 4; ++j) { v[r][j] = (f32x4){bf_lo(raw[r][j].x), bf_hi(raw[r][j].x), bf_lo(raw[r][j].y), bf_hi(raw[r][j].y)};
                a += (v[r][j].x * v[r][j].x + v[r][j].y * v[r][j].y) + (v[r][j].z * v[r][j].z + v[r][j].w * v[r][j].w); }
            s[r] = a; }
#pragma unroll
        for (int o = 1; o < 64; o <<= 1) {
#pragma unroll
            for (int r = 0; r < 4; ++r) s[r] += __shfl_xor(s[r], o); }
#pragma unroll
        for (int r = 0; r < 4; ++r) { const float rstd = 1.0f / sqrtf(s[r] * (1.0f / D) + EPS); f32x4* o = (f32x4*)(out + (size_t)(m0 + r) * D) + lane;
#pragma unroll
            for (int j = 0; j < 4; ++j) o[64 * j] = v[r][j] * rstd * gv[j]; }
    }
}

__device__ __forceinline__ void raw_rows(const float* X, bf16* out, float* ss, int gw, int NGW, int lane) {
    for (int m0 = gw * 4; m0 < M; m0 += NGW * 4) {
        f32x4 v[4][4]; float s[4];
#pragma unroll
        for (int r = 0; r < 4; ++r) { const f32x4* xr = (const f32x4*)(X + (size_t)(m0 + r) * D) + lane;
#pragma unroll
            for (int j = 0; j < 4; ++j) v[r][j] = xr[64 * j]; }
#pragma unroll
        for (int r = 0; r < 4; ++r) { float a = 0.f;
#pragma unroll
            for (int j = 0; j < 4; ++j) a += (v[r][j].x * v[r][j].x + v[r][j].y * v[r][j].y) + (v[r][j].z * v[r][j].z + v[r][j].w * v[r][j].w);
            s[r] = a; }
#pragma unroll
        for (int o = 1; o < 64; o <<= 1) {
#pragma unroll
            for (int r = 0; r < 4; ++r) s[r] += __shfl_xor(s[r], o); }
#pragma unroll
        for (int r = 0; r < 4; ++r) { if (lane == 0) ss[m0 + r] = s[r];
            v2u* o8 = (v2u*)(out + (size_t)(m0 + r) * D) + lane;
#pragma unroll
            for (int j = 0; j < 4; ++j) { v2u w; w.x = pk2(v[r][j].x, v[r][j].y); w.y = pk2(v[r][j].z, v[r][j].w); o8[64 * j] = w; } }
    }
}

constexpr int CT = 16;
__device__ __forceinline__ void conv_phase(const bf16* Zg, const float* dwk, const float* dwb, const float* lng, const float* lnb, bf16* ZC, LAS float* red, int vcu, int G) {
    const int tid = threadIdx.x, lane = tid & 63, wave = tid >> 6, c = 2 * tid;
    float w0[CW], w1[CW];
#pragma unroll
    for (int j = 0; j < CW; ++j) { const f32x2 t = *(const f32x2*)(dwk + j * D + c); w0[j] = t.x; w1[j] = t.y; }
    const f32x2 bb = *(const f32x2*)(dwb + c), gg = *(const f32x2*)(lng + c), lb = *(const f32x2*)(lnb + c);
    constexpr int NT = M / CT; const int tpb = (NT + G - 1) / G; const int tb = vcu * tpb; int te = tb + tpb; if (te > NT) te = NT;
    if (tb >= te) return;
    float z0[CT + CW - 1], z1[CT + CW - 1]; unsigned nx[CT];
    { const int t0 = tb * CT, s0 = t0 & (SEQ - 1);
#pragma unroll
        for (int i = 0; i < CT + CW - 1; ++i) { const bool valid = (s0 + i - (CW - 1)) >= 0; unsigned pk = 0u;
            if (valid) pk = *(const unsigned*)(Zg + (size_t)(t0 + i - (CW - 1)) * D + c);
            z0[i] = bf_lo(pk); z1[i] = bf_hi(pk); } }
    for (int tile = tb; tile < te; ++tile) {
        const int t0 = tile * CT; const bool more = (tile + 1 < te); LAS float* redp = red + ((tile & 1) << 8);
        if (more) {
#pragma unroll
            for (int i = 0; i < CT; ++i) nx[i] = *(const unsigned*)(Zg + (size_t)(t0 + CT + i) * D + c); }
        float o0[CT], o1[CT];
#pragma unroll
        for (int t = 0; t < CT; ++t) { o0[t] = bb.x; o1[t] = bb.y; }
#pragma unroll
        for (int j = 0; j < CW; ++j) {
#pragma unroll
            for (int t = 0; t < CT; ++t) { o0[t] += w0[j] * z0[t + j]; o1[t] += w1[j] * z1[t + j]; } }
        { const bool fresh = (((t0 + CT) & (SEQ - 1)) == 0);
#pragma unroll
            for (int i = 0; i < CW - 1; ++i) { z0[i] = fresh ? 0.f : z0[i + CT]; z1[i] = fresh ? 0.f : z1[i + CT]; } }
        { float k32[2 * CT];
#pragma unroll
            for (int t = 0; t < CT; ++t) { k32[2 * t] = o0[t] + o1[t]; k32[2 * t + 1] = o0[t] * o0[t] + o1[t] * o1[t]; }
            float k16[16], k8[8], k4[4], k2[2];
            const bool b5 = (lane & 32) != 0, b4 = (lane & 16) != 0, b3 = (lane & 8) != 0, b2 = (lane & 4) != 0, b1 = (lane & 2) != 0;
#pragma unroll
            for (int k = 0; k < 16; ++k) { const float send = b5 ? k32[k] : k32[16 + k], mine = b5 ? k32[16 + k] : k32[k]; k16[k] = mine + __shfl_xor(send, 32); }
#pragma unroll
            for (int k = 0; k < 8; ++k) { const float send = b4 ? k16[k] : k16[8 + k], mine = b4 ? k16[8 + k] : k16[k]; k8[k] = mine + __shfl_xor(send, 16); }
#pragma unroll
            for (int k = 0; k < 4; ++k) { const float send = b3 ? k8[k] : k8[4 + k], mine = b3 ? k8[4 + k] : k8[k]; k4[k] = mine + __shfl_xor(send, 8); }
#pragma unroll
            for (int k = 0; k < 2; ++k) { const float send = b2 ? k4[k] : k4[2 + k], mine = b2 ? k4[2 + k] : k4[k]; k2[k] = mine + __shfl_xor(send, 4); }
            const float send1 = b1 ? k2[0] : k2[1], mine1 = b1 ? k2[1] : k2[0]; float tot = mine1 + __shfl_xor(send1, 2);
            tot += __shfl_xor(tot, 1);
            if ((lane & 1) == 0) redp[(lane >> 1) * 8 + wave] = tot; }
        __syncthreads();
        float mu_l, rs_l;
        { const int tl = lane & 15;
            const f32x4 a = *(const LAS f32x4*)(redp + (2 * tl) * 8), b = *(const LAS f32x4*)(redp + (2 * tl) * 8 + 4);
            const f32x4 p = *(const LAS f32x4*)(redp + (2 * tl + 1) * 8), q = *(const LAS f32x4*)(redp + (2 * tl + 1) * 8 + 4);
            const float s1 = ((a.x + a.y) + (a.z + a.w)) + ((b.x + b.y) + (b.z + b.w)), s2 = ((p.x + p.y) + (p.z + p.w)) + ((q.x + q.y) + (q.z + q.w));
            mu_l = s1 * (1.0f / D); const float var = fmaxf(s2 * (1.0f / D) - mu_l * mu_l, 0.f); rs_l = 1.0f / sqrtf(var + EPS); }
        unsigned* outp = (unsigned*)(ZC + (size_t)t0 * D + c);
#pragma unroll
        for (int t = 0; t < CT; ++t) { const float mu = __int_as_float(__builtin_amdgcn_readlane(__float_as_int(mu_l), t)), rstd = __int_as_float(__builtin_amdgcn_readlane(__float_as_int(rs_l), t));
            float y0 = (o0[t] - mu) * rstd * gg.x + lb.x, y1 = (o1[t] - mu) * rstd * gg.y + lb.y;
            y0 = y0 * sigmoid_f(y0); y1 = y1 * sigmoid_f(y1);
            outp[(size_t)t * (D / 2)] = pk2(y0, y1); }
        if (more) {
#pragma unroll
            for (int i = 0; i < CT; ++i) { z0[CW - 1 + i] = bf_lo(nx[i]); z1[CW - 1 + i] = bf_hi(nx[i]); } }
    }
    __syncthreads();
}

constexpr int VROW = 272;
constexpr int ATT_UNITS = BATCH * 12 * 32;
__device__ __forceinline__ v4i16_t tr16(const LAS unsigned char* p) { return __builtin_amdgcn_ds_read_tr16_b64_v4i16((LAS v4i16_t*)p); }
struct AttnPre { v4u k[4], v[4]; bf16x8 q[4]; };
struct AttnIdx { size_t row0; int hg, dsh, n; };
__device__ __forceinline__ AttnIdx attn_decode(int unit) {
    AttnIdx x; const int bh = unit >> 5, j = unit & 31; x.hg = bh % 12; const int gi = x.hg >> 2;
    x.dsh = 2 * gi; const int nbsh = 5 - x.dsh;
    x.n = j & ((1 << nbsh) - 1);
    x.row0 = (size_t)bh * SEQ + (size_t)j * 128; return x;
}
constexpr int ATT_HB = 128 * VROW;
constexpr int ATT_KOFF = 0, ATT_VOFF = 2 * ATT_HB;
__device__ __forceinline__ void attn_load_kv(AttnPre& p, const bf16* K, const bf16* V, size_t r0, int tid) {
#pragma unroll
    for (int i = 0; i < 4; ++i) { const size_t off = r0 * 128 + (size_t)(tid + 512 * i) * 8; p.k[i] = *(const v4u*)(K + off); p.v[i] = *(const v4u*)(V + off); }
}
__device__ __forceinline__ void attn_load(AttnPre& p, const bf16* Q, const bf16* K, const bf16* V, int unit, int tid, int w, int lq, int g) {
    const AttnIdx x = attn_decode(unit);
    attn_load_kv(p, K, V, x.row0, tid);
#pragma unroll
    for (int s = 0; s < 4; ++s) p.q[s] = *(const bf16x8*)(Q + (x.row0 + 16 * w + lq) * 128 + 32 * s + 8 * g);
}
__device__ __forceinline__ void attn_stage(LAS unsigned char* lds, const AttnPre& p, int half, int tid) {
#pragma unroll
    for (int i = 0; i < 4; ++i) { const int cidx = tid + 512 * i, row = cidx >> 4, ch = cidx & 15;
        *(LAS v4u*)(lds + ATT_KOFF + half * ATT_HB + row * VROW + ch * 16) = p.k[i]; *(LAS v4u*)(lds + ATT_VOFF + half * ATT_HB + row * VROW + ch * 16) = p.v[i]; }
}
__device__ __forceinline__ void attn_compute(LAS unsigned char* lds, const bf16x8 (&qf)[4], bf16* O, float* LSE, int unit, int f, int lane, int w, int lq, int g) {
    const AttnIdx x = attn_decode(unit); const int hg = x.hg, n = x.n;
    int rowT[9];
#pragma unroll
    for (int T = 0; T < 9; ++T) { const int kk0 = 16 * w + 16 * T; rowT[T] = ((((kk0 >> 7) ^ f) & 1) << 7) + (kk0 & 127); }
    f32x4 st[9];
    const LAS unsigned char* kb = lds + ATT_KOFF + lq * VROW + 16 * g;
#pragma unroll
    for (int T = 0; T < 9; ++T) { f32x4 a = (f32x4){0.f, 0.f, 0.f, 0.f}; const LAS unsigned char* kp = kb + rowT[T] * VROW;
#pragma unroll
        for (int s = 0; s < 4; ++s) { const bf16x8 kf = *(const LAS bf16x8*)(kp + 64 * s); a = __builtin_amdgcn_mfma_f32_16x16x32_bf16(kf, qf[s], a, 0, 0, 0); }
        st[T] = a; }
    const float slope2 = __builtin_amdgcn_exp2f(-(float)(8 * (hg + 1)) * (1.0f / 12.0f)) * (float)(1 << x.dsh) * 1.4426950408889634f;
    float mx = -__builtin_inff();
#pragma unroll
    for (int T = 0; T < 9; ++T)
#pragma unroll
        for (int reg = 0; reg < 4; ++reg) { const int steps = 128 + lq - 16 * T - 4 * g - reg, ki = 16 * w + 16 * T + 4 * g + reg;
            const bool valid = (steps >= 0) && (steps <= 128) && (n > 0 || ki >= 128);
            const float v = valid ? st[T][reg] - slope2 * (float)steps : -__builtin_inff(); st[T][reg] = v; mx = fmaxf(mx, v); }
    mx = fmaxf(mx, __shfl_xor(mx, 16)); mx = fmaxf(mx, __shfl_xor(mx, 32));
    float sum = 0.f;
#pragma unroll
    for (int T = 0; T < 9; ++T)
#pragma unroll
        for (int reg = 0; reg < 4; ++reg) { const float p = __builtin_amdgcn_exp2f(st[T][reg] - mx); st[T][reg] = p; sum += p; }
    sum += __shfl_xor(sum, 16); sum += __shfl_xor(sum, 32);
    bf16x8 pf[5];
#pragma unroll
    for (int u = 0; u < 5; ++u) { v4u t; t.x = pk2(st[2 * u][0], st[2 * u][1]); t.y = pk2(st[2 * u][2], st[2 * u][3]);
        if (u < 4) { t.z = pk2(st[2 * u + 1][0], st[2 * u + 1][1]); t.w = pk2(st[2 * u + 1][2], st[2 * u + 1][3]); } else { t.z = 0u; t.w = 0u; }
        pf[u] = __builtin_bit_cast(bf16x8, t); }
    const LAS unsigned char* vb = lds + ATT_VOFF + (4 * g + ((lane & 15) >> 2)) * VROW + (lane & 3) * 16;
    f32x4 o[4][2];
#pragma unroll
    for (int cp = 0; cp < 4; ++cp) { o[cp][0] = (f32x4){0.f, 0.f, 0.f, 0.f}; o[cp][1] = (f32x4){0.f, 0.f, 0.f, 0.f}; }
#pragma unroll
    for (int u = 0; u < 5; ++u) { const LAS unsigned char* vlo = vb + rowT[2 * u] * VROW; const LAS unsigned char* vhi = vb + rowT[u < 4 ? 2 * u + 1 : 8] * VROW;
#pragma unroll
        for (int cp = 0; cp < 4; ++cp)
#pragma unroll
            for (int h2 = 0; h2 < 2; ++h2) {
                const v4i16_t lo = tr16(vlo + cp * 64 + h2 * 8), hi = tr16(vhi + cp * 64 + h2 * 8);
                const bf16x8 vf = (bf16x8){lo[0], lo[1], lo[2], lo[3], hi[0], hi[1], hi[2], hi[3]};
                o[cp][h2] = __builtin_amdgcn_mfma_f32_16x16x32_bf16(vf, pf[u], o[cp][h2], 0, 0, 0); } }
    const float inv = 1.0f / sum;
    const size_t rq = x.row0 + 16 * w + lq;
    bf16* op = O + rq * 128 + 8 * g;
#pragma unroll
    for (int cp = 0; cp < 4; ++cp) { const f32x4 a = o[cp][0] * inv, c = o[cp][1] * inv;
        v4u t; t.x = pk2(a[0], a[1]); t.y = pk2(a[2], a[3]); t.z = pk2(c[0], c[1]); t.w = pk2(c[2], c[3]);
        *(v4u*)(op + 32 * cp) = t; }
    if (g == 0) LSE[rq] = mx + __builtin_amdgcn_logf(sum);
}
__device__ __forceinline__ void attn_phase(LAS unsigned char* lds, const bf16* Q, const bf16* K, const bf16* V, bf16* O, float* LSE, int vcu, int G) {
    const int tid = threadIdx.x, lane = tid & 63, w = __builtin_amdgcn_readfirstlane(tid >> 6), lq = lane & 15, g = lane >> 4;
    const int upb = (ATT_UNITS + G - 1) / G; const int u0 = vcu * upb; int u1 = u0 + upb; if (u1 > ATT_UNITS) u1 = ATT_UNITS;
    if (u0 >= u1) return;
    for (int i = tid; i < 4 * ATT_HB / 16; i += NTHREADS) ((LAS v4u*)lds)[i] = (v4u){0u, 0u, 0u, 0u};
    __syncthreads();
    AttnPre pre; int f = 0;
    { const AttnIdx x0 = attn_decode(u0); if (x0.n > 0) { attn_load_kv(pre, K, V, x0.row0 - 128, tid); attn_stage(lds, pre, f, tid); } }
    attn_load(pre, Q, K, V, u0, tid, w, lq, g);
    for (int u = u0; u < u1; ++u) {
        bf16x8 qf[4];
#pragma unroll
        for (int s = 0; s < 4; ++s) qf[s] = pre.q[s];
        attn_stage(lds, pre, f ^ 1, tid);
        __syncthreads();
        if (u + 1 < u1) attn_load(pre, Q, K, V, u + 1, tid, w, lq, g);
        attn_compute(lds, qf, O, LSE, u, f, lane, w, lq, g);
        __syncthreads();
        f ^= 1;
    }
}

__device__ __forceinline__ void merge_rows(const bf16* OG, const float* LSE, bf16* ATT, int gw, int NGW, int lane) {
    const int hh = lane >> 4, c0 = (lane & 15) * 8;
    for (int m0 = gw * 4; m0 < M; m0 += NGW * 4) {
        float l[4][3]; v4u a[4][3];
#pragma unroll
        for (int r = 0; r < 4; ++r) { const int m = m0 + r, b = m >> 12, s = m & 4095;
#pragma unroll
            for (int gi = 0; gi < 3; ++gi) { const int dsh = 2 * gi; const int pos = ((s & ((1 << dsh) - 1)) << (12 - dsh)) + (s >> dsh);
                const size_t row = (size_t)(b * 12 + gi * 4 + hh) * 4096 + pos; l[r][gi] = LSE[row]; a[r][gi] = *(const v4u*)(OG + row * 128 + c0); } }
#pragma unroll
        for (int r = 0; r < 4; ++r) {
            const float mx = fmaxf(l[r][0], fmaxf(l[r][1], l[r][2]));
            float e0 = __builtin_amdgcn_exp2f(l[r][0] - mx), e1 = __builtin_amdgcn_exp2f(l[r][1] - mx), e2 = __builtin_amdgcn_exp2f(l[r][2] - mx);
            const float inv = 1.0f / (e0 + e1 + e2); e0 *= inv; e1 *= inv; e2 *= inv;
            const v4u A = a[r][0], B = a[r][1], C = a[r][2]; v4u o;
            o.x = pk2(e0 * bf_lo(A.x) + e1 * bf_lo(B.x) + e2 * bf_lo(C.x), e0 * bf_hi(A.x) + e1 * bf_hi(B.x) + e2 * bf_hi(C.x));
            o.y = pk2(e0 * bf_lo(A.y) + e1 * bf_lo(B.y) + e2 * bf_lo(C.y), e0 * bf_hi(A.y) + e1 * bf_hi(B.y) + e2 * bf_hi(C.y));
            o.z = pk2(e0 * bf_lo(A.z) + e1 * bf_lo(B.z) + e2 * bf_lo(C.z), e0 * bf_hi(A.z) + e1 * bf_hi(B.z) + e2 * bf_hi(C.z));
            o.w = pk2(e0 * bf_lo(A.w) + e1 * bf_lo(B.w) + e2 * bf_lo(C.w), e0 * bf_hi(A.w) + e1 * bf_hi(B.w) + e2 * bf_hi(C.w));
            *(v4u*)(ATT + (size_t)(m0 + r) * 512 + hh * 128 + c0) = o; }
    }
}

#define XB_TMO      128
#define XB_XCNT(j)  (256  + 64 * (j))
#define XB_XSUB(j)  (1280 + 64 * (j))
#define XB_XGEN(j)  (2304 + 64 * (j))
#define XB_TOP      3328
#define XB_TOPGEN   3392
#define XCD_BAR_WORDS 3456
#define XB_SPIN_CAP (1u << 18)

__device__ __forceinline__ unsigned xb_ld(unsigned* p)              { return __hip_atomic_load(p, __ATOMIC_RELAXED, __HIP_MEMORY_SCOPE_AGENT); }
__device__ __forceinline__ unsigned xb_add(unsigned* p, unsigned v) { return __hip_atomic_fetch_add(p, v, __ATOMIC_RELAXED, __HIP_MEMORY_SCOPE_AGENT); }
__device__ __forceinline__ unsigned xb_xcc_id() { return (unsigned)__builtin_amdgcn_s_getreg((3 << 11) | 20) & 0xFu; }
#define XB_SPIN(cond, bar) do { unsigned _sp = 0; while (cond) { __builtin_amdgcn_s_sleep(1); \
    if ((++_sp & 255u) == 0u) { if (xb_ld(&(bar)[XB_TMO])) break; if (_sp > XB_SPIN_CAP) { atomicAdd(&(bar)[XB_TMO], 1u); break; } } } } while (0)

struct XcdBarrier {
    unsigned* bar; unsigned x;
    volatile LAS unsigned* st;
};

__device__ __forceinline__ XcdBarrier xcd_barrier_post(unsigned* bar, volatile LAS unsigned* st) {
    XcdBarrier b; b.bar = bar; b.x = xb_xcc_id(); b.st = st;
    if (threadIdx.x == 0) (void)xb_add(&bar[XB_XCNT(b.x)], 1u);
    return b;
}
__device__ __forceinline__ void xcd_barrier_complete(unsigned* bar, unsigned x, unsigned& nloc, unsigned& nx) {
    const unsigned G = gridDim.x * gridDim.y * gridDim.z;
    unsigned sum, cnt, mine, sp = 0u;
    for (;;) {
        sum = 0u; cnt = 0u; mine = 0u;
#pragma unroll
        for (unsigned j = 0; j < 16; ++j) { const unsigned c = xb_ld(&bar[XB_XCNT(j)]); sum += c; cnt += (c > 0u) ? 1u : 0u; mine = (j == x) ? c : mine; }
        if (sum == G) break;
        __builtin_amdgcn_s_sleep(1);
        if ((++sp & 255u) == 0u) { if (xb_ld(&bar[XB_TMO])) break; if (sp > XB_SPIN_CAP) { atomicAdd(&bar[XB_TMO], 1u); break; } }
    }
    nloc = mine > 0u ? mine : 1u; nx = cnt > 0u ? cnt : 1u;
}

__device__ __forceinline__ void xcd_barrier(const XcdBarrier& b) {
    asm volatile("s_waitcnt vmcnt(0)" ::: "memory");
    __syncthreads();
    if (threadIdx.x == 0) {
        unsigned* bar = b.bar;
        __builtin_amdgcn_s_waitcnt(0);
        unsigned nloc = b.st[0], nx = b.st[1];
        if (nloc == 0u) { xcd_barrier_complete(bar, b.x, nloc, nx); b.st[0] = nloc; b.st[1] = nx; }
        const unsigned old = xb_add(&bar[XB_XSUB(b.x)], 1u);
        const unsigned gen = old / nloc;
        if (old + 1u == (gen + 1u) * nloc) {
            __builtin_amdgcn_fence(__ATOMIC_RELEASE, "agent");
            asm volatile("s_waitcnt vmcnt(0)" ::: "memory");
            const unsigned og = xb_add(&bar[XB_TOP], 1u);
            const unsigned tg = og / nx;
            if (og + 1u == (tg + 1u) * nx) xb_add(&bar[XB_TOPGEN], 1u);
            else XB_SPIN(xb_ld(&bar[XB_TOPGEN]) == tg, bar);
            __builtin_amdgcn_fence(__ATOMIC_ACQUIRE, "agent");
            xb_add(&bar[XB_XGEN(b.x)], 1u);
            asm volatile("s_waitcnt vmcnt(0)" ::: "memory");
        } else {
            XB_SPIN(xb_ld(&bar[XB_XGEN(b.x)]) == gen, bar);
            __builtin_amdgcn_fence(__ATOMIC_ACQUIRE, "agent");
            asm volatile("s_waitcnt vmcnt(0)" ::: "memory");
        }
    }
    __syncthreads();
}

template <int NP> __device__ __forceinline__ void fill_rstab(LAS unsigned char* lds, const float* ssp, int N, int G, int bx, int tid) {
    LAS float* rstab = (LAS float*)(lds + 131072); LAS int* pmtab = (LAS int*)(lds + 131072 + 15360);
    pg8::StaticOrder S0; S0.init(M, N, G, bx); pg8::Unit u0; int nu = 0;
    for (; nu < 15 && S0.next(nu, u0); ++nu) if (tid == 0) pmtab[nu] = u0.pm;
    __syncthreads();
    float sv[8];
#pragma unroll
    for (int k = 0; k < 8; ++k) { const int ri = tid + 512 * k; sv[k] = 0.f;
        if (ri < nu * 256) { const float* p = ssp + (size_t)(pmtab[ri >> 8] * 256 + (ri & 255)) * NP;
            if (NP == 16) { const f32x4 a = *(const f32x4*)p, b = *(const f32x4*)(p + 4), c = *(const f32x4*)(p + 8), d = *(const f32x4*)(p + 12);
                sv[k] = (((a.x + a.y) + (a.z + a.w)) + ((b.x + b.y) + (b.z + b.w))) + (((c.x + c.y) + (c.z + c.w)) + ((d.x + d.y) + (d.z + d.w))); }
            else sv[k] = p[0]; } }
#pragma unroll
    for (int k = 0; k < 8; ++k) { const int ri = tid + 512 * k; if (ri < nu * 256) rstab[ri] = __builtin_amdgcn_rsqf(sv[k] * (1.0f / 1024.0f) + EPS); }
    __syncthreads();
}

struct Args { const float* in[19]; float* out; unsigned char* ws; int ph_lo, ph_hi; };
#ifndef MK_MULTI
#define MK_MULTI 0
#endif
#if MK_MULTI
#define GRID_SYNC() do { } while (0)
#else
#ifndef MK_CG
#define MK_CG 0
#endif
#if MK_CG
#define GRID_SYNC() do { __threadfence(); cg::this_grid().sync(); } while (0)
#else
#define GRID_SYNC() xcd_barrier(xbar)
#endif
#endif

__global__ void __launch_bounds__(NTHREADS, 2) fwd_kernel(Args args) {
    extern __shared__ __attribute__((aligned(16))) unsigned char lds_raw[];
    LAS unsigned char* lds = (LAS unsigned char*)lds_raw;
    const int tid = threadIdx.x, lane = tid & 63, wave = __builtin_amdgcn_readfirstlane(tid >> 6);
    const int G = gridDim.x, bx = blockIdx.x; const int vcu = (G % 8 == 0) ? (bx % 8) * (G / 8) + bx / 8 : bx;
    const int gw = vcu * NWAVES + wave, NGW = G * NWAVES;
    unsigned char* ws = args.ws;
#if !MK_MULTI && !MK_CG
    volatile LAS unsigned* xst = (volatile LAS unsigned*)(lds + LDS_BYTES - 128);
    if (tid < 2) xst[tid] = 0u;
    __syncthreads();
    XcdBarrier xbar = xcd_barrier_post((unsigned*)(ws + WS_CTL), xst);
#endif
    const float* x = args.in[0];
    float* X = args.out; bf16* XB = (bf16*)args.out;
#define Wgu1 ((bf16*)(ws + WS_WGU1))
#define Wd1 ((bf16*)(ws + WS_WD1))
#define Wgu2 ((bf16*)(ws + WS_WGU2))
#define Wd2 ((bf16*)(ws + WS_WD2))
#define Win ((bf16*)(ws + WS_WIN))
#define Wc ((bf16*)(ws + WS_WC))
#define Wa ((bf16*)(ws + WS_WA))
#define Wo ((bf16*)(ws + WS_WO))
#define H ((bf16*)(ws + WS_H))
#define ZC ((bf16*)(ws + WS_ZC))
#define Qb ((bf16*)(ws + WS_Q))
#define Kb ((bf16*)(ws + WS_K))
#define Vb ((bf16*)(ws + WS_V))
#define LSE ((float*)(ws + WS_LSE))
#define ATT ((bf16*)(ws + WS_ATT))
#define ZG ((bf16*)(ws + WS_ZG))
#define GT ((bf16*)(ws + WS_G))
#define T1 ((bf16*)(ws + WS_T1))
#define MIX ((bf16*)(ws + WS_MIX))
#define A1 ((bf16*)(ws + WS_A1))
#define SS1 ((float*)(ws + WS_SS))
#define SS2 ((float*)(ws + WS_SSP))
#define SS3 ((float*)(ws + WS_SSP) + (size_t)M * 16)
    const int lo = args.ph_lo, hi = args.ph_hi;
#define IN(k) (lo <= (k) && (k) < hi)
#define SEAM(k) do { if (IN(k) && IN((k) + 1)) GRID_SYNC(); } while (0)
#define GEMM_PHASE(EPI, Aptr, Bptr, Nn, Kk, ...) do { pg8::Gemm g_{Aptr, Bptr, M, Nn, Kk}; pg8::StaticOrder S_; S_.init(M, Nn, G, bx); EPI E_{__VA_ARGS__}; \
        pg8::gemm_phase<EPI, pg8::StaticOrder, true, true>(lds, g_, S_, E_); } while (0)
#define GEMM_PHASE_RS(SSp, NP, EPI, Aptr, Bptr, Nn, Kk, ...) do { fill_rstab<NP>(lds, SSp, Nn, G, bx, tid); GEMM_PHASE(EPI, Aptr, Bptr, Nn, Kk, __VA_ARGS__); } while (0)

    if (IN(0)) {
        LAS float* scr = (LAS float*)(lds + wave * 16384);
        constexpr int I_GU = 16 * 88, I_DN = 44 * 32, I_IN = 16 * 272, I_C = 16 * 32, I_A = 8 * 32;
        constexpr int NITEMS = 6 * I_GU + I_IN + 2 * I_C + I_A;
        static_assert(I_DN == I_GU, "items");
        for (int it = gw; it < NITEMS; it += NGW) {
            int r = it;
            if (r < I_GU) { transpose_item(args.in[2], D, FF, Wgu1, 1, scr, r, lane, args.in[1]); continue; } r -= I_GU;
            if (r < I_GU) { transpose_item(args.in[3], D, FF, Wgu1, 2, scr, r, lane, args.in[1]); continue; } r -= I_GU;
            if (r < I_GU) { transpose_item(args.in[4], FF, D, Wd1, 0, scr, r, lane); continue; } r -= I_GU;
            if (r < I_GU) { transpose_item(args.in[15], D, FF, Wgu2, 1, scr, r, lane, args.in[14]); continue; } r -= I_GU;
            if (r < I_GU) { transpose_item(args.in[16], D, FF, Wgu2, 2, scr, r, lane, args.in[14]); continue; } r -= I_GU;
            if (r < I_GU) { transpose_item(args.in[17], FF, D, Wd2, 0, scr, r, lane); continue; } r -= I_GU;
            if (r < I_IN) { transpose_item(args.in[6], D, NIN, Win, 3, scr, r, lane, args.in[5]); continue; } r -= I_IN;
            if (r < I_C) { transpose_item(args.in[11], D, D, Wc, 0, scr, r, lane); continue; } r -= I_C;
            if (r < I_A) { transpose_item(args.in[12], 512, D, Wa, 0, scr, r, lane); continue; } r -= I_A;
            transpose_item(args.in[13], D, D, Wo, 0, scr, r, lane);
        }
        raw_rows(x, H, SS1, gw, NGW, lane);
        __syncthreads();
    }
    SEAM(0);
    if (IN(1)) GEMM_PHASE_RS(SS1, 1, pg8::EpiPair<0>, H, Wgu1, 2 * FF, D, A1, FF);
    SEAM(1);
    if (IN(2)) GEMM_PHASE(pg8::EpiResid<true>, A1, Wd1, D, FF, H, XB, SS2, 0.5f);
    SEAM(2);
    if (IN(3)) GEMM_PHASE_RS(SS2, 16, pg8::EpiGluQkv, XB, Win, 2048 + 3 * AW, D, {ZG, D}, {Qb, (size_t)(WS_K - WS_Q) / 2, 0.08838834764831845f * 1.4426950408889634f});
    SEAM(3);
    if (IN(4)) { conv_phase(ZG, args.in[7], args.in[8], args.in[9], args.in[10], ZC, (LAS float*)lds, vcu, G); __syncthreads(); }
    if (IN(4)) attn_phase(lds, Qb, Kb, Vb, Qb, LSE, vcu, G);
    SEAM(4);
    if (IN(5)) { merge_rows(Qb, LSE, ATT, gw, NGW, lane); __syncthreads(); }
    if (IN(5)) GEMM_PHASE_RS(SS2, 16, pg8::EpiSig, XB, Win + (size_t)6656 * D, 2048, D, GT, 2048);
    SEAM(5);
    if (IN(6)) GEMM_PHASE(pg8::EpiGate<false>, ZC, Wc, D, D, nullptr, GT, 2048, T1);
    if (IN(6)) GEMM_PHASE(pg8::EpiGate<true>, ATT, Wa, D, 512, T1, GT + 1024, 2048, MIX);
    SEAM(6);
    if (IN(7)) GEMM_PHASE(pg8::EpiResid<true>, MIX, Wo, D, D, XB, XB, SS3, 1.0f);
    SEAM(7);
    if (IN(8)) GEMM_PHASE_RS(SS3, 16, pg8::EpiPair<0>, XB, Wgu2, 2 * FF, D, A1, FF);
    SEAM(8);
    if (IN(9)) GEMM_PHASE(pg8::EpiResid<true>, A1, Wd2, D, FF, XB, H, nullptr, 0.5f);
    SEAM(9);
    if (IN(10)) rms_rows_b(H, args.in[18], X, gw, NGW, lane);
#undef IN
#undef Wgu1
#undef Wd1
#undef Wgu2
#undef Wd2
#undef Win
#undef Wc
#undef Wa
#undef Wo
#undef H
#undef ZC
#undef Qb
#undef Kb
#undef Vb
#undef LSE
#undef ATT
#undef ZG
#undef GT
#undef T1
#undef MIX
#undef A1
#undef SS1
#undef SS2
#undef SS3
#undef SEAM
}
constexpr int NPHASES = 11;

extern "C" void kernel_launch(void* const* d_in, const int* in_sizes, int n_in, void* d_out, int out_size, void* d_ws, size_t ws_size, hipStream_t stream) {
    static int grid = 0;
    if (grid == 0) {
        if (n_in != 19 || out_size != M * D || ws_size < WS_END) { fprintf(stderr, "kernel_launch: unexpected shapes (n_in %d out %d ws %zu)\n", n_in, out_size, ws_size); grid = -1; return; }
        int dev = 0, cus = 0, per_cu = 0;
        hipGetDevice(&dev); hipDeviceGetAttribute(&cus, hipDeviceAttributeMultiprocessorCount, dev);
        if (hipFuncSetAttribute((const void*)fwd_kernel, hipFuncAttributeMaxDynamicSharedMemorySize, LDS_BYTES) != hipSuccess) { fprintf(stderr, "kernel_launch: hipFuncSetAttribute failed\n"); grid = -1; return; }
        if (hipOccupancyMaxActiveBlocksPerMultiprocessor(&per_cu, (const void*)fwd_kernel, NTHREADS, LDS_BYTES) != hipSuccess || per_cu < 1) { fprintf(stderr, "kernel_launch: occupancy query says %d\n", per_cu); per_cu = 1; }
        (void)hipGetLastError();
        if (per_cu > 1) per_cu = 1;
        grid = cus * per_cu;
    }
    if (grid < 0) return;
    Args a{};
    for (int i = 0; i < 19; ++i) a.in[i] = (const float*)d_in[i];
    a.out = (float*)d_out; a.ws = (unsigned char*)d_ws;
#if MK_MULTI
    for (int p = 0; p < NPHASES; ++p) { a.ph_lo = p; a.ph_hi = p + 1; hipLaunchKernelGGL(fwd_kernel, dim3(grid), dim3(NTHREADS), LDS_BYTES, stream, a); }
#else
    a.ph_lo = 0; a.ph_hi = NPHASES;
#if MK_CG
    void* kargs[] = {&a};
    hipError_t e = hipLaunchCooperativeKernel((const void*)fwd_kernel, dim3(grid), dim3(NTHREADS), kargs, LDS_BYTES, stream);
    if (e != hipSuccess) fprintf(stderr, "cooperative launch failed: %s (grid %d)\n", hipGetErrorString(e), grid);
#else
    if (hipMemsetAsync((char*)d_ws + WS_CTL, 0, 65536, stream) != hipSuccess) { fprintf(stderr, "kernel_launch: memset failed\n"); return; }
    hipLaunchKernelGGL(fwd_kernel, dim3(grid), dim3(NTHREADS), LDS_BYTES, stream, a);
#endif
#endif
}
```
